# Optimizing an MI355X kernel written in HIP

```python
import jax, jax.numpy as jnp
from jax import lax
import numpy as np

D_MODEL = 2048
BATCH = 8
SEQ = 2048
DEPTH = 1

CHUNK = 64
N_META = 16
POOL_W = D_MODEL // 2
POOL_WINDOWS = (2, 4, 8, 16)
POOL_GROUPS = len(POOL_WINDOWS)
POOL_GW = POOL_W // POOL_GROUPS
V_DIM = 128
N_HEADS = (D_MODEL - POOL_W) // V_DIM
QK_NOPE = 128
QK_ROPE = 64
Q_LORA = D_MODEL // 4
KV_LORA = D_MODEL // 8
MLA_W = N_HEADS * V_DIM
MIX_W = POOL_W + MLA_W
IN_W = POOL_W + Q_LORA + KV_LORA + QK_ROPE
ROPE_BASE = 10000.0
Q_BLOCK = 128
SOFTMAX_SCALE = (QK_NOPE + QK_ROPE) ** -0.5
N_EXPERTS = 32
TOP_K = 4
D_FF = D_MODEL
SWIGLU_LIMIT = 7.0
SWIGLU_ALPHA = 1.702
EXPERT_BLOCK = 256
EPS = 1e-5

kernel_name = "hymba_pool_mla_moe_streaming"


def rmsnorm(x, g):
    xf = x.astype(jnp.float32)
    y = xf * lax.rsqrt(jnp.mean(xf * xf, axis=-1, keepdims=True) + EPS)
    return (y * g.astype(jnp.float32)).astype(x.dtype)


def chunk_ids(pos):
    return jnp.where(pos < N_META, 0, 1 + (pos - N_META) // CHUNK)


def rope(x, cos, sin):
    half = x.shape[-1] // 2
    xf = x.astype(jnp.float32)
    x1, x2 = xf[..., :half], xf[..., half:]
    return jnp.concatenate([x1 * cos - x2 * sin, x2 * cos + x1 * sin], axis=-1).astype(x.dtype)


def pool_mixer(u, pool_w, pool_scale):
    B, L, _ = u.shape
    uf = u.astype(jnp.float32)
    t = jnp.arange(L)
    outs = []
    for g, w in enumerate(POOL_WINDOWS):
        ug = uf[..., g * POOL_GW:(g + 1) * POOL_GW]
        cs = jnp.concatenate([jnp.zeros((B, 1, POOL_GW), jnp.float32), jnp.cumsum(ug, axis=1)], axis=1)
        lo = jnp.maximum(t + 1 - w, 0)
        cnt = (t + 1 - lo).astype(jnp.float32)
        mean = (cs[:, 1:] - cs[:, lo]) / cnt[None, :, None]
        outs.append(mean - ug)
    d = jnp.stack(outs, axis=2).astype(u.dtype)
    y = jnp.einsum('blgc,gcd->blgd', d, pool_w).reshape(B, L, POOL_W)
    return y * pool_scale


def mla(q_c, kv_c, k_r, q_norm_g, w_uq, kv_norm_g, w_ukv):
    B, L, _ = q_c.shape
    q = (rmsnorm(q_c, q_norm_g) @ w_uq).reshape(B, L, N_HEADS, QK_NOPE + QK_ROPE)
    kv = (rmsnorm(kv_c, kv_norm_g) @ w_ukv).reshape(B, L, N_HEADS, QK_NOPE + V_DIM)
    pos = jnp.arange(L)
    inv_freq = 1.0 / (ROPE_BASE ** (jnp.arange(0, QK_ROPE, 2, dtype=jnp.float32) / QK_ROPE))
    ang = pos.astype(jnp.float32)[:, None] * inv_freq[None, :]
    cos, sin = jnp.cos(ang), jnp.sin(ang)
    q_rope = rope(q[..., QK_NOPE:], cos[None, :, None], sin[None, :, None])
    k_rope = rope(k_r, cos[None], sin[None])
    q = jnp.concatenate([q[..., :QK_NOPE], q_rope], axis=-1)
    k = jnp.concatenate([kv[..., :QK_NOPE], jnp.broadcast_to(k_rope[:, :, None, :], (B, L, N_HEADS, QK_ROPE))], axis=-1)
    v = kv[..., QK_NOPE:]
    n_blk = -(-L // Q_BLOCK)
    Lp = n_blk * Q_BLOCK
    padw = ((0, 0), (0, Lp - L), (0, 0), (0, 0))
    q, k, v = jnp.pad(q, padw), jnp.pad(k, padw), jnp.pad(v, padw)
    ppos = jnp.arange(Lp)
    q_chunk = chunk_ids(ppos)
    k_chunk = jnp.where(ppos < L, q_chunk, jnp.iinfo(jnp.int32).max)
    qb = q.reshape(B, n_blk, Q_BLOCK, N_HEADS, QK_NOPE + QK_ROPE).transpose(1, 0, 2, 3, 4)
    qcb = q_chunk.reshape(n_blk, Q_BLOCK)

    def attend(args):
        qblk, qc = args
        s = jnp.einsum('bqhd,bkhd->bhqk', qblk, k).astype(jnp.float32) * SOFTMAX_SCALE
        mask = k_chunk[None, :] <= qc[:, None]
        s = jnp.where(mask[None, None], s, -jnp.inf)
        p = jax.nn.softmax(s, axis=-1).astype(v.dtype)
        return jnp.einsum('bhqk,bkhd->bqhd', p, v)

    o = lax.map(attend, (qb, qcb))
    o = o.transpose(1, 0, 2, 3, 4).reshape(B, Lp, MLA_W)
    return o[:, :L]


def moe(h, w_router, b_router, w1, b1, w2, b2):
    B, L, D = h.shape
    xf = h.reshape(-1, D)
    T = xf.shape[0]
    logits = (xf @ w_router + b_router).astype(jnp.float32)
    top_val, top_idx = lax.top_k(logits, TOP_K)
    gates = jax.nn.softmax(top_val, axis=-1).astype(h.dtype)
    n_assign = T * TOP_K
    e_flat = top_idx.reshape(-1)
    g_flat = gates.reshape(-1)
    tok_flat = jnp.arange(n_assign, dtype=jnp.int32) // TOP_K
    order = jnp.argsort(e_flat)
    sorted_e = e_flat[order]
    counts = jnp.bincount(e_flat, length=N_EXPERTS)
    starts = jnp.cumsum(counts) - counts
    padded = (counts + EXPERT_BLOCK - 1) // EXPERT_BLOCK * EXPERT_BLOCK
    pad_ends = jnp.cumsum(padded)
    pad_starts = pad_ends - padded
    dest = pad_starts[sorted_e] + (jnp.arange(n_assign) - starts[sorted_e])
    n_blocks = -(-(n_assign + N_EXPERTS * (EXPERT_BLOCK - 1)) // EXPERT_BLOCK)
    P = n_blocks * EXPERT_BLOCK
    row_tok = jnp.full((P,), T, jnp.int32).at[dest].set(tok_flat[order])
    row_gate = jnp.zeros((P,), h.dtype).at[dest].set(g_flat[order])
    block_e = jnp.minimum(jnp.searchsorted(pad_ends, jnp.arange(n_blocks) * EXPERT_BLOCK, side='right'), N_EXPERTS - 1)
    x_pad = jnp.concatenate([xf, jnp.zeros((1, D), xf.dtype)], axis=0)

    def expert_block(args):
        tok, gate, e = args
        xb = x_pad[tok]
        hc = xb @ w1[e] + b1[e]
        glu = jnp.minimum(hc[:, ::2], SWIGLU_LIMIT)
        lin = jnp.clip(hc[:, 1::2], -SWIGLU_LIMIT, SWIGLU_LIMIT)
        a = glu * jax.nn.sigmoid(SWIGLU_ALPHA * glu) * (lin + 1)
        y = a @ w2[e] + b2[e]
        return y * gate[:, None]

    ys = lax.map(expert_block, (row_tok.reshape(n_blocks, EXPERT_BLOCK), row_gate.reshape(n_blocks, EXPERT_BLOCK), block_e))
    out = jnp.zeros((T + 1, D), h.dtype).at[row_tok].add(ys.reshape(P, D))[:T]
    return out.reshape(B, L, D)


def setup_inputs(seed: int = 0) -> dict:
    key = jax.random.key(seed)
    ks = jax.random.split(key, 20)

    def nrm(k, shape, scale):
        return jax.random.normal(k, shape, jnp.float32) * scale

    def gain(k, shape):
        return 1.0 + 0.05 * jax.random.normal(k, shape, jnp.float32)

    return {
        "x": nrm(ks[0], (BATCH, SEQ, D_MODEL), 1.0),
        "meta_tokens": nrm(ks[1], (N_META, D_MODEL), 1.0),
        "attn_norm_g": gain(ks[2], (DEPTH, D_MODEL)),
        "w_in": nrm(ks[3], (DEPTH, D_MODEL, IN_W), D_MODEL ** -0.5),
        "q_norm_g": gain(ks[4], (DEPTH, Q_LORA)),
        "w_uq": nrm(ks[5], (DEPTH, Q_LORA, N_HEADS * (QK_NOPE + QK_ROPE)), Q_LORA ** -0.5),
        "kv_norm_g": gain(ks[6], (DEPTH, KV_LORA)),
        "w_ukv": nrm(ks[7], (DEPTH, KV_LORA, N_HEADS * (QK_NOPE + V_DIM)), KV_LORA ** -0.5),
        "pool_w": nrm(ks[8], (DEPTH, POOL_GROUPS, POOL_GW, POOL_GW), POOL_GW ** -0.5),
        "pool_scale": gain(ks[9], (DEPTH, POOL_W)),
        "w_o": nrm(ks[10], (DEPTH, MIX_W, D_MODEL), MIX_W ** -0.5),
        "ffn_norm_g": gain(ks[11], (DEPTH, D_MODEL)),
        "w_router": nrm(ks[12], (DEPTH, D_MODEL, N_EXPERTS), D_MODEL ** -0.5),
        "b_router": nrm(ks[13], (DEPTH, N_EXPERTS), 0.01),
        "w1": nrm(ks[14], (DEPTH, N_EXPERTS, D_MODEL, 2 * D_FF), D_MODEL ** -0.5),
        "b1": nrm(ks[15], (DEPTH, N_EXPERTS, 2 * D_FF), 0.01),
        "w2": nrm(ks[16], (DEPTH, N_EXPERTS, D_FF, D_MODEL), D_FF ** -0.5),
        "b2": nrm(ks[17], (DEPTH, N_EXPERTS, D_MODEL), 0.01),
        "final_norm_g": gain(ks[18], (D_MODEL,)),
    }


def reference(x, meta_tokens, attn_norm_g, w_in, q_norm_g, w_uq, kv_norm_g, w_ukv, pool_w, pool_scale, w_o, ffn_norm_g, w_router, b_router, w1, b1, w2, b2, final_norm_g):
    B = x.shape[0]
    meta = jnp.broadcast_to(meta_tokens[None].astype(x.dtype), (B, N_META, D_MODEL))
    h = jnp.concatenate([meta, x], axis=1)
    cuts = [POOL_W, POOL_W + Q_LORA, POOL_W + Q_LORA + KV_LORA]
    for layer in range(DEPTH):
        hn = rmsnorm(h, attn_norm_g[layer])
        proj = hn @ w_in[layer]
        pool_in, q_c, kv_c, k_r = jnp.split(proj, cuts, axis=-1)
        y_pool = pool_mixer(pool_in, pool_w[layer], pool_scale[layer])
        y_mla = mla(q_c, kv_c, k_r, q_norm_g[layer], w_uq[layer], kv_norm_g[layer], w_ukv[layer])
        h = h + jnp.concatenate([y_pool, y_mla], axis=-1) @ w_o[layer]
        h = h + moe(rmsnorm(h, ffn_norm_g[layer]), w_router[layer], b_router[layer], w1[layer], b1[layer], w2[layer], b2[layer])
    h = rmsnorm(h, final_norm_g)
    return h[:, N_META:]
```

```cpp
#include <hip/hip_runtime.h>
#include <cstdint>
#include <cstdio>

constexpr int NB = 8, SEQ = 2048, NMETA = 16, LSEQ = 2064, LP = 2112, PADR = 48, MP = NB * LP, MR = NB * SEQ;
constexpr int DM = 2048, POOLW = 1024, QLORA = 512, KVLORA = 256, QKROPE = 64, QKNOPE = 128, VDIM = 128, NH = 8, QKD = 192;
constexpr int INW = 1856, NE = 32, TOPK = 4, DFF = 2048;
constexpr float EPS = 1e-5f;
constexpr float C2 = 0.07216878364870322f * 1.4426950408889634f;
constexpr int ACT_ROWS = MR * TOPK + NE * 256;

typedef unsigned short bf16_t;
typedef unsigned u32x4 __attribute__((ext_vector_type(4)));
typedef float f32x4 __attribute__((ext_vector_type(4)));

constexpr size_t MiB = 1u << 20;
constexpr size_t WS_CTL = 0, CTL_ZERO_BYTES = 1 * MiB;
constexpr size_t WS_ROPE = 1 * MiB;
constexpr size_t WS_WR = 2 * MiB;
constexpr size_t WS_WIN = 4 * MiB;
constexpr size_t WS_WUQ = 12 * MiB;
constexpr size_t WS_WUKV = 14 * MiB;
constexpr size_t WS_WPOOL = 15 * MiB;
constexpr size_t WS_WO = 16 * MiB;
constexpr size_t WS_W1 = 24 * MiB;
constexpr size_t WS_W2 = 536 * MiB;
constexpr size_t WS_HN = 792 * MiB;
constexpr size_t WS_PROJ = 860 * MiB;
constexpr size_t WS_QB = 928 * MiB;
constexpr size_t WS_KN = 980 * MiB;
constexpr size_t WS_VB = 1014 * MiB;
constexpr size_t WS_KR = 1048 * MiB;
constexpr size_t WS_RSQ = 1051 * MiB;
constexpr size_t WS_RSKV = 1052 * MiB;
constexpr size_t WS_RS2 = 1053 * MiB;
constexpr size_t WS_DP = 1054 * MiB;
constexpr size_t WS_MIX = 1088 * MiB;
constexpr size_t WS_H2B = 1156 * MiB;
constexpr size_t WS_LIST = 1220 * MiB;
constexpr size_t WS_GATE = 1222 * MiB;
constexpr size_t WS_ACT = 1224 * MiB;
constexpr size_t WS_YB = 1512 * MiB;
constexpr size_t WS_RSL = 1768 * MiB;
constexpr size_t WS_END = 1770 * MiB;
constexpr int CW_CNT = 64;

struct Ptrs {
    const float *x, *meta, *g_attn, *w_in, *g_q, *w_uq, *g_kv, *w_ukv, *pool_w, *pool_scale, *w_o, *g_ffn, *w_router, *b_router, *w1, *b1, *w2, *b2, *g_final;
    float* out; unsigned char* ws;
};

__device__ __forceinline__ float bf2f(bf16_t v) { return __uint_as_float((unsigned)v << 16); }
__device__ __forceinline__ unsigned f2bf(float f) { unsigned u = __float_as_uint(f); return (u + 0x7fffu + ((u >> 16) & 1u)) >> 16; }
__device__ __forceinline__ unsigned pk2(float lo, float hi) { return f2bf(lo) | (f2bf(hi) << 16); }
__device__ __forceinline__ float wave_sum(float v) {
#pragma unroll
    for (int o = 1; o < 64; o <<= 1) v += __shfl_xor(v, o);
    return v;
}
__device__ __forceinline__ float wave_max(float v) {
#pragma unroll
    for (int o = 1; o < 64; o <<= 1) v = fmaxf(v, __shfl_xor(v, o));
    return v;
}

__device__ __forceinline__ void p0_hn_row(const Ptrs& P, int p, int lane) {
    bf16_t* hn = (bf16_t*)(P.ws + WS_HN) + (size_t)p * DM;
    const int b = p / LP, q = p % LP;
    unsigned long long* o8 = (unsigned long long*)hn + lane;
    if (q < PADR) {
#pragma unroll
        for (int j = 0; j < 8; ++j) o8[64 * j] = 0ull;
        return;
    }
    const int pos = q - PADR;
    const float* src = pos < NMETA ? P.meta + (size_t)pos * DM : P.x + ((size_t)b * SEQ + (pos - NMETA)) * DM;
    const f32x4* xr = (const f32x4*)src + lane;
    const f32x4* gr = (const f32x4*)P.g_attn + lane;
    f32x4 v[8]; float s = 0.f;
#pragma unroll
    for (int j = 0; j < 8; ++j) { v[j] = xr[64 * j]; s += (v[j].x * v[j].x + v[j].y * v[j].y) + (v[j].z * v[j].z + v[j].w * v[j].w); }
    const float rs = 1.0f / sqrtf(wave_sum(s) * (1.0f / DM) + EPS);
#pragma unroll
    for (int j = 0; j < 8; ++j) { const f32x4 g = gr[64 * j];
        o8[64 * j] = (unsigned long long)pk2(v[j].x * rs * g.x, v[j].y * rs * g.y) | ((unsigned long long)pk2(v[j].z * rs * g.z, v[j].w * rs * g.w) << 32); }
}
template <int MODE> __device__ __forceinline__ int nmap(int n) {
    if (MODE == 1) { if (n >= 1792) { const int j = n - 1792; return 1792 + (j < 32 ? 2 * j : 2 * (j - 32) + 1); } return n; }
    if (MODE == 2) { const int h = n / 192, d = n % 192; if (d >= 128) { const int j = d - 128; return h * 192 + 128 + (j < 32 ? 2 * j : 2 * (j - 32) + 1); } return n; }
    return n;
}
template <int MODE> __device__ __forceinline__ void p0_transpose_item(const float* W, int K, int N, bf16_t* WT, const float* gk, float* scr, int item, int lane) {
    const int nblk = N / 64, kb = item / nblk, nb = item % nblk, k0 = 64 * kb, n0 = 64 * nb;
    const int kl = lane >> 4, nl = (lane & 15) * 4;
#pragma unroll 4
    for (int i = 0; i < 16; ++i) { const int kk = kl + 4 * i; const f32x4 v = *(const f32x4*)(W + (size_t)(k0 + kk) * N + n0 + nl);
        const float g = gk ? gk[k0 + kk] : 1.0f;
        float* s = scr + kk * 65 + nl; s[0] = v.x * g; s[1] = v.y * g; s[2] = v.z * g; s[3] = v.w * g; }
    __builtin_amdgcn_s_waitcnt(0xc07f); asm volatile("" ::: "memory");
    const int c = lane & 7;
#pragma unroll
    for (int j = 0; j < 8; ++j) { const int n = (lane >> 3) + 8 * j; const float* s = scr + (8 * c) * 65 + n;
        u32x4 o; o.x = pk2(s[0 * 65], s[1 * 65]); o.y = pk2(s[2 * 65], s[3 * 65]); o.z = pk2(s[4 * 65], s[5 * 65]); o.w = pk2(s[6 * 65], s[7 * 65]);
        *(u32x4*)(WT + (size_t)nmap<MODE>(n0 + n) * K + k0 + 8 * c) = o; }
    __builtin_amdgcn_s_waitcnt(0xc07f); asm volatile("" ::: "memory");
}
__device__ __forceinline__ void p0_transpose_item_f8(const float* W, int K, int N, unsigned char* WT, const float* gk, float scale, float* scr, int item, int lane) {
    const int nblk = N / 64, kb = item / nblk, nb = item % nblk, k0 = 64 * kb, n0 = 64 * nb;
    const int kl = lane >> 4, nl = (lane & 15) * 4;
#pragma unroll 4
    for (int i = 0; i < 16; ++i) { const int kk = kl + 4 * i; const f32x4 v = *(const f32x4*)(W + (size_t)(k0 + kk) * N + n0 + nl);
        const float g = (gk ? gk[k0 + kk] : 1.0f) * scale;
        float* s = scr + kk * 65 + nl; s[0] = v.x * g; s[1] = v.y * g; s[2] = v.z * g; s[3] = v.w * g; }
    asm volatile("s_waitcnt lgkmcnt(0)" ::: "memory");
    const int c = lane & 7;
#pragma unroll
    for (int j = 0; j < 8; ++j) { const int n = (lane >> 3) + 8 * j; const float* s = scr + (8 * c) * 65 + n;
        int w0 = 0, w1 = 0;
        w0 = __builtin_amdgcn_cvt_pk_fp8_f32(s[0 * 65], s[1 * 65], w0, false); w0 = __builtin_amdgcn_cvt_pk_fp8_f32(s[2 * 65], s[3 * 65], w0, true);
        w1 = __builtin_amdgcn_cvt_pk_fp8_f32(s[4 * 65], s[5 * 65], w1, false); w1 = __builtin_amdgcn_cvt_pk_fp8_f32(s[6 * 65], s[7 * 65], w1, true);
        *(unsigned long long*)(WT + (size_t)(n0 + n) * K + k0 + 8 * c) = (unsigned long long)(unsigned)w0 | ((unsigned long long)(unsigned)w1 << 32); }
    asm volatile("s_waitcnt lgkmcnt(0)" ::: "memory");
}
constexpr int CV_ITEMS_W1 = NE * (DM / 128) * (4096 / 256), CV_ITEMS_W2 = NE * (DFF / 128) * (DM / 256), CV_ITEMS = CV_ITEMS_W1 + CV_ITEMS_W2;
struct CvItem { const float* src; unsigned char* dst; const float* gk; };
template <bool W1> __device__ __forceinline__ CvItem cv_decode(const Ptrs& P, int it) {
    CvItem c;
    if (W1) { const int e = it >> 8, r = it & 255, kb = r >> 4, nb = r & 15;
        c.src = P.w1 + (size_t)e * DM * 4096 + (size_t)kb * 128 * 4096 + nb * 256; c.dst = P.ws + WS_W1 + ((size_t)e * 4096 + nb * 256) * DM + kb * 128; c.gk = P.g_ffn + kb * 128; }
    else { const int j = it - CV_ITEMS_W1, e = j >> 7, r = j & 127, kb = r >> 3, nb = r & 7;
        c.src = P.w2 + (size_t)e * DFF * DM + (size_t)kb * 128 * DM + nb * 256; c.dst = P.ws + WS_W2 + ((size_t)e * DM + nb * 256) * DFF + kb * 128; c.gk = nullptr; }
    return c;
}
#define CV_LOAD(V, C) do { const __amdgpu_buffer_rsrc_t rs_ = __builtin_amdgcn_make_buffer_rsrc((void*)(C).src, 0, 0x7ffffffe, 0x00020000); \
        _Pragma("unroll") for (int i_ = 0; i_ < 16; ++i_) V[i_] = __builtin_bit_cast(f32x4, __builtin_amdgcn_raw_buffer_load_b128(rs_, lane * 16, (wave + 8 * i_) * NN * 4, 2  )); } while (0)
#define CV_PROCESS(V, C, NEXT_IDX) do { \
        _Pragma("unroll") for (int i_ = 0; i_ < 16; ++i_) { const int k_ = wave + 8 * i_; const float g_ = W1 ? (C).gk[k_] * 32.0f : 32.0f; float* s_ = scr + k_ * 257 + lane * 4; \
            s_[0] = V[i_].x * g_; s_[1] = V[i_].y * g_; s_[2] = V[i_].z * g_; s_[3] = V[i_].w * g_; } \
        unsigned char* dst_ = (C).dst; \
        { const int nx_ = (NEXT_IDX) < count ? (NEXT_IDX) : count - 1; (C) = cv_decode<W1>(P, first + nx_ * step); CV_LOAD(V, C); } \
        asm volatile("s_waitcnt lgkmcnt(0)\n\ts_barrier" ::: "memory"); \
          \
        _Pragma("unroll") for (int p_ = 0; p_ < 4; ++p_) { const int u_ = p_ * 8 + wave, nn_ = (u_ >> 1) * 16 + (lane >> 2), k0_ = (u_ & 1) * 64 + (lane & 3) * 16; \
            const float* t_ = scr + k0_ * 257 + nn_; u32x4 w_; \
            _Pragma("unroll") for (int d_ = 0; d_ < 4; ++d_) { int x_ = 0; x_ = __builtin_amdgcn_cvt_pk_fp8_f32(t_[(4 * d_) * 257], t_[(4 * d_ + 1) * 257], x_, false); \
                x_ = __builtin_amdgcn_cvt_pk_fp8_f32(t_[(4 * d_ + 2) * 257], t_[(4 * d_ + 3) * 257], x_, true); w_[d_] = (unsigned)x_; } \
            *(u32x4*)(dst_ + (size_t)nn_ * DM + k0_) = w_; } \
        asm volatile("s_waitcnt lgkmcnt(0)\n\ts_barrier" ::: "memory"); } while (0)
template <bool W1> __device__ __forceinline__ void cv_slice(const Ptrs& P, unsigned char* ldsg, int tid, int first, int step, int count) {
    if (count <= 0) return;
    constexpr int NN = W1 ? 4096 : DM;
    float* scr = (float*)ldsg;
    const int lane = tid & 63, wave = __builtin_amdgcn_readfirstlane(tid >> 6);
    f32x4 va[16];
    CvItem ca = cv_decode<W1>(P, first);
    CV_LOAD(va, ca);
    for (int n = 0; n < count; ++n) CV_PROCESS(va, ca, n + 1);
    asm volatile("s_waitcnt vmcnt(0)" ::: "memory");
}
#undef CV_LOAD
#undef CV_PROCESS
constexpr int I_WIN = (DM / 64) * (INW / 64), I_WUQ = (QLORA / 64) * (1536 / 64), I_WUKV = (KVLORA / 64) * (2048 / 64), I_POOL1 = 4 * 4, I_WO = 32 * 32,
              I_W1E = (DM / 64) * (4096 / 64), I_W2E = 32 * 32;
constexpr int I_SMALL = I_WIN + I_WUQ + I_WUKV + 4 * I_POOL1 + I_WO;
constexpr long I_TOTAL = (long)I_SMALL;
__device__ __forceinline__ void p0_item(const Ptrs& P, long it, float* scr, int lane) {
    unsigned char* ws = P.ws;
    if (it < I_SMALL) {
        int r = (int)it;
        if (r < I_WIN) { p0_transpose_item<1>(P.w_in, DM, INW, (bf16_t*)(ws + WS_WIN), nullptr, scr, r, lane); return; } r -= I_WIN;
        if (r < I_WUQ) { p0_transpose_item<2>(P.w_uq, QLORA, 1536, (bf16_t*)(ws + WS_WUQ), P.g_q, scr, r, lane); return; } r -= I_WUQ;
        if (r < I_WUKV) { p0_transpose_item<0>(P.w_ukv, KVLORA, 2048, (bf16_t*)(ws + WS_WUKV), P.g_kv, scr, r, lane); return; } r -= I_WUKV;
        if (r < 4 * I_POOL1) { const int g = r / I_POOL1; p0_transpose_item<0>(P.pool_w + (size_t)g * 65536, 256, 256, (bf16_t*)(ws + WS_WPOOL) + (size_t)g * 65536, nullptr, scr, r % I_POOL1, lane); return; } r -= 4 * I_POOL1;
        p0_transpose_item<0>(P.w_o, DM, DM, (bf16_t*)(ws + WS_WO), nullptr, scr, r, lane); return;
    }
    it -= I_SMALL;
    if (it < (long)NE * I_W1E) { const int e = (int)(it / I_W1E), r = (int)(it % I_W1E);
        p0_transpose_item_f8(P.w1 + (size_t)e * DM * 4096, DM, 4096, ws + WS_W1 + (size_t)e * 4096 * DM, P.g_ffn, 32.0f, scr, r, lane); return; }
    it -= (long)NE * I_W1E;
    { const int e = (int)(it / I_W2E), r = (int)(it % I_W2E);
      p0_transpose_item_f8(P.w2 + (size_t)e * DFF * DM, DFF, DM, ws + WS_W2 + (size_t)e * DM * DFF, nullptr, 32.0f, scr, r, lane); }
}
__device__ __forceinline__ void st4bf(bf16_t* p, float a, float b, float c, float d) { *(unsigned long long*)p = (unsigned long long)pk2(a, b) | ((unsigned long long)pk2(c, d) << 32); }
__device__ __forceinline__ void p1b_row(const Ptrs& P, int m, int lane) {
    const bf16_t* proj = (const bf16_t*)(P.ws + WS_PROJ);
    const bf16_t* row = proj + (size_t)m * DM;
    bf16_t* dp = (bf16_t*)(P.ws + WS_DP) + (size_t)m * POOLW;
    const int pos = (m % LP) - PADR;
    if (pos < 0) {
#pragma unroll
        for (int g = 0; g < 4; ++g) *(unsigned long long*)(dp + g * 256 + lane * 4) = 0ull;
        return;
    }
    unsigned long long ld[30];
    { int q = 0;
#pragma unroll
      for (int g = 0; g < 4; ++g)
#pragma unroll
          for (int j = 0; j < (2 << g); ++j) { const int jj = j < pos ? j : pos; ld[q++] = *(const unsigned long long*)(row - (size_t)jj * DM + g * 256 + lane * 4); } }
    { int q = 0;
#pragma unroll
      for (int g = 0; g < 4; ++g) { const int w = 2 << g; const int cntw = pos + 1 < w ? pos + 1 : w;
        float s0 = 0.f, s1 = 0.f, s2 = 0.f, s3 = 0.f, u0 = 0.f, u1 = 0.f, u2 = 0.f, u3 = 0.f;
#pragma unroll
        for (int j = 0; j < w; ++j) { const unsigned long long v = ld[q++]; const unsigned lo = (unsigned)v, hi = (unsigned)(v >> 32);
            const float mk = j < cntw ? 1.0f : 0.0f;
            const float a = __uint_as_float(lo << 16) * mk, b2 = __uint_as_float(lo & 0xffff0000u) * mk, cc = __uint_as_float(hi << 16) * mk, d = __uint_as_float(hi & 0xffff0000u) * mk;
            if (j == 0) { u0 = a; u1 = b2; u2 = cc; u3 = d; } s0 += a; s1 += b2; s2 += cc; s3 += d; }
        const float ic = 1.0f / (float)cntw;
        st4bf(dp + g * 256 + lane * 4, s0 * ic - u0, s1 * ic - u1, s2 * ic - u2, s3 * ic - u3); } }
}
typedef float f32x16_t __attribute__((ext_vector_type(16)));
__device__ __forceinline__ void p5_block(const Ptrs& P, int blk, unsigned char* ldsg, int tid) {
    const int lane = tid & 63, wave = tid >> 6, t = lane & 31, kk = lane >> 5, tg = wave >> 2, kq = wave & 3;
    float* part = (float*)ldsg;
    float* ssqp = part + 8 * 32 * 33;
    const float* arow = P.out + (size_t)(blk * 64 + tg * 32 + t) * DM + kq * 512 + 4 * kk;
    const f32x4* bptr = (const f32x4*)(P.ws + WS_WR) + ((kq * 128 + kk) * NE + t);
    f32x16_t acc;
#pragma unroll
    for (int r = 0; r < 16; ++r) acc[r] = 0.f;
    float ss = 0.f;
#pragma unroll 4
    for (int j = 0; j < 64; ++j) {
        const f32x4 a = *(const f32x4*)(arow + 8 * j); const f32x4 b = bptr[2 * j * NE];
        ss += (a.x * a.x + a.y * a.y) + (a.z * a.z + a.w * a.w);
        acc = __builtin_amdgcn_mfma_f32_32x32x2f32(a.x, b.x, acc, 0, 0, 0); acc = __builtin_amdgcn_mfma_f32_32x32x2f32(a.y, b.y, acc, 0, 0, 0);
        acc = __builtin_amdgcn_mfma_f32_32x32x2f32(a.z, b.z, acc, 0, 0, 0); acc = __builtin_amdgcn_mfma_f32_32x32x2f32(a.w, b.w, acc, 0, 0, 0);
    }
    ss += __shfl_xor(ss, 32);
#pragma unroll
    for (int r = 0; r < 16; ++r) part[(wave * 32 + ((r & 3) + 8 * (r >> 2) + 4 * kk)) * 33 + t] = acc[r];
    if (kk == 0) ssqp[wave * 32 + t] = ss;
    __syncthreads();
    if (tid < 64) {
        const int tg2 = tid >> 5, ti = tid & 31, r = blk * 64 + tid;
        float lg[NE];
#pragma unroll
        for (int e = 0; e < NE; ++e) lg[e] = (part[((tg2 * 4 + 0) * 32 + ti) * 33 + e] + part[((tg2 * 4 + 1) * 32 + ti) * 33 + e]) + (part[((tg2 * 4 + 2) * 32 + ti) * 33 + e] + part[((tg2 * 4 + 3) * 32 + ti) * 33 + e]);
        const float ssq = (ssqp[(tg2 * 4 + 0) * 32 + ti] + ssqp[(tg2 * 4 + 1) * 32 + ti]) + (ssqp[(tg2 * 4 + 2) * 32 + ti] + ssqp[(tg2 * 4 + 3) * 32 + ti]);
        const float rs = 1.0f / sqrtf(ssq * (1.0f / DM) + EPS);
#pragma unroll
        for (int e = 0; e < NE; ++e) lg[e] = lg[e] * rs + P.b_router[e];
        ((float*)(P.ws + WS_RS2))[r] = rs;
        int idx[TOPK]; float val[TOPK]; unsigned used = 0u;
#pragma unroll
        for (int k = 0; k < TOPK; ++k) { float best = -INFINITY; int bi = 0;
#pragma unroll
            for (int e = 0; e < NE; ++e) { const bool ok = !((used >> e) & 1u) && lg[e] > best; best = ok ? lg[e] : best; bi = ok ? e : bi; }
            used |= 1u << bi; idx[k] = bi; val[k] = best; }
        float den = 0.f, pe[TOPK];
#pragma unroll
        for (int k = 0; k < TOPK; ++k) { pe[k] = __expf(val[k] - val[0]); den += pe[k]; }
        unsigned* cnt = (unsigned*)(P.ws + WS_CTL) + CW_CNT; int* list = (int*)(P.ws + WS_LIST); float* gate = (float*)(P.ws + WS_GATE); float* rsl = (float*)(P.ws + WS_RSL);
#pragma unroll
        for (int k = 0; k < TOPK; ++k) { const unsigned slot = atomicAdd(cnt + idx[k], 1u); const size_t o = (size_t)idx[k] * MR + slot; list[o] = r * 4 + k; gate[o] = pe[k] / den; rsl[o] = rs; }
    }
    __syncthreads();
}
__device__ __forceinline__ void p8_row(const Ptrs& P, int r, int lane, float* outbase) {
    float* h2 = P.out + (size_t)r * DM; float* orow = outbase + (size_t)r * DM; const bf16_t* yb = (const bf16_t*)(P.ws + WS_YB) + (size_t)r * 4 * DM;
    f32x4 v[8]; float s = 0.f;
#pragma unroll
    for (int j = 0; j < 8; ++j) { const int c = 4 * lane + 256 * j; v[j] = __builtin_nontemporal_load((const f32x4*)(h2 + c));
#pragma unroll
        for (int k = 0; k < 4; ++k) { const unsigned long long y = __builtin_nontemporal_load((const unsigned long long*)(yb + (size_t)k * DM + c)); const unsigned lo = (unsigned)y, hi = (unsigned)(y >> 32);
            v[j].x += __uint_as_float(lo << 16); v[j].y += __uint_as_float(lo & 0xffff0000u); v[j].z += __uint_as_float(hi << 16); v[j].w += __uint_as_float(hi & 0xffff0000u); }
        s += (v[j].x * v[j].x + v[j].y * v[j].y) + (v[j].z * v[j].z + v[j].w * v[j].w); }
    const float rs = 1.0f / sqrtf(wave_sum(s) * (1.0f / DM) + EPS);
#pragma unroll
    for (int j = 0; j < 8; ++j) { const int c = 4 * lane + 256 * j; const f32x4 g = *(const f32x4*)(P.g_final + c);
        __builtin_nontemporal_store((f32x4){v[j].x * rs * g.x, v[j].y * rs * g.y, v[j].z * rs * g.z, v[j].w * rs * g.w}, (f32x4*)(orow + c)); }
}
#define LAS __attribute__((address_space(3)))
#define GAS __attribute__((address_space(1)))
typedef short bf16x8 __attribute__((ext_vector_type(8)));
typedef int v4i_t __attribute__((ext_vector_type(4)));
typedef GAS unsigned gu32;
#define RLX_AGENT __ATOMIC_RELAXED, __HIP_MEMORY_SCOPE_AGENT
constexpr int NWAVES = 8;
constexpr int RING_OFF = 0, RING_BYTES = 131072;
constexpr int TAB_OFF = 133 * 1024;
constexpr int MISC_OFF = 143 * 1024;
constexpr int LDS_BYTES = 147456;

namespace pg8 {
constexpr int BM = 256, BK = 64, HALF = 128, HTB = HALF * BK * 2, NXCD = 8, WGM = 8;
__host__ __device__ __forceinline__ int lds_byte(int r, int c) { const int st = (r >> 4) * 2 + (c >> 5), rr = r & 15, cc = c & 31, ob = rr * 64 + cc * 2; return st * 1024 + (ob ^ (((ob >> 9) & 1) << 5)); }
__host__ __device__ __forceinline__ void stage_rc(int b, int& R, int& C) { const int st = b / 1024, sb = b % 1024, swz = sb ^ (((sb >> 9) & 1) << 5); R = (st >> 1) * 16 + swz / 64; C = (st & 1) * 32 + (swz % 64) / 2; }
__host__ __device__ __forceinline__ void stage_rc_f8(int b, int& R, int& Cb) { const int s = b >> 4; R = s >> 3; const int q = s & 7; Cb = 32 * ((q >> 1) ^ ((R >> 1) & 3)) + 16 * (q & 1); }
__host__ __device__ __forceinline__ int perm32(int rho) { const int n = rho >> 4, i = rho & 15; return 8 * (i >> 2) + 4 * n + (i & 3); }
struct Unit { int pm, pn, aux; };
__device__ __forceinline__ unsigned cvt_pk_bf16(float lo, float hi) { unsigned r; asm volatile("v_cvt_pk_bf16_f32 %0, %1, %2" : "=v"(r) : "v"(lo), "v"(hi)); return r; }
__device__ __forceinline__ u32x4 pack8(const f32x4& a, const f32x4& b) { u32x4 w; w.x = cvt_pk_bf16(a[0], a[1]); w.y = cvt_pk_bf16(a[2], a[3]); w.z = cvt_pk_bf16(b[0], b[1]); w.w = cvt_pk_bf16(b[2], b[3]); return w; }

struct Order2D {
    int nM, nN, nwg, G, c;
    __device__ __forceinline__ void init(int nM_, int nN_, int G_, int c_) { nM = nM_; nN = nN_; nwg = nM * nN; G = G_; c = c_; }
    __device__ __forceinline__ bool next(int i, Unit& u) const {
        const long L = (long)i * G + c; if (L >= nwg) return false;
        int wgid = (int)L; { const int q = nwg / NXCD, r = nwg % NXCD, xcd = wgid % NXCD, off = wgid / NXCD; wgid = (xcd < r ? xcd * (q + 1) : r * (q + 1) + (xcd - r) * q) + off; }
        const int nig = WGM * nN, gid = wgid / nig, fm = gid * WGM, gsz = (nM - fm) < WGM ? (nM - fm) : WGM;
        u.pm = fm + ((wgid % nig) % gsz); u.pn = (wgid % nig) / gsz; u.aux = 0; return true;
    }
};

template <class Prob, bool ALIGN_EPI>
__device__ __forceinline__ void gemm_phase(LAS unsigned char* lds, const Prob& Pb, const int tid) {
    const int wid = __builtin_amdgcn_readfirstlane(tid >> 6), lane = tid & 63, wr = wid >> 2, wc = wid & 3, fr = lane & 15, fq = lane >> 4;
    constexpr bool F8 = Prob::F8;
    const int nt = F8 ? Pb.K / 128 : Pb.K / BK;
    constexpr bool GATHER = Prob::GATHER;
    int Rr[2], Cc[2]; unsigned voffB, voffA = 0u;
    { int R, C; if (F8) stage_rc_f8(tid * 16, R, C); else { stage_rc(tid * 16, R, C); C *= 2; }
      Rr[0] = R; Rr[1] = R + 64; Cc[0] = C; Cc[1] = C; const int Rb = (R & ~31) + perm32(R & 31); voffB = (unsigned)(Rb * Pb.ldbB + C);
      if constexpr (!GATHER) voffA = (unsigned)(R * Pb.ldaB + C); }
    const unsigned r64B = 64u * (unsigned)Pb.ldbB, r64A = GATHER ? 0u : 64u * (unsigned)Pb.ldaB;
    const unsigned kstep = 128u;
    const unsigned hstepB = (unsigned)HALF * Pb.ldbB;
    const unsigned ldsw = (unsigned)wid * 1024u;
    const int aoff = F8 ? (wr * 64 + fr) * 128 + ((fq ^ ((fr >> 1) & 3)) * 32) : lds_byte(wr * 64 + fr, fq * 8);
    const int boff = F8 ? (wc * 32 + fr) * 128 + ((fq ^ ((fr >> 1) & 3)) * 32) : lds_byte(wc * 32 + fr, fq * 8);
    const int aoff8 = aoff + (fq & 1) * 16, boff8 = boff + (fq & 1) * 16;
#define PG8_SA(b, h) (((b) * 2 + (h)) * HTB)
#define PG8_SB(b, h) ((4 + (b) * 2 + (h)) * HTB)
    const __amdgpu_buffer_rsrc_t rsA = __builtin_amdgcn_make_buffer_rsrc((void*)Pb.A, 0, 0x7ffffffe, 0x00020000), rsB = __builtin_amdgcn_make_buffer_rsrc((void*)Pb.Bt, 0, 0x7ffffffe, 0x00020000);
#define PG8_STAGE_B(bufoff, so) do { \
        __builtin_amdgcn_raw_ptr_buffer_load_lds(rsB, (LAS unsigned*)(lds + (bufoff) + ldsw), 16, voffB, (int)(so), 0, 0); \
        __builtin_amdgcn_raw_ptr_buffer_load_lds(rsB, (LAS unsigned*)(lds + (bufoff) + ldsw + 8192), 16, voffB, (int)((so) + r64B), 0, 0); } while (0)
#define PG8_STAGE_A(bufoff, so, h) do { if constexpr (GATHER) { \
        __builtin_amdgcn_raw_ptr_buffer_load_lds(rsA, (LAS unsigned*)(lds + (bufoff) + ldsw), 16, (h) ? ca10 : ca00, (int)(so), 0, 0); \
        __builtin_amdgcn_raw_ptr_buffer_load_lds(rsA, (LAS unsigned*)(lds + (bufoff) + ldsw + 8192), 16, (h) ? ca11 : ca01, (int)(so), 0, 0); } else { \
        __builtin_amdgcn_raw_ptr_buffer_load_lds(rsA, (LAS unsigned*)(lds + (bufoff) + ldsw), 16, voffA, (int)((so) + (h) * 2u * r64A), 0, 0); \
        __builtin_amdgcn_raw_ptr_buffer_load_lds(rsA, (LAS unsigned*)(lds + (bufoff) + ldsw + 8192), 16, voffA, (int)((so) + (h) * 2u * r64A + r64A), 0, 0); } } while (0)
#define PG8_LDA(dst, b, h) do { if constexpr (F8) { _Pragma("unroll") for (int m = 0; m < 4; ++m) { dst[m][0] = *(const LAS bf16x8*)(lds + PG8_SA(b, h) + m * 2048 + aoff8); dst[m][1] = *(const LAS bf16x8*)(lds + PG8_SA(b, h) + m * 2048 + (aoff8 ^ 16)); } } \
        else { _Pragma("unroll") for (int m = 0; m < 4; ++m) _Pragma("unroll") for (int k = 0; k < 2; ++k) dst[m][k] = *(const LAS bf16x8*)(lds + PG8_SA(b, h) + aoff + m * 2048 + k * 1024); } } while (0)
#define PG8_LDB(dst, b, h) do { if constexpr (F8) { _Pragma("unroll") for (int n = 0; n < 2; ++n) { dst[n][0] = *(const LAS bf16x8*)(lds + PG8_SB(b, h) + n * 2048 + boff8); dst[n][1] = *(const LAS bf16x8*)(lds + PG8_SB(b, h) + n * 2048 + (boff8 ^ 16)); } } \
        else { _Pragma("unroll") for (int n = 0; n < 2; ++n) _Pragma("unroll") for (int k = 0; k < 2; ++k) dst[n][k] = *(const LAS bf16x8*)(lds + PG8_SB(b, h) + boff + n * 2048 + k * 1024); } } while (0)
#define PG8_F8FRAG(x) __builtin_shufflevector(__builtin_bit_cast(v4i_t, x[0]), __builtin_bit_cast(v4i_t, x[1]), 0, 1, 2, 3, 4, 5, 6, 7)
#define PG8_MMA(ai, bj, At, Bt) do { __builtin_amdgcn_s_setprio(1); if constexpr (F8) { _Pragma("unroll") for (int m = 0; m < 4; ++m) _Pragma("unroll") for (int n = 0; n < 2; ++n) \
        acc[ai][bj][m][n] = __builtin_amdgcn_mfma_scale_f32_16x16x128_f8f6f4(PG8_F8FRAG(Bt[n]), PG8_F8FRAG(At[m]), acc[ai][bj][m][n], 0, 0, 0, 0x7f7f7f7f, 0, 0x7f7f7f7f); } \
        else { _Pragma("unroll") for (int m = 0; m < 4; ++m) _Pragma("unroll") for (int n = 0; n < 2; ++n) _Pragma("unroll") for (int k = 0; k < 2; ++k) \
        acc[ai][bj][m][n] = __builtin_amdgcn_mfma_f32_16x16x32_bf16(Bt[n][k], At[m][k], acc[ai][bj][m][n], 0, 0, 0); } __builtin_amdgcn_s_setprio(0); } while (0)
#define PG8_WAIT_V(n) asm volatile("s_waitcnt vmcnt(" #n ")" ::: "memory")
#define PG8_WAIT_L(n) asm volatile("s_waitcnt lgkmcnt(" #n ")" ::: "memory")
#define PG8_BAR __builtin_amdgcn_s_barrier()
#define PG8_SCHED __builtin_amdgcn_sched_barrier(0)
    Unit cur, nxt; int ui = 0;
    if (!Pb.next(0, cur)) return;
    const unsigned ktm = (unsigned)nt - 1u;
    unsigned rc = Pb.rot(cur), rn = 0u;
    f32x4 acc[2][2][4][2];
#pragma unroll
    for (int a = 0; a < 2; ++a)
#pragma unroll
        for (int b = 0; b < 2; ++b)
#pragma unroll
            for (int m = 0; m < 4; ++m)
#pragma unroll
                for (int n = 0; n < 2; ++n) acc[a][b][m][n] = (f32x4){0.f, 0.f, 0.f, 0.f};
    bf16x8 At[4][2], B0[2][2], B1[2][2];
    unsigned ca00 = 0, ca01 = 0, ca10 = 0, ca11 = 0;
    unsigned cA, nA;
    if constexpr (GATHER) { Pb.a_fetch(cur, lds, wid); asm volatile("s_waitcnt vmcnt(0)" ::: "memory"); __builtin_amdgcn_s_barrier(); }
    Pb.e_fetch(cur, lds, wid, 0);
    { unsigned o[2][2]; Pb.a_addr(cur, Rr, Cc, o, cA, lds); ca00 = o[0][0]; ca01 = o[0][1]; ca10 = o[1][0]; ca11 = o[1][1]; }
    unsigned cB = Pb.b_base(cur);
    { const unsigned k0 = (rc & ktm) * kstep;
    PG8_STAGE_B(PG8_SB(0, 0), cB + k0); PG8_STAGE_B(PG8_SB(0, 1), cB + k0 + hstepB); PG8_STAGE_A(PG8_SA(0, 0), cA + k0, 0); PG8_STAGE_A(PG8_SA(0, 1), cA + k0, 1);
    if (wr == 1) PG8_BAR;
    PG8_WAIT_V(2); PG8_BAR;
    PG8_STAGE_B(PG8_SB(1, 0), cB + k0 + kstep); PG8_STAGE_A(PG8_SA(1, 0), cA + k0 + kstep, 0); PG8_STAGE_B(PG8_SB(1, 1), cB + k0 + hstepB + kstep); }
    PG8_WAIT_V(6); PG8_BAR;
    for (;;) {
        const bool has_next = Pb.next(ui + 1, nxt);
        unsigned nB;
        if (has_next) { if constexpr (GATHER) Pb.a_fetch(nxt, lds, wid); else { unsigned o[2][2]; Pb.a_addr(nxt, Rr, Cc, o, nA, lds); } nB = Pb.b_base(nxt); rn = Pb.rot(nxt); }
        else { nA = cA; nB = cB; rn = rc; }
        for (int t = 0; t < nt; t += 2) {
            const bool last = (t == nt - 2);
            const unsigned a1 = cA + (((unsigned)(t + 1) + rc) & ktm) * kstep;
            PG8_LDB(B0, 0, 0); PG8_LDB(B1, 0, 1); PG8_SCHED; PG8_LDA(At, 0, 0); PG8_STAGE_A(PG8_SA(1, 1), a1, 1);
            PG8_WAIT_V(8); PG8_WAIT_L(0); PG8_BAR; PG8_MMA(0, 0, At, B0); PG8_MMA(0, 1, At, B1); PG8_BAR; PG8_SCHED;
            const unsigned k2 = last ? (rn & ktm) * kstep : (((unsigned)(t + 2) + rc) & ktm) * kstep;
            const unsigned a2 = (last ? nA : cA) + k2, b2 = (last ? nB : cB) + k2;
            const unsigned a3 = a2 + kstep, b3 = b2 + kstep;
            if constexpr (GATHER) { if (last && has_next) { unsigned o[2][2]; Pb.a_addr(nxt, Rr, Cc, o, nA, lds); ca00 = o[0][0]; ca01 = o[0][1]; ca10 = o[1][0]; ca11 = o[1][1]; } }
            PG8_LDA(At, 0, 1); PG8_STAGE_B(PG8_SB(0, 0), b2); PG8_STAGE_B(PG8_SB(0, 1), b2 + hstepB); PG8_STAGE_A(PG8_SA(0, 0), a2, 0);
            PG8_WAIT_V(8); PG8_WAIT_L(0); PG8_BAR; PG8_MMA(1, 0, At, B0); PG8_MMA(1, 1, At, B1); PG8_BAR; PG8_SCHED;
            PG8_LDB(B0, 1, 0); PG8_LDB(B1, 1, 1); PG8_SCHED; PG8_LDA(At, 1, 0); PG8_STAGE_A(PG8_SA(0, 1), a2, 1);
            PG8_WAIT_V(8); PG8_WAIT_L(0); PG8_BAR; PG8_MMA(0, 0, At, B0); PG8_MMA(0, 1, At, B1); PG8_BAR; PG8_SCHED;
            PG8_LDA(At, 1, 1); PG8_STAGE_B(PG8_SB(1, 0), b3); PG8_STAGE_B(PG8_SB(1, 1), b3 + hstepB); PG8_STAGE_A(PG8_SA(1, 0), a3, 0);
            PG8_WAIT_V(8); PG8_WAIT_L(0); PG8_BAR; PG8_MMA(1, 0, At, B0); PG8_MMA(1, 1, At, B1); PG8_BAR; PG8_SCHED;
        }
        if constexpr (ALIGN_EPI) { if (wr == 0) PG8_BAR; }
        { int tl = tid; asm volatile("" : "+v"(tl));
          const int ln = tl & 63; Pb.epi(acc, cur, wr, wc, ln & 15, ln >> 4, lds + (ui & 1) * 3072); }
        if (!has_next) break;
#pragma unroll
        for (int a = 0; a < 2; ++a)
#pragma unroll
            for (int b = 0; b < 2; ++b)
#pragma unroll
                for (int m = 0; m < 4; ++m)
#pragma unroll
                    for (int n = 0; n < 2; ++n) acc[a][b][m][n] = (f32x4){0.f, 0.f, 0.f, 0.f};
        _Pragma("unroll") for (int a = 0; a < 2; ++a) _Pragma("unroll") for (int b = 0; b < 2; ++b) _Pragma("unroll") for (int m = 0; m < 4; ++m) asm volatile("" : "+v"(acc[a][b][m][0]), "+v"(acc[a][b][m][1]));
        cur = nxt; cA = nA; cB = nB; rc = rn; ++ui;
        Pb.e_fetch(cur, lds, wid, ui & 1);
        if constexpr (ALIGN_EPI) { if (wr == 1) PG8_BAR; }
    }
    PG8_WAIT_V(0);
    if constexpr (!ALIGN_EPI) { if (wr == 0) PG8_BAR; }
    PG8_BAR;
#undef PG8_SA
#undef PG8_SB
#undef PG8_STAGE_A
#undef PG8_STAGE_B
#undef PG8_LDA
#undef PG8_LDB
#undef PG8_MMA
#undef PG8_F8FRAG
#undef PG8_WAIT_V
#undef PG8_WAIT_L
#undef PG8_BAR
#undef PG8_SCHED
}
}
namespace pg8 {
#define PG8_EPI_LOOP for (int ai = 0; ai < 2; ++ai) _Pragma("unroll") for (int m = 0; m < 4; ++m) _Pragma("unroll") for (int bj = 0; bj < 2; ++bj)
__device__ __forceinline__ void rope4(const float* rope, int pos, int i0, f32x4& a, f32x4& b) {
    const f32x4 c = *(const f32x4*)(rope + pos * 32 + i0), s = *(const f32x4*)(rope + LSEQ * 32 + pos * 32 + i0);
    const f32x4 r0 = {a[0] * c[0] - a[1] * s[0], a[1] * c[0] + a[0] * s[0], a[2] * c[1] - a[3] * s[1], a[3] * c[1] + a[2] * s[1]};
    const f32x4 r1 = {b[0] * c[2] - b[1] * s[2], b[1] * c[2] + b[0] * s[2], b[2] * c[3] - b[3] * s[3], b[3] * c[3] + b[2] * s[3]};
    a = r0; b = r1;
}
__device__ __forceinline__ float clamp448(float v) { return __builtin_amdgcn_fmed3f(v, -448.0f, 448.0f); }
__device__ __forceinline__ unsigned pack4_f8(float a, float b, float c, float d) { int w = 0; w = __builtin_amdgcn_cvt_pk_fp8_f32(clamp448(a), clamp448(b), w, false); w = __builtin_amdgcn_cvt_pk_fp8_f32(clamp448(c), clamp448(d), w, true); return (unsigned)w; }
__device__ __forceinline__ unsigned long long pack8_f8(const f32x4& a, const f32x4& b) { return (unsigned long long)pack4_f8(a[0], a[1], a[2], a[3]) | ((unsigned long long)pack4_f8(b[0], b[1], b[2], b[3]) << 32); }
struct DenseBase {
    static constexpr bool F8 = false, GATHER = false; static constexpr int scaleA = 0, scaleB = 0;
    const char* A; const char* Bt; int K, lda, ldb, ldaB, ldbB; Order2D ord;
    __device__ __forceinline__ bool next(int i, Unit& u) const { return ord.next(i, u); }
    __device__ __forceinline__ unsigned rot(const Unit&) const { return 0u; }
    __device__ __forceinline__ void e_fetch(const Unit&, LAS unsigned char*, int, int) const {}
    __device__ __forceinline__ void a_addr(const Unit& u, const int (&Rr)[2], const int (&Cc)[2], unsigned (&o)[2][2], unsigned& base, LAS unsigned char*) const {
        base = (unsigned)u.pm * 256u * (unsigned)lda * 2u;
#pragma unroll
        for (int h = 0; h < 2; ++h)
#pragma unroll
            for (int i = 0; i < 2; ++i) o[h][i] = (unsigned)((h * 128 + Rr[i]) * lda * 2 + Cc[i]);
    }
    __device__ __forceinline__ unsigned b_base(const Unit& u) const { return (unsigned)u.pn * 256u * (unsigned)ldb * 2u; }
};
struct ProbP1 : DenseBase {
    bf16_t* proj; bf16_t* kr; const float* rope; float* ssqp;
    __device__ __forceinline__ void epi(const f32x4 (&acc)[2][2][4][2], const Unit& u, int wr, int wc, int fr, int fq, LAS unsigned char*) const {
        float ssq_acc[2][4];
#pragma unroll
        for (int a = 0; a < 2; ++a)
#pragma unroll
            for (int b = 0; b < 4; ++b) ssq_acc[a][b] = 0.f;
#pragma unroll
        PG8_EPI_LOOP {
            const int row = u.pm * 256 + ai * 128 + wr * 64 + m * 16 + fr, col = u.pn * 256 + bj * 128 + wc * 32 + fq * 8;
            f32x4 v0 = acc[ai][bj][m][0], v1 = acc[ai][bj][m][1];
            if (u.pn >= 4 && u.pn < 7) { const float q = (v0[0] * v0[0] + v0[1] * v0[1]) + (v0[2] * v0[2] + v0[3] * v0[3]) + (v1[0] * v1[0] + v1[1] * v1[1]) + (v1[2] * v1[2] + v1[3] * v1[3]);
                ssq_acc[ai][m] += q; }
            if (col < 1792) { *(u32x4*)(proj + (size_t)row * DM + col) = pack8(v0, v1); }
            else if (col < INW) { const int pos = (row % LP) - PADR;
                if (pos >= 0) rope4(rope, pos, (col - 1792) >> 1, v0, v1); else { v0 = (f32x4){0.f, 0.f, 0.f, 0.f}; v1 = v0; }
                *(u32x4*)(kr + (size_t)row * 64 + (col - 1792)) = pack8(v0, v1); }
        }
        if (u.pn >= 4 && u.pn < 7) {
            const int slot = u.pn < 6 ? (u.pn - 4) * 4 + wc : 8 + wc;
#pragma unroll
            for (int ai = 0; ai < 2; ++ai)
#pragma unroll
                for (int m = 0; m < 4; ++m) { float q = ssq_acc[ai][m]; q += __shfl_xor(q, 16); q += __shfl_xor(q, 32);
                    if (fq == 0) ssqp[(size_t)(u.pm * 256 + ai * 128 + wr * 64 + m * 16 + fr) * 12 + slot] = q; }
        }
    }
};
struct ProbP2q : DenseBase {
    bf16_t* qb; const float* rsq; const float* rope;
    __device__ __forceinline__ void epi(const f32x4 (&acc)[2][2][4][2], const Unit& u, int wr, int wc, int fr, int fq, LAS unsigned char*) const {
        float rsv[2][4];
#pragma unroll
        for (int ai = 0; ai < 2; ++ai)
#pragma unroll
            for (int m = 0; m < 4; ++m) { const float* pp = rsq + (size_t)(u.pm * 256 + ai * 128 + wr * 64 + m * 16 + fr) * 12; const f32x4 a = *(const f32x4*)pp, b = *(const f32x4*)(pp + 4);
                rsv[ai][m] = C2 / sqrtf(((a[0] + a[1]) + (a[2] + a[3]) + (b[0] + b[1]) + (b[2] + b[3])) * (1.0f / QLORA) + EPS); }
#pragma unroll
        PG8_EPI_LOOP {
            const int row = u.pm * 256 + ai * 128 + wr * 64 + m * 16 + fr, col = u.pn * 256 + bj * 128 + wc * 32 + fq * 8;
            const float s = rsv[ai][m]; f32x4 v0 = acc[ai][bj][m][0] * s, v1 = acc[ai][bj][m][1] * s;
            const int dd = col % QKD;
            if (dd >= QKNOPE) { const int pos = (row % LP) - PADR; if (pos >= 0) rope4(rope, pos, (dd - QKNOPE) >> 1, v0, v1); else { v0 = (f32x4){0.f, 0.f, 0.f, 0.f}; v1 = v0; } }
            *(u32x4*)(qb + (size_t)row * 1536 + col) = pack8(v0, v1);
        }
    }
};
struct ProbP2kv : DenseBase {
    bf16_t* kn; bf16_t* vb; const float* rskv;
    __device__ __forceinline__ void epi(const f32x4 (&acc)[2][2][4][2], const Unit& u, int wr, int wc, int fr, int fq, LAS unsigned char*) const {
#pragma unroll
        PG8_EPI_LOOP {
            const int row = u.pm * 256 + ai * 128 + wr * 64 + m * 16 + fr, c = wc * 32 + fq * 8;
            const f32x4 pk = *(const f32x4*)(rskv + (size_t)row * 12 + 8); const float s = 1.0f / sqrtf(((pk[0] + pk[1]) + (pk[2] + pk[3])) * (1.0f / KVLORA) + EPS); const f32x4 v0 = acc[ai][bj][m][0] * s, v1 = acc[ai][bj][m][1] * s;
            bf16_t* dst = (bj == 0 ? kn : vb) + (size_t)row * 1024 + u.pn * 128 + c;
            *(u32x4*)dst = pack8(v0, v1);
        }
    }
};
struct ProbPool : DenseBase {
    bf16_t* mix; const float* pscale;
    __device__ __forceinline__ void a_addr(const Unit& u, const int (&Rr)[2], const int (&Cc)[2], unsigned (&o)[2][2], unsigned& base, LAS unsigned char*) const {
        base = ((unsigned)u.pm * 256u * (unsigned)lda + (unsigned)u.pn * 256u) * 2u;
#pragma unroll
        for (int h = 0; h < 2; ++h)
#pragma unroll
            for (int i = 0; i < 2; ++i) o[h][i] = (unsigned)((h * 128 + Rr[i]) * lda * 2 + Cc[i]);
    }
    __device__ __forceinline__ unsigned b_base(const Unit& u) const { return (unsigned)u.pn * 65536u * 2u; }
    __device__ __forceinline__ void epi(const f32x4 (&acc)[2][2][4][2], const Unit& u, int wr, int wc, int fr, int fq, LAS unsigned char*) const {
#pragma unroll
        PG8_EPI_LOOP {
            const int row = u.pm * 256 + ai * 128 + wr * 64 + m * 16 + fr, c = u.pn * 256 + bj * 128 + wc * 32 + fq * 8;
            const f32x4 p0 = *(const f32x4*)(pscale + c), p1 = *(const f32x4*)(pscale + c + 4);
            *(u32x4*)(mix + (size_t)row * DM + c) = pack8(acc[ai][bj][m][0] * p0, acc[ai][bj][m][1] * p1);
        }
    }
};
struct ProbP4 : DenseBase {
    const float* x; float* h2; unsigned char* h2f8;
    __device__ __forceinline__ void a_addr(const Unit& u, const int (&Rr)[2], const int (&Cc)[2], unsigned (&o)[2][2], unsigned& base, LAS unsigned char*) const {
        base = (unsigned)((u.pm >> 3) * LP + 64 + (u.pm & 7) * 256) * (unsigned)lda * 2u;
#pragma unroll
        for (int h = 0; h < 2; ++h)
#pragma unroll
            for (int i = 0; i < 2; ++i) o[h][i] = (unsigned)((h * 128 + Rr[i]) * lda * 2 + Cc[i]);
    }
    __device__ __forceinline__ void epi(const f32x4 (&acc)[2][2][4][2], const Unit& u, int wr, int wc, int fr, int fq, LAS unsigned char*) const {
#pragma unroll
        PG8_EPI_LOOP {
            const int r = u.pm * 256 + ai * 128 + wr * 64 + m * 16 + fr, c = u.pn * 256 + bj * 128 + wc * 32 + fq * 8;
            const size_t off = (size_t)r * DM + c;
            const f32x4 o0 = *(const f32x4*)(x + off) + acc[ai][bj][m][0], o1 = *(const f32x4*)(x + off + 4) + acc[ai][bj][m][1];
            *(f32x4*)(h2 + off) = o0; *(f32x4*)(h2 + off + 4) = o1; *(unsigned long long*)(h2f8 + off) = pack8_f8(o0, o1);
        }
    }
};
}
namespace pg8 {
constexpr int TB_CNT = 64, TB_TE = 128, TB_TM = 416, TB_LIST = 768, TB_E0 = 1024, TB_E1 = 1280, TB_E2 = 1536;
__device__ __forceinline__ void moe_table(LAS unsigned char* lds, const unsigned* cnt, const int tid) {
    LAS int* tab = (LAS int*)(lds + TAB_OFF);
    __syncthreads();
    if (tid < NE) tab[TB_CNT + tid] = (int)__hip_atomic_load(cnt + tid, RLX_AGENT);
    __syncthreads();
    if (tid == 0) { int s = 0; for (int e = 0; e < NE; ++e) { tab[e] = s; s += (tab[TB_CNT + e] + 255) >> 8; } tab[NE] = s; }
    __syncthreads();
    if (tid < 288) { int e = 0; for (; e < NE - 1; ++e) if (tid < tab[e + 1]) break; tab[TB_TE + tid] = e; tab[TB_TM + tid] = tid - tab[e]; }
    __syncthreads();
}
#ifndef MOE_BT
#define MOE_BT 8
#endif
template <int NTN> struct MoeOrder {
    const LAS int* tab; int G, c, i0, i1;
    __device__ __forceinline__ bool next(int i_, Unit& u) const {
        const int i = i0 + i_; if (i >= i1) return false;
        const int cpx = G >> 3; const int F = (G & 7) ? i * G + c : (i * 8 + (c & 7)) * cpx + (c >> 3);
        const int ntile = __builtin_amdgcn_readfirstlane(tab[NE]); if (F >= ntile * NTN) return false;
        constexpr int BT = MOE_BT, PG = 32 / BT;
        const int blk = F / (BT * NTN), r = F - blk * (BT * NTN), nb = (ntile - blk * BT) < BT ? (ntile - blk * BT) : BT;
        int png, rr; if (nb == BT) { png = r / 32; rr = r & 31; } else { const int gs = nb * PG; png = r / gs; rr = r - png * gs; }
        const int T = blk * BT + rr / PG;
        u.aux = __builtin_amdgcn_readfirstlane(tab[TB_TE + T]); u.pm = __builtin_amdgcn_readfirstlane(tab[TB_TM + T]); u.pn = png * PG + (rr % PG); return true;
    }
};
constexpr int W_SCALE_LOG2 = 5, ACT_SCALE_LOG2 = 2;
struct ProbP6 {
    static constexpr bool F8 = true, GATHER = true; static constexpr int ldaB = DM; static constexpr int scaleB = 0x01010101 * (127 - W_SCALE_LOG2), scaleA = 0x7f7f7f7f;
    const char* A; const char* Bt; int K, ldbB; MoeOrder<16> ord;
    const int* list; const float* rsl; const float* b1; unsigned char* act;
    __device__ __forceinline__ bool next(int i, Unit& u) const { return ord.next(i, u); }
    __device__ __forceinline__ unsigned rot(const Unit& u) const { return 0u; }
    __device__ __forceinline__ void a_fetch(const Unit& u, LAS unsigned char* lds, int wid) const {
        if (wid == 0) { const __amdgpu_buffer_rsrc_t rl = __builtin_amdgcn_make_buffer_rsrc((void*)list, 0, 0x7ffffffe, 0x00020000);
            __builtin_amdgcn_raw_ptr_buffer_load_lds(rl, (LAS unsigned*)(lds + TAB_OFF + TB_LIST * 4), 16, (threadIdx.x & 63) * 16, (int)(((unsigned)u.aux * (unsigned)MR + (unsigned)u.pm * 256u) * 4u), 0, 0); }
    }
    __device__ __forceinline__ void a_addr(const Unit& u, const int (&Rr)[2], const int (&Cc)[2], unsigned (&o)[2][2], unsigned& base, LAS unsigned char* lds) const {
        base = 0u; const int cnt_e = __builtin_amdgcn_readfirstlane(ord.tab[TB_CNT + u.aux]); const LAS int* lb = (const LAS int*)(lds + TAB_OFF) + TB_LIST; const int lastv = cnt_e - 1 - u.pm * 256;
#pragma unroll
        for (int h = 0; h < 2; ++h)
#pragma unroll
            for (int i = 0; i < 2; ++i) { int sl = h * 128 + Rr[i]; sl = sl < lastv ? sl : lastv; const int tok = lb[sl] >> 2; o[h][i] = (unsigned)tok * (unsigned)DM + (unsigned)Cc[i]; }
    }
    __device__ __forceinline__ void e_fetch(const Unit& u, LAS unsigned char* lds, int wid, int par) const {
        lds += par * 3072;
        if (wid == 1) { const __amdgpu_buffer_rsrc_t r = __builtin_amdgcn_make_buffer_rsrc((void*)rsl, 0, 0x7ffffffe, 0x00020000);
            __builtin_amdgcn_raw_ptr_buffer_load_lds(r, (LAS unsigned*)(lds + TAB_OFF + TB_E0 * 4), 16, (threadIdx.x & 63) * 16, (int)(((unsigned)u.aux * (unsigned)MR + (unsigned)u.pm * 256u) * 4u), 0, 0); }
        if (wid == 2) { const __amdgpu_buffer_rsrc_t r = __builtin_amdgcn_make_buffer_rsrc((void*)b1, 0, 0x7ffffffe, 0x00020000);
            __builtin_amdgcn_raw_ptr_buffer_load_lds(r, (LAS unsigned*)(lds + TAB_OFF + TB_E1 * 4), 16, (threadIdx.x & 63) * 16, (int)(((unsigned)u.aux * 4096u + (unsigned)u.pn * 256u) * 4u), 0, 0); }
    }
    __device__ __forceinline__ unsigned b_base(const Unit& u) const { return ((unsigned)u.aux * 4096u + (unsigned)u.pn * 256u) * (unsigned)DM; }
    __device__ __forceinline__ void epi(const f32x4 (&acc)[2][2][4][2], const Unit& u, int wr, int wc, int fr, int fq, LAS unsigned char* lds) const {
        const LAS float* rsb = (const LAS float*)(lds + TAB_OFF) + TB_E0; const LAS float* bb1 = (const LAS float*)(lds + TAB_OFF) + TB_E1;
        typedef float f32x2 __attribute__((ext_vector_type(2)));
        const int cnt_e = __builtin_amdgcn_readfirstlane(ord.tab[TB_CNT + u.aux]), rbase = __builtin_amdgcn_readfirstlane(ord.tab[u.aux]) * 256;
        f32x4 bg[2], bl[2];
#pragma unroll
        for (int bj = 0; bj < 2; ++bj) { const LAS float* bp = bb1 + bj * 128 + wc * 32 + fq * 8; const f32x4 x0 = *(const LAS f32x4*)bp, x1 = *(const LAS f32x4*)(bp + 4);
            bg[bj] = (f32x4){x0[0], x0[2], x1[0], x1[2]}; bl[bj] = (f32x4){x0[1], x0[3], x1[1], x1[3]}; }
        constexpr float AS = (float)(1 << ACT_SCALE_LOG2), NC = -1.702f * 1.4426950408889634f;
#pragma unroll
        for (int ai = 0; ai < 2; ++ai)
#pragma unroll
            for (int m = 0; m < 4; ++m) {
                const int slot = u.pm * 256 + ai * 128 + wr * 64 + m * 16 + fr; const bool valid = slot < cnt_e;
                const float rs = valid ? rsb[ai * 128 + wr * 64 + m * 16 + fr] * (1.0f / (float)(1 << W_SCALE_LOG2)) : 0.f;
#pragma unroll
                for (int bj = 0; bj < 2; ++bj) {
                    const f32x4 a0 = acc[ai][bj][m][0], a1 = acc[ai][bj][m][1];
                    f32x4 g = (f32x4){a0[0], a0[2], a1[0], a1[2]} * rs + bg[bj], l = (f32x4){a0[1], a0[3], a1[1], a1[3]} * rs + bl[bj];
#pragma unroll
                    for (int q = 0; q < 4; ++q) { g[q] = fminf(g[q], 7.0f); l[q] = __builtin_amdgcn_fmed3f(l[q], -7.0f, 7.0f); }
                    f32x4 e = g * NC, lp = l * AS + AS;
#pragma unroll
                    for (int q = 0; q < 4; ++q) e[q] = __builtin_amdgcn_rcpf(1.0f + __builtin_amdgcn_exp2f(e[q]));
                    const f32x4 o = (g * e) * lp;
                    if (valid) { int w = 0; w = __builtin_amdgcn_cvt_pk_fp8_f32(o[0], o[1], w, false); w = __builtin_amdgcn_cvt_pk_fp8_f32(o[2], o[3], w, true);
                        *(unsigned*)(act + (size_t)(rbase + slot) * DFF + u.pn * 128 + bj * 64 + wc * 16 + fq * 4) = (unsigned)w; }
                }
            }
    }
};
struct ProbP7 {
    static constexpr bool F8 = true, GATHER = false; static constexpr int ldaB = DFF; static constexpr int scaleB = 0x01010101 * (127 - W_SCALE_LOG2), scaleA = 0x01010101 * (127 - ACT_SCALE_LOG2);
    const char* A; const char* Bt; int K, ldbB; MoeOrder<8> ord;
    const int* list; const float* gate; const float* b2; bf16_t* yb;
    __device__ __forceinline__ bool next(int i, Unit& u) const { return ord.next(i, u); }
    __device__ __forceinline__ unsigned rot(const Unit& u) const { return 0u; }
    __device__ __forceinline__ void a_addr(const Unit& u, const int (&Rr)[2], const int (&Cc)[2], unsigned (&o)[2][2], unsigned& base, LAS unsigned char*) const {
        base = (unsigned)(__builtin_amdgcn_readfirstlane(ord.tab[u.aux]) + u.pm) * 256u * (unsigned)DFF;
#pragma unroll
        for (int h = 0; h < 2; ++h)
#pragma unroll
            for (int i = 0; i < 2; ++i) o[h][i] = (unsigned)((h * 128 + Rr[i]) * DFF + Cc[i]);
    }
    __device__ __forceinline__ void e_fetch(const Unit& u, LAS unsigned char* lds, int wid, int par) const {
        lds += par * 3072;
        const int so = (int)(((unsigned)u.aux * (unsigned)MR + (unsigned)u.pm * 256u) * 4u);
        if (wid == 1) { const __amdgpu_buffer_rsrc_t r = __builtin_amdgcn_make_buffer_rsrc((void*)gate, 0, 0x7ffffffe, 0x00020000);
            __builtin_amdgcn_raw_ptr_buffer_load_lds(r, (LAS unsigned*)(lds + TAB_OFF + TB_E0 * 4), 16, (threadIdx.x & 63) * 16, so, 0, 0); }
        if (wid == 2) { const __amdgpu_buffer_rsrc_t r = __builtin_amdgcn_make_buffer_rsrc((void*)b2, 0, 0x7ffffffe, 0x00020000);
            __builtin_amdgcn_raw_ptr_buffer_load_lds(r, (LAS unsigned*)(lds + TAB_OFF + TB_E1 * 4), 16, (threadIdx.x & 63) * 16, (int)(((unsigned)u.aux * (unsigned)DM + (unsigned)u.pn * 256u) * 4u), 0, 0); }
        if (wid == 3) { const __amdgpu_buffer_rsrc_t r = __builtin_amdgcn_make_buffer_rsrc((void*)list, 0, 0x7ffffffe, 0x00020000);
            __builtin_amdgcn_raw_ptr_buffer_load_lds(r, (LAS unsigned*)(lds + TAB_OFF + TB_E2 * 4), 16, (threadIdx.x & 63) * 16, so, 0, 0); }
    }
    __device__ __forceinline__ unsigned b_base(const Unit& u) const { return ((unsigned)u.aux * (unsigned)DM + (unsigned)u.pn * 256u) * (unsigned)DFF; }
    __device__ __forceinline__ void epi(const f32x4 (&acc)[2][2][4][2], const Unit& u, int wr, int wc, int fr, int fq, LAS unsigned char* lds) const {
        const int cnt_e = __builtin_amdgcn_readfirstlane(ord.tab[TB_CNT + u.aux]);
        const LAS float* gtb = (const LAS float*)(lds + TAB_OFF) + TB_E0; const LAS float* bb2 = (const LAS float*)(lds + TAB_OFF) + TB_E1; const LAS int* idb = (const LAS int*)(lds + TAB_OFF) + TB_E2;
        const int col = u.pn * 256 + wc * 32 + fq * 8;
        f32x4 bb[2][2];
#pragma unroll
        for (int bj = 0; bj < 2; ++bj) { const LAS float* bp = bb2 + bj * 128 + wc * 32 + fq * 8; bb[bj][0] = *(const LAS f32x4*)bp; bb[bj][1] = *(const LAS f32x4*)(bp + 4); }
#pragma unroll
        for (int ai = 0; ai < 2; ++ai)
#pragma unroll
            for (int m = 0; m < 4; ++m) {
                const int rl = ai * 128 + wr * 64 + m * 16 + fr, slot = u.pm * 256 + rl; const bool valid = slot < cnt_e;
                const int id = valid ? idb[rl] : 0; const float g = valid ? gtb[rl] : 0.f, gs = g * (1.0f / (float)(1 << (W_SCALE_LOG2 + ACT_SCALE_LOG2)));
                bf16_t* orow = yb + (size_t)id * DM + col;
#pragma unroll
                for (int bj = 0; bj < 2; ++bj) {
                    const f32x4 y0 = acc[ai][bj][m][0] * gs + bb[bj][0] * g, y1 = acc[ai][bj][m][1] * gs + bb[bj][1] * g;
                    if (valid) *(u32x4*)(orow + bj * 128) = pack8(y0, y1);
                }
            }
    }
};
}
namespace att {
using f32x16 = __attribute__((ext_vector_type(16))) float;
using s16x4 = __attribute__((ext_vector_type(4))) short;
constexpr int SHM_V = 16384, SHM_KN = 16384, SHM_KR = 8192, SHM_BUF = SHM_V + SHM_KN + SHM_KR, NBUF = 3, WS_OFF = NBUF * SHM_BUF;
#define ATT_SBAR() __builtin_amdgcn_sched_barrier(0)
__device__ __forceinline__ int crow(int r, int hi) { return (r & 3) + 8 * (r >> 2) + 4 * hi; }
__device__ __forceinline__ unsigned cvtpk(float lo, float hi) { unsigned r; asm volatile("v_cvt_pk_bf16_f32 %0, %1, %2" : "=v"(r) : "v"(lo), "v"(hi)); return r; }
__device__ __forceinline__ int v_st(int k, int c) { const int kk = (k & ~0xC) | ((k & 4) << 1) | ((k & 8) >> 1); return ((kk >> 3) * 4 + (c >> 5)) * 512 + ((kk & 7) * 32 + (c & 31)) * 2; }
__device__ __forceinline__ int v_rd_base(int lane) { return ((lane & 3) << 3) | (((lane >> 2) & 3) << 6) | (((lane >> 4) & 1) << 5) | (((lane >> 5) & 1) << 8); }
constexpr int v_rd_off(int d0, int ks, int half) { return d0 * 512 + ks * 4096 + half * 2048; }
template <int OFF> __device__ __forceinline__ s16x4 tr_read(int vb) { s16x4 r; asm volatile("ds_read_b64_tr_b16 %0, %1 offset:%2" : "=&v"(r) : "v"(vb), "i"(OFF) : "memory"); return r; }
template <int D0> __device__ __forceinline__ void pv_one(f32x16& od, int vb, bf16x8 pa0, bf16x8 pa1, bf16x8 pa2, bf16x8 pa3) {
    const s16x4 l0 = tr_read<v_rd_off(D0, 0, 0)>(vb), h0 = tr_read<v_rd_off(D0, 0, 1)>(vb), l1 = tr_read<v_rd_off(D0, 1, 0)>(vb), h1 = tr_read<v_rd_off(D0, 1, 1)>(vb);
    const s16x4 l2 = tr_read<v_rd_off(D0, 2, 0)>(vb), h2 = tr_read<v_rd_off(D0, 2, 1)>(vb), l3 = tr_read<v_rd_off(D0, 3, 0)>(vb), h3 = tr_read<v_rd_off(D0, 3, 1)>(vb);
    asm volatile("s_waitcnt lgkmcnt(0)" ::: "memory"); ATT_SBAR();
#define ATT_PK(L, H) (bf16x8){L[0], L[1], L[2], L[3], H[0], H[1], H[2], H[3]}
    od = __builtin_amdgcn_mfma_f32_32x32x16_bf16(pa0, ATT_PK(l0, h0), od, 0, 0, 0);
    od = __builtin_amdgcn_mfma_f32_32x32x16_bf16(pa1, ATT_PK(l1, h1), od, 0, 0, 0);
    od = __builtin_amdgcn_mfma_f32_32x32x16_bf16(pa2, ATT_PK(l2, h2), od, 0, 0, 0);
    od = __builtin_amdgcn_mfma_f32_32x32x16_bf16(pa3, ATT_PK(l3, h3), od, 0, 0, 0);
#undef ATT_PK
}
template <int D0, int HK> __device__ __forceinline__ void pv_half(f32x16& od, int vb, bf16x8 pa0, bf16x8 pa1) {
    const s16x4 l0 = tr_read<v_rd_off(D0, 2 * HK, 0)>(vb), h0 = tr_read<v_rd_off(D0, 2 * HK, 1)>(vb), l1 = tr_read<v_rd_off(D0, 2 * HK + 1, 0)>(vb), h1 = tr_read<v_rd_off(D0, 2 * HK + 1, 1)>(vb);
    asm volatile("s_waitcnt lgkmcnt(0)" ::: "memory"); ATT_SBAR();
#define ATT_PK(L, H) (bf16x8){L[0], L[1], L[2], L[3], H[0], H[1], H[2], H[3]}
    od = __builtin_amdgcn_mfma_f32_32x32x16_bf16(pa0, ATT_PK(l0, h0), od, 0, 0, 0);
    od = __builtin_amdgcn_mfma_f32_32x32x16_bf16(pa1, ATT_PK(l1, h1), od, 0, 0, 0);
#undef ATT_PK
}
__device__ __forceinline__ void attn_unit(int b, int h, int u, const bf16_t* __restrict__ QB, const bf16_t* __restrict__ KN, const bf16_t* __restrict__ KR, const bf16_t* __restrict__ VB,
                                          bf16_t* __restrict__ MIX, LAS char* lds, const int tid) {
    const int wid = tid >> 6, lane = tid & 63, r32 = lane & 31, hi = lane >> 5;
    const int qc = (0x22331100u >> (4 * wid)) & 3, half = wid & 1;
    const int c0 = 4 * u - 3, ntw = c0 + qc + 1, ntmax = 4 * u + 1;
    const size_t rowb = (size_t)b * LP;
    const int qrow0 = 64 * (c0 + qc) + 32 * half;
    LAS float* wsf = (LAS float*)(lds + WS_OFF) + wid * 64; LAS float* li_l = wsf; LAS float* al_l = wsf + 32;
    bf16x8 qr[12];
    { const bf16_t* Qw = QB + (rowb + qrow0 + r32) * 1536 + h * QKD + hi * 8;
#pragma unroll
      for (int d0 = 0; d0 < 12; ++d0) qr[d0] = *(const bf16x8*)(Qw + d0 * 16); }
    unsigned gk0, gv0, gr;
    { const int w = wid;
      { const int row = 32 * (w & 1) + (lane >> 1), hh = (lane & 1) ^ ((row >> 3) & 1);
        gk0 = (unsigned)(row * 1024 + h * 128 + (w >> 1) * 16 + hh * 8); gr = (unsigned)(row * 64 + (w >> 1) * 16 + hh * 8); }
      { const int st = 4 * w + (lane >> 5), kk = (st >> 2) * 8 + ((lane >> 2) & 7), k = (kk & ~0xC) | ((kk & 4) << 1) | ((kk & 8) >> 1), c = (st & 3) * 32 + (lane & 3) * 8; gv0 = (unsigned)(k * 1024 + h * 128 + c); } }
    const bf16_t* KNb = KN + rowb * 1024; const bf16_t* VBb = VB + rowb * 1024; const bf16_t* KRb = KR + rowb * 64;
    const unsigned wq = (unsigned)wid * 2048u, wk = (unsigned)wid * 1024u;
    const int kb0 = (int)(uintptr_t)lds + SHM_V + r32 * 32 + ((hi ^ ((r32 >> 3) & 1)) << 4);
    const int vb0 = (int)(uintptr_t)lds + v_rd_base(lane);
#define ATT_DMA(gp, lp) __builtin_amdgcn_global_load_lds((const unsigned*)(gp), (LAS unsigned*)(lp), 16, 0, 0)
#define ATT_STAGE(j_, bf_) do { LAS char* bb_ = lds + (bf_) * SHM_BUF; const size_t ko_ = (size_t)(j_) * 64; \
    ATT_DMA(KNb + ko_ * 1024 + gk0, bb_ + SHM_V + wk); ATT_DMA(KNb + ko_ * 1024 + gk0 + 64, bb_ + SHM_V + 8192 + wk); \
    ATT_DMA(VBb + ko_ * 1024 + gv0, bb_ + wq); ATT_DMA(VBb + ko_ * 1024 + gv0 + 64, bb_ + wq + 1024); ATT_DMA(KRb + ko_ * 64 + gr, bb_ + SHM_V + 16384 + wk); } while (0)
#define ATT_WAIT_BAR(N) asm volatile("s_waitcnt vmcnt(" #N ") lgkmcnt(0)\n\ts_barrier" ::: "memory")
    float m_reg = -1e30f, l_reg = 0.f; f32x16 o[4];
#pragma unroll
    for (int d = 0; d < 4; ++d)
#pragma unroll
        for (int r = 0; r < 16; ++r) o[d][r] = 0.f;
    ATT_STAGE(0, 0); if (ntmax > 1) { ATT_STAGE(1, 1); ATT_WAIT_BAR(5); } else { ATT_WAIT_BAR(0); }
    int bf = 0;
    for (int j = 0; j < ntmax; ++j) {
        const int bf2 = bf == 0 ? 2 : bf - 1;
        const bool st2 = j + 2 < ntmax;
        if (st2) ATT_STAGE(j + 2, bf2);
        if (j < ntw) {
            const int vb = vb0 + bf * SHM_BUF, kb = kb0 + bf * SHM_BUF;
#pragma unroll
            for (int hk = 0; hk < 2; ++hk) {
                if (j == 0 && hk == 0) continue;
                f32x16 p0;
#pragma unroll
                for (int r = 0; r < 16; ++r) p0[r] = 0.f;
#pragma unroll
                for (int d0 = 0; d0 < 12; ++d0) {
                    const bf16x8 b0 = *(const LAS bf16x8*)(uintptr_t)(unsigned)(kb + d0 * 2048 + hk * 1024);
                    p0 = __builtin_amdgcn_mfma_f32_32x32x16_bf16(b0, qr[d0], p0, 0, 0, 0); }
                if (j == 0) {
#pragma unroll
                    for (int r = 0; r < 8; ++r) p0[r] = -1e30f;
                }
                float pmax = p0[0];
#pragma unroll
                for (int r = 1; r < 16; ++r) pmax = fmaxf(pmax, p0[r]);
                { auto sw = __builtin_amdgcn_permlane32_swap(__float_as_uint(pmax), __float_as_uint(pmax), false, false); pmax = fmaxf(__uint_as_float(sw[0]), __uint_as_float(sw[1])); }
                float mn, alpha;
                if (__all(pmax - m_reg <= 8.0f)) { mn = m_reg; alpha = 1.f; }
                else { mn = fmaxf(m_reg, pmax); alpha = __builtin_amdgcn_exp2f(m_reg - mn); m_reg = mn; }
                float ps = 0.f;
#pragma unroll
                for (int r = 0; r < 16; ++r) { p0[r] = __builtin_amdgcn_exp2f(p0[r] - mn); ps += p0[r]; }
                { auto sw = __builtin_amdgcn_permlane32_swap(__float_as_uint(ps), __float_as_uint(ps), false, false); ps = __uint_as_float(sw[0]) + __uint_as_float(sw[1]); }
                l_reg = l_reg * alpha + ps;
                bf16x8 pa0, pa1;
#define ATT_PK4(Pv, BASE, OUT) do { unsigned a0 = cvtpk(Pv[BASE + 0], Pv[BASE + 1]), a1 = cvtpk(Pv[BASE + 2], Pv[BASE + 3]); \
    unsigned b0_ = cvtpk(Pv[BASE + 4], Pv[BASE + 5]), b1_ = cvtpk(Pv[BASE + 6], Pv[BASE + 7]); \
    auto r0 = __builtin_amdgcn_permlane32_swap(a0, b0_, false, false); auto r1 = __builtin_amdgcn_permlane32_swap(a1, b1_, false, false); \
    u32x4 w = {r0[0], r1[0], r0[1], r1[1]}; OUT = *reinterpret_cast<bf16x8*>(&w); } while (0)
                ATT_PK4(p0, 0, pa0); ATT_PK4(p0, 8, pa1);
#undef ATT_PK4
                if (__any(alpha < 1.f)) { if (hi == 0) al_l[r32] = alpha; asm volatile("s_waitcnt lgkmcnt(0)" ::: "memory");
#pragma unroll
                    for (int d = 0; d < 4; ++d)
#pragma unroll
                        for (int r = 0; r < 16; ++r) o[d][r] *= al_l[crow(r, hi)]; }
                if (hk == 0) { pv_half<0, 0>(o[0], vb, pa0, pa1); pv_half<1, 0>(o[1], vb, pa0, pa1); pv_half<2, 0>(o[2], vb, pa0, pa1); pv_half<3, 0>(o[3], vb, pa0, pa1); }
                else         { pv_half<0, 1>(o[0], vb, pa0, pa1); pv_half<1, 1>(o[1], vb, pa0, pa1); pv_half<2, 1>(o[2], vb, pa0, pa1); pv_half<3, 1>(o[3], vb, pa0, pa1); }
            }
        }
        if (st2) ATT_WAIT_BAR(5); else ATT_WAIT_BAR(0);
        bf = bf == 2 ? 0 : bf + 1;
    }
    if (hi == 0) li_l[r32] = l_reg;
    asm volatile("s_waitcnt lgkmcnt(0)" ::: "memory");
    bf16_t* Ow = MIX + (rowb + qrow0) * DM + POOLW + h * 128 + r32;
#pragma unroll
    for (int r = 0; r < 16; ++r) { const int orow = crow(r, hi); const float rli = __builtin_amdgcn_rcpf(li_l[orow]);
#pragma unroll
        for (int d0 = 0; d0 < 4; ++d0) Ow[(size_t)orow * DM + d0 * 32] = (bf16_t)f2bf(o[d0][r] * rli); }
#undef ATT_DMA
#undef ATT_STAGE
#undef ATT_WAIT_BAR
}
__device__ __forceinline__ void attn_phase(const unsigned char* ws, unsigned char* wsw, LAS char* lds, int G, int bx, const int tid) {
    const bf16_t* QB = (const bf16_t*)(ws + WS_QB); const bf16_t* KN = (const bf16_t*)(ws + WS_KN); const bf16_t* KR = (const bf16_t*)(ws + WS_KR); const bf16_t* VB = (const bf16_t*)(ws + WS_VB);
    bf16_t* MIX = (bf16_t*)(wsw + WS_MIX);
    for (int c = bx; c < 256; c += G) {
        const int x = c & 7, y = c >> 3, bh = 8 * (y >> 2) + x, p = y & 3, b = bh >> 3, h = bh & 7;
#pragma unroll 1
        for (int k = 0; k < 2; ++k) attn_unit(b, h, k == 0 ? 8 - p : 1 + p, QB, KN, KR, VB, MIX, lds, tid);
    }
}
}
#define XB_TMO      128
#define XB_XCNT(j)  (256  + 64 * (j))
#define XB_XSUB(j)  (1280 + 64 * (j))
#define XB_XGEN(j)  (2304 + 64 * (j))
#define XB_TOP      3328
#define XB_TOPGEN   3392
#define XCD_BAR_WORDS 3456
#define XB_SPIN_CAP (1u << 18)
__device__ __forceinline__ unsigned xb_ld(unsigned* p)              { return __hip_atomic_load(p, __ATOMIC_RELAXED, __HIP_MEMORY_SCOPE_AGENT); }
__device__ __forceinline__ unsigned xb_add(unsigned* p, unsigned v) { return __hip_atomic_fetch_add(p, v, __ATOMIC_RELAXED, __HIP_MEMORY_SCOPE_AGENT); }
__device__ __forceinline__ unsigned xb_xcc_id() { return (unsigned)__builtin_amdgcn_s_getreg((3 << 11) | 20) & 0xFu; }
#define XB_SPIN(cond, bar) do { unsigned _sp = 0; while (cond) { __builtin_amdgcn_s_sleep(1); \
    if ((++_sp & 255u) == 0u) { if (xb_ld(&(bar)[XB_TMO])) break; if (_sp > XB_SPIN_CAP) { atomicAdd(&(bar)[XB_TMO], 1u); break; } } } } while (0)
struct XcdBarrier { unsigned* bar; unsigned x; volatile LAS unsigned* st; };
__device__ __forceinline__ XcdBarrier xcd_barrier_post(unsigned* bar, volatile LAS unsigned* st) {
    XcdBarrier b; b.bar = bar; b.x = xb_xcc_id(); b.st = st;
    if (threadIdx.x == 0) (void)xb_add(&bar[XB_XCNT(b.x)], 1u);
    return b;
}
__device__ __forceinline__ void xcd_barrier_complete(unsigned* bar, unsigned x, unsigned& nloc, unsigned& nx) {
    const unsigned G = gridDim.x * gridDim.y * gridDim.z;
    unsigned sum, cnt, mine, sp = 0u;
    for (;;) {
        sum = 0u; cnt = 0u; mine = 0u;
#pragma unroll
        for (unsigned j = 0; j < 16; ++j) { const unsigned c = xb_ld(&bar[XB_XCNT(j)]); sum += c; cnt += (c > 0u) ? 1u : 0u; mine = (j == x) ? c : mine; }
        if (sum == G) break;
        __builtin_amdgcn_s_sleep(1);
        if ((++sp & 255u) == 0u) { if (xb_ld(&bar[XB_TMO])) break; if (sp > XB_SPIN_CAP) { atomicAdd(&bar[XB_TMO], 1u); break; } }
    }
    nloc = mine > 0u ? mine : 1u; nx = cnt > 0u ? cnt : 1u;
}
__device__ __forceinline__ void xcd_barrier(const XcdBarrier& b) {
    asm volatile("s_waitcnt vmcnt(0)" ::: "memory");
    __syncthreads();
    if (threadIdx.x == 0) {
        unsigned* bar = b.bar;
        __builtin_amdgcn_s_waitcnt(0);
        unsigned nloc = b.st[0], nx = b.st[1];
        if (nloc == 0u) { xcd_barrier_complete(bar, b.x, nloc, nx); b.st[0] = nloc; b.st[1] = nx; }
        const unsigned old = xb_add(&bar[XB_XSUB(b.x)], 1u);
        const unsigned gen = old / nloc;
        if (old + 1u == (gen + 1u) * nloc) {
            __builtin_amdgcn_fence(__ATOMIC_RELEASE, "agent");
            asm volatile("s_waitcnt vmcnt(0)" ::: "memory");
            const unsigned og = xb_add(&bar[XB_TOP], 1u);
            const unsigned tg = og / nx;
            if (og + 1u == (tg + 1u) * nx) xb_add(&bar[XB_TOPGEN], 1u);
            else XB_SPIN(xb_ld(&bar[XB_TOPGEN]) == tg, bar);
            __builtin_amdgcn_fence(__ATOMIC_ACQUIRE, "agent");
            xb_add(&bar[XB_XGEN(b.x)], 1u);
            asm volatile("s_waitcnt vmcnt(0)" ::: "memory");
        } else {
            XB_SPIN(xb_ld(&bar[XB_XGEN(b.x)]) == gen, bar);
            __builtin_amdgcn_fence(__ATOMIC_ACQUIRE, "agent");
            asm volatile("s_waitcnt vmcnt(0)" ::: "memory");
        }
    }
    __syncthreads();
}
constexpr int CW_BAR = 4096;

constexpr int CVS_P1 = 0, CVS_P2 = 3072, CVS_P3 = 4352, CVS_P3B = 8192, CVS_P4 = 8448, CVS_P6 = 11776;
static_assert(CVS_P1 + 16 * 7 + 80 * 13 + 160 * 12 == CVS_P2 && CVS_P2 + 140 * 4 + 24 * 7 + 92 * 6 == CVS_P3 && CVS_P3 + 256 * 15 == CV_ITEMS_W1 && CVS_P3B == CV_ITEMS_W1 && CVS_P3B + 256 == CVS_P4 && CVS_P4 + 256 * 13 == CVS_P6 && CVS_P6 + 512 == CV_ITEMS, "conversion plan");
constexpr int PH_P0 = 0, PH_P1 = 1, PH_P1B = 2, PH_P2 = 3, PH_P3 = 4, PH_P4 = 5, PH_P5 = 6, PH_P6 = 7, PH_P7 = 8, PH_P8 = 9, PH_END = 10;
struct Args { Ptrs P; int ph_lo, ph_hi, use_bar, pad; };
#define CAS __attribute__((address_space(4)))
__device__ __forceinline__ void load_ptrs(const CAS Args* a, Ptrs& P) { P.x = a->P.x; P.meta = a->P.meta; P.g_attn = a->P.g_attn; P.w_in = a->P.w_in; P.g_q = a->P.g_q; P.w_uq = a->P.w_uq; P.g_kv = a->P.g_kv; P.w_ukv = a->P.w_ukv; P.pool_w = a->P.pool_w; P.pool_scale = a->P.pool_scale; P.w_o = a->P.w_o; P.g_ffn = a->P.g_ffn; P.w_router = a->P.w_router; P.b_router = a->P.b_router; P.w1 = a->P.w1; P.b1 = a->P.b1; P.w2 = a->P.w2; P.b2 = a->P.b2; P.g_final = a->P.g_final; P.out = a->P.out; P.ws = a->P.ws; }
__global__ void __launch_bounds__(NWAVES * 64, 2) mk_fwd(Args args) {
    extern __shared__ __attribute__((aligned(16))) unsigned char lds_raw[];
    LAS unsigned char* lds = (LAS unsigned char*)lds_raw;
    const int G = gridDim.x, bx = blockIdx.x;
#define PHASE_IDS int tid; asm volatile("v_mov_b32 %0, %1" : "=v"(tid) : "v"(threadIdx.x)); const int lane = tid & 63, wave = __builtin_amdgcn_readfirstlane(tid >> 6); \
    const long gw = (long)bx * NWAVES + wave, NGW = (long)G * NWAVES; (void)lane; (void)gw; (void)NGW; \
    const CAS Args* ap_ = (const CAS Args*)__builtin_amdgcn_kernarg_segment_ptr(); asm volatile("" : "+s"(ap_)); Ptrs P; load_ptrs(ap_, P); unsigned char* const ws = P.ws
    volatile LAS unsigned* MISC = (volatile LAS unsigned*)(lds + MISC_OFF);
    if (threadIdx.x < 64) MISC[threadIdx.x] = 0u;
    __syncthreads();
    XcdBarrier bar; bar.bar = (unsigned*)(args.P.ws + WS_CTL) + CW_BAR; bar.x = 0; bar.st = nullptr;
    if (args.use_bar) bar = xcd_barrier_post((unsigned*)(args.P.ws + WS_CTL) + CW_BAR, MISC + 8);
    const int lo = args.ph_lo, hi = args.ph_hi;
#define IN(k) (lo <= (k) && (k) < hi)
    const bool cv_first = ((bx >> 3) & 1) != 0;
#define CV_CALL(W1, F, S, N) do { const CAS Args* ap2_ = (const CAS Args*)__builtin_amdgcn_kernarg_segment_ptr(); asm volatile("" : "+s"(ap2_)); Ptrs Pc_; load_ptrs(ap2_, Pc_); cv_slice<W1>(Pc_, lds_raw, tid, (F), (S), (N)); } while (0)
#define CV_DEAL(W1, S, ca, ka, cb, kb, kc) do { if (G == 256) { int f_, s_, n_; if (bx < (ca)) { f_ = (S) + bx; s_ = (ca); n_ = (ka); } else if (bx < (cb)) { f_ = (S) + (ca) * (ka) + (bx - (ca)); s_ = (cb) - (ca); n_ = (kb); } \
        else { f_ = (S) + (ca) * (ka) + ((cb) - (ca)) * (kb) + (bx - (cb)); s_ = 256 - (cb); n_ = (kc); } CV_CALL(W1, f_, s_, n_); } \
    else { const int tot_ = (ca) * (ka) + ((cb) - (ca)) * (kb) + (256 - (cb)) * (kc); for (int it_ = (S) + bx; it_ < (S) + tot_; it_ += G) CV_CALL(W1, it_, 0, 1); } } while (0)
#define CV_SLICE(W1, S, N) CV_DEAL(W1, S, 0, 0, 0, 0, N)
#define SEAM(k) do { if (IN(k) && IN((k) + 1)) xcd_barrier(bar); } while (0)

    if (IN(PH_P0)) { PHASE_IDS;
        float* scr = (float*)lds_raw + wave * (64 * 65);
        for (long it = gw; it < I_TOTAL; it += NGW) p0_item(P, it, scr, lane);
        for (long p = gw; p < MP; p += NGW) p0_hn_row(P, (int)p, lane);
        { u32x4* z = (u32x4*)(ws + WS_WIN + (size_t)INW * DM * 2); const long n16 = (long)(DM - INW) * DM * 2 / 16;
          for (long i = (long)bx * 512 + tid; i < n16; i += (long)G * 512) z[i] = (u32x4){0u, 0u, 0u, 0u}; }
        { float* ct = (float*)(ws + WS_ROPE); float* st = ct + LSEQ * 32;
          for (long i = (long)bx * 512 + tid; i < LSEQ * 32; i += (long)G * 512) { const int pos = (int)(i / 32), j = (int)(i % 32);
              const float inv = 1.0f / powf(10000.0f, (float)(2 * j) / 64.0f); const float ang = (float)pos * inv; ct[i] = cosf(ang); st[i] = sinf(ang); } }
        { float* wr = (float*)(ws + WS_WR);
          for (long i = (long)bx * 512 + tid; i < DM * NE; i += (long)G * 512) { const int k = (int)(i / NE), e = (int)(i % NE); wr[((k >> 2) * NE + e) * 4 + (k & 3)] = P.w_router[i] * P.g_ffn[k]; } }
        __syncthreads();
    }
    SEAM(PH_P0);
    if (IN(PH_P1)) { PHASE_IDS;
        pg8::ProbP1 pb; pb.A = (const char*)(ws + WS_HN); pb.Bt = (const char*)(ws + WS_WIN); pb.K = DM; pb.lda = DM; pb.ldaB = 2 * DM; pb.ldb = DM; pb.ldbB = 2 * DM; pb.ord.init(MP / 256, 8, G, bx);
        pb.proj = (bf16_t*)(ws + WS_PROJ); pb.kr = (bf16_t*)(ws + WS_KR); pb.rope = (const float*)(ws + WS_ROPE); pb.ssqp = (float*)(ws + WS_RSQ);
        if (cv_first) CV_DEAL(true, CVS_P1, 16, 7, 96, 13, 12);
        pg8::gemm_phase<pg8::ProbP1, true>(lds + RING_OFF, pb, tid);
        if (!cv_first) CV_DEAL(true, CVS_P1, 16, 7, 96, 13, 12);
    }
    if (IN(PH_P1) && IN(PH_P2)) xcd_barrier(bar);
    if (IN(PH_P2)) { PHASE_IDS;
        for (long m = gw; m < MP; m += NGW) p1b_row(P, (int)m, lane);
        if (cv_first) CV_DEAL(true, CVS_P2, 140, 4, 164, 7, 6);
        { pg8::ProbP2q pb; pb.A = (const char*)(ws + WS_PROJ) + 1024 * 2; pb.Bt = (const char*)(ws + WS_WUQ); pb.K = QLORA; pb.lda = DM; pb.ldaB = 2 * DM; pb.ldb = QLORA; pb.ldbB = 2 * QLORA; pb.ord.init(MP / 256, 6, G, bx);
          pb.qb = (bf16_t*)(ws + WS_QB); pb.rsq = (const float*)(ws + WS_RSQ); pb.rope = (const float*)(ws + WS_ROPE);
          pg8::gemm_phase<pg8::ProbP2q, true>(lds + RING_OFF, pb, tid); }
        { pg8::ProbP2kv pb; pb.A = (const char*)(ws + WS_PROJ) + 1536 * 2; pb.Bt = (const char*)(ws + WS_WUKV); pb.K = KVLORA; pb.lda = DM; pb.ldaB = 2 * DM; pb.ldb = KVLORA; pb.ldbB = 2 * KVLORA; pb.ord.init(MP / 256, 8, G, (bx + 116) % G);
          pb.kn = (bf16_t*)(ws + WS_KN); pb.vb = (bf16_t*)(ws + WS_VB); pb.rskv = (const float*)(ws + WS_RSQ);
          pg8::gemm_phase<pg8::ProbP2kv, true>(lds + RING_OFF, pb, tid); }
        if (!cv_first) CV_DEAL(true, CVS_P2, 140, 4, 164, 7, 6);
    }
    SEAM(PH_P2);
    if (IN(PH_P3)) { PHASE_IDS;
        if (cv_first) { CV_SLICE(true, CVS_P3, 15); CV_SLICE(false, CVS_P3B, 1); }
        att::attn_phase(ws, ws, (LAS char*)(lds + RING_OFF), G, bx, tid);
        { pg8::ProbPool pb; pb.A = (const char*)(ws + WS_DP); pb.Bt = (const char*)(ws + WS_WPOOL); pb.K = 256; pb.lda = POOLW; pb.ldaB = 2 * POOLW; pb.ldb = 256; pb.ldbB = 2 * 256; pb.ord.init(MP / 256, 4, G, bx);
          pb.mix = (bf16_t*)(ws + WS_MIX); pb.pscale = P.pool_scale;
          pg8::gemm_phase<pg8::ProbPool, true>(lds + RING_OFF, pb, tid); }
        if (!cv_first) { CV_SLICE(true, CVS_P3, 15); CV_SLICE(false, CVS_P3B, 1); }
    }
    SEAM(PH_P3);
    if (IN(PH_P4)) { PHASE_IDS;
        pg8::ProbP4 pb; pb.A = (const char*)(ws + WS_MIX); pb.Bt = (const char*)(ws + WS_WO); pb.K = DM; pb.lda = DM; pb.ldaB = 2 * DM; pb.ldb = DM; pb.ldbB = 2 * DM; pb.ord.init(MR / 256, 8, G, bx);
        pb.x = P.x; pb.h2 = P.out; pb.h2f8 = ws + WS_H2B;
        pg8::gemm_phase<pg8::ProbP4, true>(lds + RING_OFF, pb, tid);
    }
    SEAM(PH_P4);
    if (IN(PH_P5)) { PHASE_IDS; for (int blk = bx; blk < MR / 64; blk += G) p5_block(P, blk, lds_raw, tid); }
    SEAM(PH_P5);
    if (IN(PH_P6)) { PHASE_IDS;
        pg8::moe_table(lds, (const unsigned*)(ws + WS_CTL) + CW_CNT, tid);
        pg8::ProbP6 pb; pb.A = (const char*)(ws + WS_H2B); pb.Bt = (const char*)(ws + WS_W1); pb.K = DM; pb.ldbB = DM; pb.ord.tab = (const LAS int*)(lds + TAB_OFF); pb.ord.G = G; pb.ord.c = bx;
        pb.list = (const int*)(ws + WS_LIST); pb.rsl = (const float*)(ws + WS_RSL); pb.b1 = P.b1; pb.act = ws + WS_ACT;
        const int split = 2 + 4 * ((bx >> 3) & 3);
        pb.ord.i0 = 0; pb.ord.i1 = split;
        pg8::gemm_phase<pg8::ProbP6, true>(lds + RING_OFF, pb, tid);
        CV_SLICE(false, CVS_P4, 13);
        pb.ord.i0 = split; pb.ord.i1 = 0x7fffffff;
        pg8::gemm_phase<pg8::ProbP6, true>(lds + RING_OFF, pb, tid);
        { const int U = ((const LAS int*)(lds + TAB_OFF))[NE] * 16, R = U % G, nidle = G - R, rank0 = (G & 7) ? bx : (bx & 7) * (G >> 3) + (bx >> 3);
          const bool few = nidle < 64; const int nshare = few ? G : nidle, rank = few ? rank0 : rank0 - R;
          if (rank >= 0) { const int cnt_ = (CV_ITEMS - CVS_P6 - rank + nshare - 1) / nshare; CV_CALL(false, CVS_P6 + rank, nshare, cnt_); } }
    }
    SEAM(PH_P6);
    if (IN(PH_P7)) { PHASE_IDS;
        pg8::moe_table(lds, (const unsigned*)(ws + WS_CTL) + CW_CNT, tid);
        pg8::ProbP7 pb; pb.A = (const char*)(ws + WS_ACT); pb.Bt = (const char*)(ws + WS_W2); pb.K = DFF; pb.ldbB = DFF; pb.ord.tab = (const LAS int*)(lds + TAB_OFF); pb.ord.G = G; pb.ord.c = bx; pb.ord.i0 = 0; pb.ord.i1 = 0x7fffffff;
        pb.list = (const int*)(ws + WS_LIST); pb.gate = (const float*)(ws + WS_GATE); pb.b2 = P.b2; pb.yb = (bf16_t*)(ws + WS_YB);
        pg8::gemm_phase<pg8::ProbP7, true>(lds + RING_OFF, pb, tid);
    }
    SEAM(PH_P7);
    if (IN(PH_P8)) { PHASE_IDS; for (long r = gw; r < MR; r += NGW) p8_row(P, (int)r, lane, P.out); }
#undef IN
#undef SEAM
}

extern "C" void kernel_launch(void* const* d_in, const int* in_sizes, int n_in, void* d_out, int out_size, void* d_ws, size_t ws_size, hipStream_t stream) {
    static int ok = 0; static int grid = 256;
    if (ok == 0) {
        if (n_in != 19 || in_sizes[0] != NB * SEQ * DM || out_size != MR * DM || ws_size < WS_END) { fprintf(stderr, "kernel_launch: shape mismatch n_in %d in0 %d out %d ws %zu\n", n_in, n_in > 0 ? in_sizes[0] : -1, out_size, ws_size); ok = -1; return; }
        if (hipFuncSetAttribute((const void*)mk_fwd, hipFuncAttributeMaxDynamicSharedMemorySize, LDS_BYTES) != hipSuccess) { fprintf(stderr, "hipFuncSetAttribute(mk) failed\n"); ok = -1; return; }
        int dev = 0, cus = 0; (void)hipGetDevice(&dev); (void)hipDeviceGetAttribute(&cus, hipDeviceAttributeMultiprocessorCount, dev); if (cus > 0) grid = cus;
        ok = 1;
    }
    if (ok < 0) return;
    Ptrs P{};
    const float** pp = (const float**)&P;
    for (int i = 0; i < 19; ++i) pp[i] = (const float*)d_in[i];
    P.out = (float*)d_out; P.ws = (unsigned char*)d_ws;
    unsigned char* ws = (unsigned char*)d_ws;
    (void)hipMemsetAsync(ws + WS_CTL, 0, CTL_ZERO_BYTES, stream);
    { Args a{}; a.P = P; a.ph_lo = 0; a.ph_hi = PH_END; a.use_bar = 1; a.pad = 0;
      hipLaunchKernelGGL(mk_fwd, dim3(grid), dim3(NWAVES * 64), LDS_BYTES, stream, a); }
}
```

```cpp
#include <hip/hip_runtime.h>
#include <cstdint>
#include <cstdio>

constexpr int NB = 8, SEQ = 2048, NMETA = 16, LSEQ = 2064, LP = 2112, PADR = 48, MP = NB * LP, MR = NB * SEQ;
constexpr int DM = 2048, POOLW = 1024, QLORA = 512, KVLORA = 256, QKROPE = 64, QKNOPE = 128, VDIM = 128, NH = 8, QKD = 192;
constexpr int INW = 1856, NE = 32, TOPK = 4, DFF = 2048;
constexpr float EPS = 1e-5f;
constexpr float C2 = 0.07216878364870322f * 1.4426950408889634f;
constexpr int ACT_ROWS = MR * TOPK + NE * 256;

typedef unsigned short bf16_t;
typedef unsigned u32x4 __attribute__((ext_vector_type(4)));
typedef float f32x4 __attribute__((ext_vector_type(4)));

constexpr size_t MiB = 1u << 20;
constexpr size_t WS_CTL = 0, CTL_ZERO_BYTES = 1 * MiB;
constexpr size_t WS_ROPE = 1 * MiB;
constexpr size_t WS_WR = 2 * MiB;
constexpr size_t WS_WIN = 4 * MiB;
constexpr size_t WS_WUQ = 12 * MiB;
constexpr size_t WS_WUKV = 14 * MiB;
constexpr size_t WS_WPOOL = 15 * MiB;
constexpr size_t WS_WO = 16 * MiB;
constexpr size_t WS_W1 = 24 * MiB;
constexpr size_t WS_W2 = 536 * MiB;
constexpr size_t WS_HN = 792 * MiB;
constexpr size_t WS_PROJ = 860 * MiB;
constexpr size_t WS_QB = 928 * MiB;
constexpr size_t WS_KN = 980 * MiB;
constexpr size_t WS_VB = 1014 * MiB;
constexpr size_t WS_KR = 1048 * MiB;
constexpr size_t WS_RSQ = 1051 * MiB;
constexpr size_t WS_RSKV = 1052 * MiB;
constexpr size_t WS_RS2 = 1053 * MiB;
constexpr size_t WS_DP = 1054 * MiB;
constexpr size_t WS_MIX = 1088 * MiB;
constexpr size_t WS_H2B = 1156 * MiB;
constexpr size_t WS_LIST = 1220 * MiB;
constexpr size_t WS_GATE = 1222 * MiB;
constexpr size_t WS_ACT = 1224 * MiB;
constexpr size_t WS_YB = 1512 * MiB;
constexpr size_t WS_RSL = 1768 * MiB;
constexpr size_t WS_END = 1770 * MiB;
constexpr int CW_CNT = 64;

struct Ptrs {
    const float *x, *meta, *g_attn, *w_in, *g_q, *w_uq, *g_kv, *w_ukv, *pool_w, *pool_scale, *w_o, *g_ffn, *w_router, *b_router, *w1, *b1, *w2, *b2, *g_final;
    float* out; unsigned char* ws;
};

__device__ __forceinline__ float bf2f(bf16_t v) { return __uint_as_float((unsigned)v << 16); }
__device__ __forceinline__ unsigned f2bf(float f) { unsigned u = __float_as_uint(f); return (u + 0x7fffu + ((u >> 16) & 1u)) >> 16; }
__device__ __forceinline__ unsigned pk2(float lo, float hi) { return f2bf(lo) | (f2bf(hi) << 16); }
__device__ __forceinline__ float wave_sum(float v) {
#pragma unroll
    for (int o = 1; o < 64; o <<= 1) v += __shfl_xor(v, o);
    return v;
}
__device__ __forceinline__ float wave_max(float v) {
#pragma unroll
    for (int o = 1; o < 64; o <<= 1) v = fmaxf(v, __shfl_xor(v, o));
    return v;
}

__device__ __forceinline__ void p0_hn_row(const Ptrs& P, int p, int lane) {
    bf16_t* hn = (bf16_t*)(P.ws + WS_HN) + (size_t)p * DM;
    const int b = p / LP, q = p % LP;
    unsigned long long* o8 = (unsigned long long*)hn + lane;
    if (q < PADR) {
#pragma unroll
        for (int j = 0; j < 8; ++j) o8[64 * j] = 0ull;
        return;
    }
    const int pos = q - PADR;
    const float* src = pos < NMETA ? P.meta + (size_t)pos * DM : P.x + ((size_t)b * SEQ + (pos - NMETA)) * DM;
    const f32x4* xr = (const f32x4*)src + lane;
    const f32x4* gr = (const f32x4*)P.g_attn + lane;
    f32x4 v[8]; float s = 0.f;
#pragma unroll
    for (int j = 0; j < 8; ++j) { v[j] = xr[64 * j]; s += (v[j].x * v[j].x + v[j].y * v[j].y) + (v[j].z * v[j].z + v[j].w * v[j].w); }
    const float rs = 1.0f / sqrtf(wave_sum(s) * (1.0f / DM) + EPS);
#pragma unroll
    for (int j = 0; j < 8; ++j) { const f32x4 g = gr[64 * j];
        o8[64 * j] = (unsigned long long)pk2(v[j].x * rs * g.x, v[j].y * rs * g.y) | ((unsigned long long)pk2(v[j].z * rs * g.z, v[j].w * rs * g.w) << 32); }
}
template <int MODE> __device__ __forceinline__ int nmap(int n) {
    if (MODE == 1) { if (n >= 1792) { const int j = n - 1792; return 1792 + (j < 32 ? 2 * j : 2 * (j - 32) + 1); } return n; }
    if (MODE == 2) { const int h = n / 192, d = n % 192; if (d >= 128) { const int j = d - 128; return h * 192 + 128 + (j < 32 ? 2 * j : 2 * (j - 32) + 1); } return n; }
    return n;
}
template <int MODE> __device__ __forceinline__ void p0_transpose_item(const float* W, int K, int N, bf16_t* WT, const float* gk, float* scr, int item, int lane) {
    const int nblk = N / 64, kb = item / nblk, nb = item % nblk, k0 = 64 * kb, n0 = 64 * nb;
    const int kl = lane >> 4, nl = (lane & 15) * 4;
#pragma unroll 4
    for (int i = 0; i < 16; ++i) { const int kk = kl + 4 * i; const f32x4 v = *(const f32x4*)(W + (size_t)(k0 + kk) * N + n0 + nl);
        const float g = gk ? gk[k0 + kk] : 1.0f;
        float* s = scr + kk * 65 + nl; s[0] = v.x * g; s[1] = v.y * g; s[2] = v.z * g; s[3] = v.w * g; }
    __builtin_amdgcn_s_waitcnt(0xc07f); asm volatile("" ::: "memory");
    const int c = lane & 7;
#pragma unroll
    for (int j = 0; j < 8; ++j) { const int n = (lane >> 3) + 8 * j; const float* s = scr + (8 * c) * 65 + n;
        u32x4 o; o.x = pk2(s[0 * 65], s[1 * 65]); o.y = pk2(s[2 * 65], s[3 * 65]); o.z = pk2(s[4 * 65], s[5 * 65]); o.w = pk2(s[6 * 65], s[7 * 65]);
        *(u32x4*)(WT + (size_t)nmap<MODE>(n0 + n) * K + k0 + 8 * c) = o; }
    __builtin_amdgcn_s_waitcnt(0xc07f); asm volatile("" ::: "memory");
}
__device__ __forceinline__ void p0_transpose_item_f8(const float* W, int K, int N, unsigned char* WT, const float* gk, float scale, float* scr, int item, int lane) {
    const int nblk = N / 64, kb = item / nblk, nb = item % nblk, k0 = 64 * kb, n0 = 64 * nb;
    const int kl = lane >> 4, nl = (lane & 15) * 4;
#pragma unroll 4
    for (int i = 0; i < 16; ++i) { const int kk = kl + 4 * i; const f32x4 v = *(const f32x4*)(W + (size_t)(k0 + kk) * N + n0 + nl);
        const float g = (gk ? gk[k0 + kk] : 1.0f) * scale;
        float* s = scr + kk * 65 + nl; s[0] = v.x * g; s[1] = v.y * g; s[2] = v.z * g; s[3] = v.w * g; }
    asm volatile("s_waitcnt lgkmcnt(0)" ::: "memory");
    const int c = lane & 7;
#pragma unroll
    for (int j = 0; j < 8; ++j) { const int n = (lane >> 3) + 8 * j; const float* s = scr + (8 * c) * 65 + n;
        int w0 = 0, w1 = 0;
        w0 = __builtin_amdgcn_cvt_pk_fp8_f32(s[0 * 65], s[1 * 65], w0, false); w0 = __builtin_amdgcn_cvt_pk_fp8_f32(s[2 * 65], s[3 * 65], w0, true);
        w1 = __builtin_amdgcn_cvt_pk_fp8_f32(s[4 * 65], s[5 * 65], w1, false); w1 = __builtin_amdgcn_cvt_pk_fp8_f32(s[6 * 65], s[7 * 65], w1, true);
        *(unsigned long long*)(WT + (size_t)(n0 + n) * K + k0 + 8 * c) = (unsigned long long)(unsigned)w0 | ((unsigned long long)(unsigned)w1 << 32); }
    asm volatile("s_waitcnt lgkmcnt(0)" ::: "memory");
}
constexpr int CV_ITEMS_W1 = NE * (DM / 128) * (4096 / 256), CV_ITEMS_W2 = NE * (DFF / 128) * (DM / 256), CV_ITEMS = CV_ITEMS_W1 + CV_ITEMS_W2;
struct CvItem { const float* src; unsigned char* dst; const float* gk; };
template <bool W1> __device__ __forceinline__ CvItem cv_decode(const Ptrs& P, int it) {
    CvItem c;
    if (W1) { const int e = it >> 8, r = it & 255, kb = r >> 4, nb = r & 15;
        c.src = P.w1 + (size_t)e * DM * 4096 + (size_t)kb * 128 * 4096 + nb * 256; c.dst = P.ws + WS_W1 + ((size_t)e * 4096 + nb * 256) * DM + kb * 128; c.gk = P.g_ffn + kb * 128; }
    else { const int j = it - CV_ITEMS_W1, e = j >> 7, r = j & 127, kb = r >> 3, nb = r & 7;
        c.src = P.w2 + (size_t)e * DFF * DM + (size_t)kb * 128 * DM + nb * 256; c.dst = P.ws + WS_W2 + ((size_t)e * DM + nb * 256) * DFF + kb * 128; c.gk = nullptr; }
    return c;
}
#define CV_LOAD(V, C) do { const __amdgpu_buffer_rsrc_t rs_ = __builtin_amdgcn_make_buffer_rsrc((void*)(C).src, 0, 0x7ffffffe, 0x00020000); \
        _Pragma("unroll") for (int i_ = 0; i_ < 16; ++i_) V[i_] = __builtin_bit_cast(f32x4, __builtin_amdgcn_raw_buffer_load_b128(rs_, lane * 16, (wave + 8 * i_) * NN * 4, 2  )); } while (0)
#define CV_PROCESS(V, C, NEXT_IDX) do { \
        _Pragma("unroll") for (int i_ = 0; i_ < 16; ++i_) { const int k_ = wave + 8 * i_; const float g_ = W1 ? (C).gk[k_] * 32.0f : 32.0f; float* s_ = scr + k_ * 257 + lane * 4; \
            s_[0] = V[i_].x * g_; s_[1] = V[i_].y * g_; s_[2] = V[i_].z * g_; s_[3] = V[i_].w * g_; } \
        unsigned char* dst_ = (C).dst; \
        { const int nx_ = (NEXT_IDX) < count ? (NEXT_IDX) : count - 1; (C) = cv_decode<W1>(P, first + nx_ * step); CV_LOAD(V, C); } \
        asm volatile("s_waitcnt lgkmcnt(0)\n\ts_barrier" ::: "memory"); \
          \
        _Pragma("unroll") for (int p_ = 0; p_ < 4; ++p_) { const int u_ = p_ * 8 + wave, nn_ = (u_ >> 1) * 16 + (lane >> 2), k0_ = (u_ & 1) * 64 + (lane & 3) * 16; \
            const float* t_ = scr + k0_ * 257 + nn_; u32x4 w_; \
            _Pragma("unroll") for (int d_ = 0; d_ < 4; ++d_) { int x_ = 0; x_ = __builtin_amdgcn_cvt_pk_fp8_f32(t_[(4 * d_) * 257], t_[(4 * d_ + 1) * 257], x_, false); \
                x_ = __builtin_amdgcn_cvt_pk_fp8_f32(t_[(4 * d_ + 2) * 257], t_[(4 * d_ + 3) * 257], x_, true); w_[d_] = (unsigned)x_; } \
            *(u32x4*)(dst_ + (size_t)nn_ * DM + k0_) = w_; } \
        asm volatile("s_waitcnt lgkmcnt(0)\n\ts_barrier" ::: "memory"); } while (0)
template <bool W1> __device__ __forceinline__ void cv_slice(const Ptrs& P, unsigned char* ldsg, int tid, int first, int step, int count) {
    if (count <= 0) return;
    constexpr int NN = W1 ? 4096 : DM;
    float* scr = (float*)ldsg;
    const int lane = tid & 63, wave = __builtin_amdgcn_readfirstlane(tid >> 6);
    f32x4 va[16];
    CvItem ca = cv_decode<W1>(P, first);
    CV_LOAD(va, ca);
    for (int n = 0; n < count; ++n) CV_PROCESS(va, ca, n + 1);
    asm volatile("s_waitcnt vmcnt(0)" ::: "memory");
}
#undef CV_LOAD
#undef CV_PROCESS
constexpr int I_WIN = (DM / 64) * (INW / 64), I_WUQ = (QLORA / 64) * (1536 / 64), I_WUKV = (KVLORA / 64) * (2048 / 64), I_POOL1 = 4 * 4, I_WO = 32 * 32,
              I_W1E = (DM / 64) * (4096 / 64), I_W2E = 32 * 32;
constexpr int I_SMALL = I_WIN + I_WUQ + I_WUKV + 4 * I_POOL1 + I_WO;
constexpr long I_TOTAL = (long)I_SMALL;
__device__ __forceinline__ void p0_item(const Ptrs& P, long it, float* scr, int lane) {
    unsigned char* ws = P.ws;
    if (it < I_SMALL) {
        int r = (int)it;
        if (r < I_WIN) { p0_transpose_item<1>(P.w_in, DM, INW, (bf16_t*)(ws + WS_WIN), nullptr, scr, r, lane); return; } r -= I_WIN;
        if (r < I_WUQ) { p0_transpose_item<2>(P.w_uq, QLORA, 1536, (bf16_t*)(ws + WS_WUQ), P.g_q, scr, r, lane); return; } r -= I_WUQ;
        if (r < I_WUKV) { p0_transpose_item<0>(P.w_ukv, KVLORA, 2048, (bf16_t*)(ws + WS_WUKV), P.g_kv, scr, r, lane); return; } r -= I_WUKV;
        if (r < 4 * I_POOL1) { const int g = r / I_POOL1; p0_transpose_item<0>(P.pool_w + (size_t)g * 65536, 256, 256, (bf16_t*)(ws + WS_WPOOL) + (size_t)g * 65536, nullptr, scr, r % I_POOL1, lane); return; } r -= 4 * I_POOL1;
        p0_transpose_item<0>(P.w_o, DM, DM, (bf16_t*)(ws + WS_WO), nullptr, scr, r, lane); return;
    }
    it -= I_SMALL;
    if (it < (long)NE * I_W1E) { const int e = (int)(it / I_W1E), r = (int)(it % I_W1E);
        p0_transpose_item_f8(P.w1 + (size_t)e * DM * 4096, DM, 4096, ws + WS_W1 + (size_t)e * 4096 * DM, P.g_ffn, 32.0f, scr, r, lane); return; }
    it -= (long)NE * I_W1E;
    { const int e = (int)(it / I_W2E), r = (int)(it % I_W2E);
      p0_transpose_item_f8(P.w2 + (size_t)e * DFF * DM, DFF, DM, ws + WS_W2 + (size_t)e * DM * DFF, nullptr, 32.0f, scr, r, lane); }
}
__device__ __forceinline__ void st4bf(bf16_t* p, float a, float b, float c, float d) { *(unsigned long long*)p = (unsigned long long)pk2(a, b) | ((unsigned long long)pk2(c, d) << 32); }
__device__ __forceinline__ void p1b_row(const Ptrs& P, int m, int lane) {
    const bf16_t* proj = (const bf16_t*)(P.ws + WS_PROJ);
    const bf16_t* row = proj + (size_t)m * DM;
    bf16_t* dp = (bf16_t*)(P.ws + WS_DP) + (size_t)m * POOLW;
    const int pos = (m % LP) - PADR;
    if (pos < 0) {
#pragma unroll
        for (int g = 0; g < 4; ++g) *(unsigned long long*)(dp + g * 256 + lane * 4) = 0ull;
        return;
    }
    unsigned long long ld[30];
    { int q = 0;
#pragma unroll
      for (int g = 0; g < 4; ++g)
#pragma unroll
          for (int j = 0; j < (2 << g); ++j) { const int jj = j < pos ? j : pos; ld[q++] = *(const unsigned long long*)(row - (size_t)jj * DM + g * 256 + lane * 4); } }
    { int q = 0;
#pragma unroll
      for (int g = 0; g < 4; ++g) { const int w = 2 << g; const int cntw = pos + 1 < w ? pos + 1 : w;
        float s0 = 0.f, s1 = 0.f, s2 = 0.f, s3 = 0.f, u0 = 0.f, u1 = 0.f, u2 = 0.f, u3 = 0.f;
#pragma unroll
        for (int j = 0; j < w; ++j) { const unsigned long long v = ld[q++]; const unsigned lo = (unsigned)v, hi = (unsigned)(v >> 32);
            const float mk = j < cntw ? 1.0f : 0.0f;
            const float a = __uint_as_float(lo << 16) * mk, b2 = __uint_as_float(lo & 0xffff0000u) * mk, cc = __uint_as_float(hi << 16) * mk, d = __uint_as_float(hi & 0xffff0000u) * mk;
            if (j == 0) { u0 = a; u1 = b2; u2 = cc; u3 = d; } s0 += a; s1 += b2; s2 += cc; s3 += d; }
        const float ic = 1.0f / (float)cntw;
        st4bf(dp + g * 256 + lane * 4, s0 * ic - u0, s1 * ic - u1, s2 * ic - u2, s3 * ic - u3); } }
}
typedef float f32x16_t __attribute__((ext_vector_type(16)));
__device__ __forceinline__ void p5_block(const Ptrs& P, int blk, unsigned char* ldsg, int tid) {
    const int lane = tid & 63, wave = tid >> 6, t = lane & 31, kk = lane >> 5, tg = wave >> 2, kq = wave & 3;
    float* part = (float*)ldsg;
    float* ssqp = part + 8 * 32 * 33;
    const float* arow = P.out + (size_t)(blk * 64 + tg * 32 + t) * DM + kq * 512 + 16 * kk;
    const f32x4* bptr = (const f32x4*)(P.ws + WS_WR) + ((kq * 128 + 4 * kk) * NE + t);
    f32x16_t acc;
#pragma unroll
    for (int r = 0; r < 16; ++r) acc[r] = 0.f;
    float ss = 0.f;
#pragma unroll 2
    for (int j = 0; j < 16; ++j) {
        f32x4 a[4], b[4];
#pragma unroll
        for (int q = 0; q < 4; ++q) { a[q] = *(const f32x4*)(arow + 32 * j + 4 * q); b[q] = bptr[(8 * j + q) * NE]; }
#pragma unroll
        for (int q = 0; q < 4; ++q) {
            ss += (a[q].x * a[q].x + a[q].y * a[q].y) + (a[q].z * a[q].z + a[q].w * a[q].w);
            acc = __builtin_amdgcn_mfma_f32_32x32x2f32(a[q].x, b[q].x, acc, 0, 0, 0); acc = __builtin_amdgcn_mfma_f32_32x32x2f32(a[q].y, b[q].y, acc, 0, 0, 0);
            acc = __builtin_amdgcn_mfma_f32_32x32x2f32(a[q].z, b[q].z, acc, 0, 0, 0); acc = __builtin_amdgcn_mfma_f32_32x32x2f32(a[q].w, b[q].w, acc, 0, 0, 0);
        }
    }
    ss += __shfl_xor(ss, 32);
#pragma unroll
    for (int r = 0; r < 16; ++r) part[(wave * 32 + ((r & 3) + 8 * (r >> 2) + 4 * kk)) * 33 + t] = acc[r];
    if (kk == 0) ssqp[wave * 32 + t] = ss;
    __syncthreads();
    if (tid < 64) {
        const int tg2 = tid >> 5, ti = tid & 31, r = blk * 64 + tid;
        float lg[NE];
#pragma unroll
        for (int e = 0; e < NE; ++e) lg[e] = (part[((tg2 * 4 + 0) * 32 + ti) * 33 + e] + part[((tg2 * 4 + 1) * 32 + ti) * 33 + e]) + (part[((tg2 * 4 + 2) * 32 + ti) * 33 + e] + part[((tg2 * 4 + 3) * 32 + ti) * 33 + e]);
        const float ssq = (ssqp[(tg2 * 4 + 0) * 32 + ti] + ssqp[(tg2 * 4 + 1) * 32 + ti]) + (ssqp[(tg2 * 4 + 2) * 32 + ti] + ssqp[(tg2 * 4 + 3) * 32 + ti]);
        const float rs = 1.0f / sqrtf(ssq * (1.0f / DM) + EPS);
#pragma unroll
        for (int e = 0; e < NE; ++e) lg[e] = lg[e] * rs + P.b_router[e];
        ((float*)(P.ws + WS_RS2))[r] = rs;
        int idx[TOPK]; float val[TOPK]; unsigned used = 0u;
#pragma unroll
        for (int k = 0; k < TOPK; ++k) { float best = -INFINITY; int bi = 0;
#pragma unroll
            for (int e = 0; e < NE; ++e) { const bool ok = !((used >> e) & 1u) && lg[e] > best; best = ok ? lg[e] : best; bi = ok ? e : bi; }
            used |= 1u << bi; idx[k] = bi; val[k] = best; }
        float den = 0.f, pe[TOPK];
#pragma unroll
        for (int k = 0; k < TOPK; ++k) { pe[k] = __expf(val[k] - val[0]); den += pe[k]; }
        unsigned* cnt = (unsigned*)(P.ws + WS_CTL) + CW_CNT; int* list = (int*)(P.ws + WS_LIST); float* gate = (float*)(P.ws + WS_GATE); float* rsl = (float*)(P.ws + WS_RSL);
        unsigned* lcnt = (unsigned*)(ssqp + 8 * 32); unsigned* lbase = lcnt + NE;
        if (tid < NE) lcnt[tid] = 0u;
        unsigned rk[TOPK];
#pragma unroll
        for (int k = 0; k < TOPK; ++k) rk[k] = __hip_atomic_fetch_add(lcnt + idx[k], 1u, __ATOMIC_RELAXED, __HIP_MEMORY_SCOPE_WORKGROUP);
        if (tid < NE) { const unsigned n = lcnt[tid]; lbase[tid] = n ? atomicAdd(cnt + tid, n) : 0u; }
#pragma unroll
        for (int k = 0; k < TOPK; ++k) { const unsigned slot = lbase[idx[k]] + rk[k]; const size_t o = (size_t)idx[k] * MR + slot; list[o] = r * 4 + k; gate[o] = pe[k] / den; rsl[o] = rs; }
    }
    __syncthreads();
}
__device__ __forceinline__ void p8_row(const Ptrs& P, int r, int lane, float* outbase) {
    float* h2 = P.out + (size_t)r * DM; float* orow = outbase + (size_t)r * DM; const bf16_t* yb = (const bf16_t*)(P.ws + WS_YB) + (size_t)r * 4 * DM;
    f32x4 v[8]; float s = 0.f;
#pragma unroll
    for (int j = 0; j < 8; ++j) { const int c = 4 * lane + 256 * j; v[j] = __builtin_nontemporal_load((const f32x4*)(h2 + c));
#pragma unroll
        for (int k = 0; k < 4; ++k) { const unsigned long long y = __builtin_nontemporal_load((const unsigned long long*)(yb + (size_t)k * DM + c)); const unsigned lo = (unsigned)y, hi = (unsigned)(y >> 32);
            v[j].x += __uint_as_float(lo << 16); v[j].y += __uint_as_float(lo & 0xffff0000u); v[j].z += __uint_as_float(hi << 16); v[j].w += __uint_as_float(hi & 0xffff0000u); }
        s += (v[j].x * v[j].x + v[j].y * v[j].y) + (v[j].z * v[j].z + v[j].w * v[j].w); }
    const float rs = 1.0f / sqrtf(wave_sum(s) * (1.0f / DM) + EPS);
#pragma unroll
    for (int j = 0; j < 8; ++j) { const int c = 4 * lane + 256 * j; const f32x4 g = *(const f32x4*)(P.g_final + c);
        __builtin_nontemporal_store((f32x4){v[j].x * rs * g.x, v[j].y * rs * g.y, v[j].z * rs * g.z, v[j].w * rs * g.w}, (f32x4*)(orow + c)); }
}
#define LAS __attribute__((address_space(3)))
#define GAS __attribute__((address_space(1)))
typedef short bf16x8 __attribute__((ext_vector_type(8)));
typedef int v4i_t __attribute__((ext_vector_type(4)));
typedef GAS unsigned gu32;
#define RLX_AGENT __ATOMIC_RELAXED, __HIP_MEMORY_SCOPE_AGENT
constexpr int NWAVES = 8;
constexpr int RING_OFF = 0, RING_BYTES = 131072;
constexpr int TAB_OFF = 133 * 1024;
constexpr int MISC_OFF = 143 * 1024;
constexpr int LDS_BYTES = 147456;

namespace pg8 {
constexpr int BM = 256, BK = 64, HALF = 128, HTB = HALF * BK * 2, NXCD = 8, WGM = 8;
__host__ __device__ __forceinline__ int lds_byte(int r, int c) { const int st = (r >> 4) * 2 + (c >> 5), rr = r & 15, cc = c & 31, ob = rr * 64 + cc * 2; return st * 1024 + (ob ^ (((ob >> 9) & 1) << 5)); }
__host__ __device__ __forceinline__ void stage_rc(int b, int& R, int& C) { const int st = b / 1024, sb = b % 1024, swz = sb ^ (((sb >> 9) & 1) << 5); R = (st >> 1) * 16 + swz / 64; C = (st & 1) * 32 + (swz % 64) / 2; }
__host__ __device__ __forceinline__ void stage_rc_f8(int b, int& R, int& Cb) { const int s = b >> 4; R = s >> 3; const int q = s & 7; Cb = 32 * ((q >> 1) ^ ((R >> 1) & 3)) + 16 * (q & 1); }
__host__ __device__ __forceinline__ int perm32(int rho) { const int n = rho >> 4, i = rho & 15; return 8 * (i >> 2) + 4 * n + (i & 3); }
struct Unit { int pm, pn, aux; };
__device__ __forceinline__ unsigned cvt_pk_bf16(float lo, float hi) { unsigned r; asm volatile("v_cvt_pk_bf16_f32 %0, %1, %2" : "=v"(r) : "v"(lo), "v"(hi)); return r; }
__device__ __forceinline__ u32x4 pack8(const f32x4& a, const f32x4& b) { u32x4 w; w.x = cvt_pk_bf16(a[0], a[1]); w.y = cvt_pk_bf16(a[2], a[3]); w.z = cvt_pk_bf16(b[0], b[1]); w.w = cvt_pk_bf16(b[2], b[3]); return w; }

struct Order2D {
    int nM, nN, nwg, G, c;
    __device__ __forceinline__ void init(int nM_, int nN_, int G_, int c_) { nM = nM_; nN = nN_; nwg = nM * nN; G = G_; c = c_; }
    __device__ __forceinline__ bool next(int i, Unit& u) const {
        const long L = (long)i * G + c; if (L >= nwg) return false;
        int wgid = (int)L; { const int q = nwg / NXCD, r = nwg % NXCD, xcd = wgid % NXCD, off = wgid / NXCD; wgid = (xcd < r ? xcd * (q + 1) : r * (q + 1) + (xcd - r) * q) + off; }
        const int nig = WGM * nN, gid = wgid / nig, fm = gid * WGM, gsz = (nM - fm) < WGM ? (nM - fm) : WGM;
        u.pm = fm + ((wgid % nig) % gsz); u.pn = (wgid % nig) / gsz; u.aux = 0; return true;
    }
};

template <class Prob, bool ALIGN_EPI>
__device__ __forceinline__ void gemm_phase(LAS unsigned char* lds, const Prob& Pb, const int tid) {
    const int wid = __builtin_amdgcn_readfirstlane(tid >> 6), lane = tid & 63, wr = wid >> 2, wc = wid & 3, fr = lane & 15, fq = lane >> 4;
    constexpr bool F8 = Prob::F8;
    const int nt = F8 ? Pb.K / 128 : Pb.K / BK;
    constexpr bool GATHER = Prob::GATHER;
    int Rr[2], Cc[2]; unsigned voffB, voffA = 0u;
    { int R, C; if (F8) stage_rc_f8(tid * 16, R, C); else { stage_rc(tid * 16, R, C); C *= 2; }
      Rr[0] = R; Rr[1] = R + 64; Cc[0] = C; Cc[1] = C; const int Rb = (R & ~31) + perm32(R & 31); voffB = (unsigned)(Rb * Pb.ldbB + C);
      if constexpr (!GATHER) voffA = (unsigned)(R * Pb.ldaB + C); }
    const unsigned r64B = 64u * (unsigned)Pb.ldbB, r64A = GATHER ? 0u : 64u * (unsigned)Pb.ldaB;
    const unsigned kstep = 128u;
    const unsigned hstepB = (unsigned)HALF * Pb.ldbB;
    const unsigned ldsw = (unsigned)wid * 1024u;
    const int aoff = F8 ? (wr * 64 + fr) * 128 + ((fq ^ ((fr >> 1) & 3)) * 32) : lds_byte(wr * 64 + fr, fq * 8);
    const int boff = F8 ? (wc * 32 + fr) * 128 + ((fq ^ ((fr >> 1) & 3)) * 32) : lds_byte(wc * 32 + fr, fq * 8);
    const int aoff8 = aoff + (fq & 1) * 16, boff8 = boff + (fq & 1) * 16;
#define PG8_SA(b, h) (((b) * 2 + (h)) * HTB)
#define PG8_SB(b, h) ((4 + (b) * 2 + (h)) * HTB)
    const __amdgpu_buffer_rsrc_t rsA = __builtin_amdgcn_make_buffer_rsrc((void*)Pb.A, 0, 0x7ffffffe, 0x00020000), rsB = __builtin_amdgcn_make_buffer_rsrc((void*)Pb.Bt, 0, 0x7ffffffe, 0x00020000);
#define PG8_STAGE_B(bufoff, so) do { \
        __builtin_amdgcn_raw_ptr_buffer_load_lds(rsB, (LAS unsigned*)(lds + (bufoff) + ldsw), 16, voffB, (int)(so), 0, 0); \
        __builtin_amdgcn_raw_ptr_buffer_load_lds(rsB, (LAS unsigned*)(lds + (bufoff) + ldsw + 8192), 16, voffB, (int)((so) + r64B), 0, 0); } while (0)
#define PG8_STAGE_A(bufoff, so, h) do { if constexpr (GATHER) { \
        __builtin_amdgcn_raw_ptr_buffer_load_lds(rsA, (LAS unsigned*)(lds + (bufoff) + ldsw), 16, (h) ? ca10 : ca00, (int)(so), 0, 0); \
        __builtin_amdgcn_raw_ptr_buffer_load_lds(rsA, (LAS unsigned*)(lds + (bufoff) + ldsw + 8192), 16, (h) ? ca11 : ca01, (int)(so), 0, 0); } else { \
        __builtin_amdgcn_raw_ptr_buffer_load_lds(rsA, (LAS unsigned*)(lds + (bufoff) + ldsw), 16, voffA, (int)((so) + (h) * 2u * r64A), 0, 0); \
        __builtin_amdgcn_raw_ptr_buffer_load_lds(rsA, (LAS unsigned*)(lds + (bufoff) + ldsw + 8192), 16, voffA, (int)((so) + (h) * 2u * r64A + r64A), 0, 0); } } while (0)
#define PG8_LDA(dst, b, h) do { if constexpr (F8) { _Pragma("unroll") for (int m = 0; m < 4; ++m) { dst[m][0] = *(const LAS bf16x8*)(lds + PG8_SA(b, h) + m * 2048 + aoff8); dst[m][1] = *(const LAS bf16x8*)(lds + PG8_SA(b, h) + m * 2048 + (aoff8 ^ 16)); } } \
        else { _Pragma("unroll") for (int m = 0; m < 4; ++m) _Pragma("unroll") for (int k = 0; k < 2; ++k) dst[m][k] = *(const LAS bf16x8*)(lds + PG8_SA(b, h) + aoff + m * 2048 + k * 1024); } } while (0)
#define PG8_LDB(dst, b, h) do { if constexpr (F8) { _Pragma("unroll") for (int n = 0; n < 2; ++n) { dst[n][0] = *(const LAS bf16x8*)(lds + PG8_SB(b, h) + n * 2048 + boff8); dst[n][1] = *(const LAS bf16x8*)(lds + PG8_SB(b, h) + n * 2048 + (boff8 ^ 16)); } } \
        else { _Pragma("unroll") for (int n = 0; n < 2; ++n) _Pragma("unroll") for (int k = 0; k < 2; ++k) dst[n][k] = *(const LAS bf16x8*)(lds + PG8_SB(b, h) + boff + n * 2048 + k * 1024); } } while (0)
#define PG8_F8FRAG(x) __builtin_shufflevector(__builtin_bit_cast(v4i_t, x[0]), __builtin_bit_cast(v4i_t, x[1]), 0, 1, 2, 3, 4, 5, 6, 7)
#define PG8_MMA(ai, bj, At, Bt) do { __builtin_amdgcn_s_setprio(1); if constexpr (F8) { _Pragma("unroll") for (int m = 0; m < 4; ++m) _Pragma("unroll") for (int n = 0; n < 2; ++n) \
        acc[ai][bj][m][n] = __builtin_amdgcn_mfma_scale_f32_16x16x128_f8f6f4(PG8_F8FRAG(Bt[n]), PG8_F8FRAG(At[m]), acc[ai][bj][m][n], 0, 0, 0, 0x7f7f7f7f, 0, 0x7f7f7f7f); } \
        else { _Pragma("unroll") for (int m = 0; m < 4; ++m) _Pragma("unroll") for (int n = 0; n < 2; ++n) _Pragma("unroll") for (int k = 0; k < 2; ++k) \
        acc[ai][bj][m][n] = __builtin_amdgcn_mfma_f32_16x16x32_bf16(Bt[n][k], At[m][k], acc[ai][bj][m][n], 0, 0, 0); } __builtin_amdgcn_s_setprio(0); } while (0)
#define PG8_WAIT_V(n) asm volatile("s_waitcnt vmcnt(" #n ")" ::: "memory")
#define PG8_WAIT_L(n) asm volatile("s_waitcnt lgkmcnt(" #n ")" ::: "memory")
#define PG8_BAR __builtin_amdgcn_s_barrier()
#define PG8_SCHED __builtin_amdgcn_sched_barrier(0)
    Unit cur, nxt; int ui = 0;
    if (!Pb.next(0, cur)) return;
    const unsigned ktm = (unsigned)nt - 1u;
    unsigned rc = Pb.rot(cur), rn = 0u;
    f32x4 acc[2][2][4][2];
#pragma unroll
    for (int a = 0; a < 2; ++a)
#pragma unroll
        for (int b = 0; b < 2; ++b)
#pragma unroll
            for (int m = 0; m < 4; ++m)
#pragma unroll
                for (int n = 0; n < 2; ++n) acc[a][b][m][n] = (f32x4){0.f, 0.f, 0.f, 0.f};
    bf16x8 At[4][2], B0[2][2], B1[2][2];
    unsigned ca00 = 0, ca01 = 0, ca10 = 0, ca11 = 0;
    unsigned cA, nA;
    if constexpr (GATHER) { Pb.a_fetch(cur, lds, wid); asm volatile("s_waitcnt vmcnt(0)" ::: "memory"); __builtin_amdgcn_s_barrier(); }
    Pb.e_fetch(cur, lds, wid, 0);
    { unsigned o[2][2]; Pb.a_addr(cur, Rr, Cc, o, cA, lds); ca00 = o[0][0]; ca01 = o[0][1]; ca10 = o[1][0]; ca11 = o[1][1]; }
    unsigned cB = Pb.b_base(cur);
    { const unsigned k0 = (rc & ktm) * kstep;
    PG8_STAGE_B(PG8_SB(0, 0), cB + k0); PG8_STAGE_B(PG8_SB(0, 1), cB + k0 + hstepB); PG8_STAGE_A(PG8_SA(0, 0), cA + k0, 0); PG8_STAGE_A(PG8_SA(0, 1), cA + k0, 1);
    if (wr == 1) PG8_BAR;
    PG8_WAIT_V(2); PG8_BAR;
    PG8_STAGE_B(PG8_SB(1, 0), cB + k0 + kstep); PG8_STAGE_A(PG8_SA(1, 0), cA + k0 + kstep, 0); PG8_STAGE_B(PG8_SB(1, 1), cB + k0 + hstepB + kstep); }
    PG8_WAIT_V(6); PG8_BAR;
    for (;;) {
        const bool has_next = Pb.next(ui + 1, nxt);
        unsigned nB;
        if (has_next) { if constexpr (GATHER) Pb.a_fetch(nxt, lds, wid); else { unsigned o[2][2]; Pb.a_addr(nxt, Rr, Cc, o, nA, lds); } nB = Pb.b_base(nxt); rn = Pb.rot(nxt); }
        else { nA = cA; nB = cB; rn = rc; }
        for (int t = 0; t < nt; t += 2) {
            const bool last = (t == nt - 2);
            const unsigned a1 = cA + (((unsigned)(t + 1) + rc) & ktm) * kstep;
            PG8_LDB(B0, 0, 0); PG8_LDB(B1, 0, 1); PG8_SCHED; PG8_LDA(At, 0, 0); PG8_STAGE_A(PG8_SA(1, 1), a1, 1);
            PG8_WAIT_V(8); PG8_WAIT_L(0); PG8_BAR; PG8_MMA(0, 0, At, B0); PG8_MMA(0, 1, At, B1); PG8_BAR; PG8_SCHED;
            const unsigned k2 = last ? (rn & ktm) * kstep : (((unsigned)(t + 2) + rc) & ktm) * kstep;
            const unsigned a2 = (last ? nA : cA) + k2, b2 = (last ? nB : cB) + k2;
            const unsigned a3 = a2 + kstep, b3 = b2 + kstep;
            if constexpr (GATHER) { if (last && has_next) { unsigned o[2][2]; Pb.a_addr(nxt, Rr, Cc, o, nA, lds); ca00 = o[0][0]; ca01 = o[0][1]; ca10 = o[1][0]; ca11 = o[1][1]; } }
            PG8_LDA(At, 0, 1); PG8_STAGE_B(PG8_SB(0, 0), b2); PG8_STAGE_B(PG8_SB(0, 1), b2 + hstepB); PG8_STAGE_A(PG8_SA(0, 0), a2, 0);
            PG8_WAIT_V(8); PG8_WAIT_L(0); PG8_BAR; PG8_MMA(1, 0, At, B0); PG8_MMA(1, 1, At, B1); PG8_BAR; PG8_SCHED;
            PG8_LDB(B0, 1, 0); PG8_LDB(B1, 1, 1); PG8_SCHED; PG8_LDA(At, 1, 0); PG8_STAGE_A(PG8_SA(0, 1), a2, 1);
            PG8_WAIT_V(8); PG8_WAIT_L(0); PG8_BAR; PG8_MMA(0, 0, At, B0); PG8_MMA(0, 1, At, B1); PG8_BAR; PG8_SCHED;
            PG8_LDA(At, 1, 1); PG8_STAGE_B(PG8_SB(1, 0), b3); PG8_STAGE_B(PG8_SB(1, 1), b3 + hstepB); PG8_STAGE_A(PG8_SA(1, 0), a3, 0);
            PG8_WAIT_V(8); PG8_WAIT_L(0); PG8_BAR; PG8_MMA(1, 0, At, B0); PG8_MMA(1, 1, At, B1); PG8_BAR; PG8_SCHED;
        }
        if constexpr (ALIGN_EPI) { if (wr == 0) PG8_BAR; }
        { int tl = tid; asm volatile("" : "+v"(tl));
          const int ln = tl & 63; Pb.epi(acc, cur, wr, wc, ln & 15, ln >> 4, lds + (ui & 1) * 3072); }
        if (!has_next) break;
#pragma unroll
        for (int a = 0; a < 2; ++a)
#pragma unroll
            for (int b = 0; b < 2; ++b)
#pragma unroll
                for (int m = 0; m < 4; ++m)
#pragma unroll
                    for (int n = 0; n < 2; ++n) acc[a][b][m][n] = (f32x4){0.f, 0.f, 0.f, 0.f};
        _Pragma("unroll") for (int a = 0; a < 2; ++a) _Pragma("unroll") for (int b = 0; b < 2; ++b) _Pragma("unroll") for (int m = 0; m < 4; ++m) asm volatile("" : "+v"(acc[a][b][m][0]), "+v"(acc[a][b][m][1]));
        cur = nxt; cA = nA; cB = nB; rc = rn; ++ui;
        Pb.e_fetch(cur, lds, wid, ui & 1);
        if constexpr (ALIGN_EPI) { if (wr == 1) PG8_BAR; }
    }
    PG8_WAIT_V(0);
    if constexpr (!ALIGN_EPI) { if (wr == 0) PG8_BAR; }
    PG8_BAR;
#undef PG8_SA
#undef PG8_SB
#undef PG8_STAGE_A
#undef PG8_STAGE_B
#undef PG8_LDA
#undef PG8_LDB
#undef PG8_MMA
#undef PG8_F8FRAG
#undef PG8_WAIT_V
#undef PG8_WAIT_L
#undef PG8_BAR
#undef PG8_SCHED
}
}
namespace pg8 {
#define PG8_EPI_LOOP for (int ai = 0; ai < 2; ++ai) _Pragma("unroll") for (int m = 0; m < 4; ++m) _Pragma("unroll") for (int bj = 0; bj < 2; ++bj)
__device__ __forceinline__ void rope4(const float* rope, int pos, int i0, f32x4& a, f32x4& b) {
    const f32x4 c = *(const f32x4*)(rope + pos * 32 + i0), s = *(const f32x4*)(rope + LSEQ * 32 + pos * 32 + i0);
    const f32x4 r0 = {a[0] * c[0] - a[1] * s[0], a[1] * c[0] + a[0] * s[0], a[2] * c[1] - a[3] * s[1], a[3] * c[1] + a[2] * s[1]};
    const f32x4 r1 = {b[0] * c[2] - b[1] * s[2], b[1] * c[2] + b[0] * s[2], b[2] * c[3] - b[3] * s[3], b[3] * c[3] + b[2] * s[3]};
    a = r0; b = r1;
}
__device__ __forceinline__ float clamp448(float v) { return __builtin_amdgcn_fmed3f(v, -448.0f, 448.0f); }
__device__ __forceinline__ unsigned pack4_f8(float a, float b, float c, float d) { int w = 0; w = __builtin_amdgcn_cvt_pk_fp8_f32(clamp448(a), clamp448(b), w, false); w = __builtin_amdgcn_cvt_pk_fp8_f32(clamp448(c), clamp448(d), w, true); return (unsigned)w; }
__device__ __forceinline__ unsigned long long pack8_f8(const f32x4& a, const f32x4& b) { return (unsigned long long)pack4_f8(a[0], a[1], a[2], a[3]) | ((unsigned long long)pack4_f8(b[0], b[1], b[2], b[3]) << 32); }
struct DenseBase {
    static constexpr bool F8 = false, GATHER = false; static constexpr int scaleA = 0, scaleB = 0;
    const char* A; const char* Bt; int K, lda, ldb, ldaB, ldbB; Order2D ord;
    __device__ __forceinline__ bool next(int i, Unit& u) const { return ord.next(i, u); }
    __device__ __forceinline__ unsigned rot(const Unit&) const { return 0u; }
    __device__ __forceinline__ void e_fetch(const Unit&, LAS unsigned char*, int, int) const {}
    __device__ __forceinline__ void a_addr(const Unit& u, const int (&Rr)[2], const int (&Cc)[2], unsigned (&o)[2][2], unsigned& base, LAS unsigned char*) const {
        base = (unsigned)u.pm * 256u * (unsigned)lda * 2u;
#pragma unroll
        for (int h = 0; h < 2; ++h)
#pragma unroll
            for (int i = 0; i < 2; ++i) o[h][i] = (unsigned)((h * 128 + Rr[i]) * lda * 2 + Cc[i]);
    }
    __device__ __forceinline__ unsigned b_base(const Unit& u) const { return (unsigned)u.pn * 256u * (unsigned)ldb * 2u; }
};
struct ProbP1 : DenseBase {
    bf16_t* proj; bf16_t* kr; const float* rope; float* ssqp;
    __device__ __forceinline__ void epi(const f32x4 (&acc)[2][2][4][2], const Unit& u, int wr, int wc, int fr, int fq, LAS unsigned char*) const {
        float ssq_acc[2][4];
#pragma unroll
        for (int a = 0; a < 2; ++a)
#pragma unroll
            for (int b = 0; b < 4; ++b) ssq_acc[a][b] = 0.f;
#pragma unroll
        PG8_EPI_LOOP {
            const int row = u.pm * 256 + ai * 128 + wr * 64 + m * 16 + fr, col = u.pn * 256 + bj * 128 + wc * 32 + fq * 8;
            f32x4 v0 = acc[ai][bj][m][0], v1 = acc[ai][bj][m][1];
            if (u.pn >= 4 && u.pn < 7) { const float q = (v0[0] * v0[0] + v0[1] * v0[1]) + (v0[2] * v0[2] + v0[3] * v0[3]) + (v1[0] * v1[0] + v1[1] * v1[1]) + (v1[2] * v1[2] + v1[3] * v1[3]);
                ssq_acc[ai][m] += q; }
            if (col < 1792) { *(u32x4*)(proj + (size_t)row * DM + col) = pack8(v0, v1); }
            else if (col < INW) { const int pos = (row % LP) - PADR;
                if (pos >= 0) rope4(rope, pos, (col - 1792) >> 1, v0, v1); else { v0 = (f32x4){0.f, 0.f, 0.f, 0.f}; v1 = v0; }
                *(u32x4*)(kr + (size_t)row * 64 + (col - 1792)) = pack8(v0, v1); }
        }
        if (u.pn >= 4 && u.pn < 7) {
            const int slot = u.pn < 6 ? (u.pn - 4) * 4 + wc : 8 + wc;
#pragma unroll
            for (int ai = 0; ai < 2; ++ai)
#pragma unroll
                for (int m = 0; m < 4; ++m) { float q = ssq_acc[ai][m]; q += __shfl_xor(q, 16); q += __shfl_xor(q, 32);
                    if (fq == 0) ssqp[(size_t)(u.pm * 256 + ai * 128 + wr * 64 + m * 16 + fr) * 12 + slot] = q; }
        }
    }
};
struct ProbP2q : DenseBase {
    bf16_t* qb; const float* rsq; const float* rope;
    __device__ __forceinline__ void epi(const f32x4 (&acc)[2][2][4][2], const Unit& u, int wr, int wc, int fr, int fq, LAS unsigned char*) const {
        float rsv[2][4];
#pragma unroll
        for (int ai = 0; ai < 2; ++ai)
#pragma unroll
            for (int m = 0; m < 4; ++m) { const float* pp = rsq + (size_t)(u.pm * 256 + ai * 128 + wr * 64 + m * 16 + fr) * 12; const f32x4 a = *(const f32x4*)pp, b = *(const f32x4*)(pp + 4);
                rsv[ai][m] = C2 / sqrtf(((a[0] + a[1]) + (a[2] + a[3]) + (b[0] + b[1]) + (b[2] + b[3])) * (1.0f / QLORA) + EPS); }
#pragma unroll
        PG8_EPI_LOOP {
            const int row = u.pm * 256 + ai * 128 + wr * 64 + m * 16 + fr, col = u.pn * 256 + bj * 128 + wc * 32 + fq * 8;
            const float s = rsv[ai][m]; f32x4 v0 = acc[ai][bj][m][0] * s, v1 = acc[ai][bj][m][1] * s;
            const int dd = col % QKD;
            if (dd >= QKNOPE) { const int pos = (row % LP) - PADR; if (pos >= 0) rope4(rope, pos, (dd - QKNOPE) >> 1, v0, v1); else { v0 = (f32x4){0.f, 0.f, 0.f, 0.f}; v1 = v0; } }
            *(u32x4*)(qb + (size_t)row * 1536 + col) = pack8(v0, v1);
        }
    }
};
struct ProbP2kv : DenseBase {
    bf16_t* kn; bf16_t* vb; const float* rskv;
    __device__ __forceinline__ void epi(const f32x4 (&acc)[2][2][4][2], const Unit& u, int wr, int wc, int fr, int fq, LAS unsigned char*) const {
#pragma unroll
        PG8_EPI_LOOP {
            const int row = u.pm * 256 + ai * 128 + wr * 64 + m * 16 + fr, c = wc * 32 + fq * 8;
            const f32x4 pk = *(const f32x4*)(rskv + (size_t)row * 12 + 8); const float s = 1.0f / sqrtf(((pk[0] + pk[1]) + (pk[2] + pk[3])) * (1.0f / KVLORA) + EPS); const f32x4 v0 = acc[ai][bj][m][0] * s, v1 = acc[ai][bj][m][1] * s;
            bf16_t* dst = (bj == 0 ? kn : vb) + (size_t)row * 1024 + u.pn * 128 + c;
            *(u32x4*)dst = pack8(v0, v1);
        }
    }
};
struct ProbPool : DenseBase {
    bf16_t* mix; const float* pscale;
    __device__ __forceinline__ void a_addr(const Unit& u, const int (&Rr)[2], const int (&Cc)[2], unsigned (&o)[2][2], unsigned& base, LAS unsigned char*) const {
        base = ((unsigned)u.pm * 256u * (unsigned)lda + (unsigned)u.pn * 256u) * 2u;
#pragma unroll
        for (int h = 0; h < 2; ++h)
#pragma unroll
            for (int i = 0; i < 2; ++i) o[h][i] = (unsigned)((h * 128 + Rr[i]) * lda * 2 + Cc[i]);
    }
    __device__ __forceinline__ unsigned b_base(const Unit& u) const { return (unsigned)u.pn * 65536u * 2u; }
    __device__ __forceinline__ void epi(const f32x4 (&acc)[2][2][4][2], const Unit& u, int wr, int wc, int fr, int fq, LAS unsigned char*) const {
#pragma unroll
        PG8_EPI_LOOP {
            const int row = u.pm * 256 + ai * 128 + wr * 64 + m * 16 + fr, c = u.pn * 256 + bj * 128 + wc * 32 + fq * 8;
            const f32x4 p0 = *(const f32x4*)(pscale + c), p1 = *(const f32x4*)(pscale + c + 4);
            *(u32x4*)(mix + (size_t)row * DM + c) = pack8(acc[ai][bj][m][0] * p0, acc[ai][bj][m][1] * p1);
        }
    }
};
struct ProbP4 : DenseBase {
    const float* x; float* h2; unsigned char* h2f8;
    __device__ __forceinline__ void a_addr(const Unit& u, const int (&Rr)[2], const int (&Cc)[2], unsigned (&o)[2][2], unsigned& base, LAS unsigned char*) const {
        base = (unsigned)((u.pm >> 3) * LP + 64 + (u.pm & 7) * 256) * (unsigned)lda * 2u;
#pragma unroll
        for (int h = 0; h < 2; ++h)
#pragma unroll
            for (int i = 0; i < 2; ++i) o[h][i] = (unsigned)((h * 128 + Rr[i]) * lda * 2 + Cc[i]);
    }
    __device__ __forceinline__ void epi(const f32x4 (&acc)[2][2][4][2], const Unit& u, int wr, int wc, int fr, int fq, LAS unsigned char*) const {
#pragma unroll
        PG8_EPI_LOOP {
            const int r = u.pm * 256 + ai * 128 + wr * 64 + m * 16 + fr, c = u.pn * 256 + bj * 128 + wc * 32 + fq * 8;
            const size_t off = (size_t)r * DM + c;
            const f32x4 o0 = *(const f32x4*)(x + off) + acc[ai][bj][m][0], o1 = *(const f32x4*)(x + off + 4) + acc[ai][bj][m][1];
            *(f32x4*)(h2 + off) = o0; *(f32x4*)(h2 + off + 4) = o1; *(unsigned long long*)(h2f8 + off) = pack8_f8(o0, o1);
        }
    }
};
}
namespace pg8 {
constexpr int TB_CNT = 64, TB_TE = 128, TB_TM = 416, TB_LIST = 768, TB_E0 = 1024, TB_E1 = 1280, TB_E2 = 1536;
__device__ __forceinline__ void moe_table(LAS unsigned char* lds, const unsigned* cnt, const int tid) {
    LAS int* tab = (LAS int*)(lds + TAB_OFF);
    __syncthreads();
    if (tid < NE) tab[TB_CNT + tid] = (int)__hip_atomic_load(cnt + tid, RLX_AGENT);
    __syncthreads();
    if (tid == 0) { int s = 0; for (int e = 0; e < NE; ++e) { tab[e] = s; s += (tab[TB_CNT + e] + 255) >> 8; } tab[NE] = s; }
    __syncthreads();
    if (tid < 288) { int e = 0; for (; e < NE - 1; ++e) if (tid < tab[e + 1]) break; tab[TB_TE + tid] = e; tab[TB_TM + tid] = tid - tab[e]; }
    __syncthreads();
}
#ifndef MOE_BT
#define MOE_BT 8
#endif
template <int NTN> struct MoeOrder {
    const LAS int* tab; int G, c, i0, i1;
    __device__ __forceinline__ bool next(int i_, Unit& u) const {
        const int i = i0 + i_; if (i >= i1) return false;
        const int cpx = G >> 3; const int F = (G & 7) ? i * G + c : (i * 8 + (c & 7)) * cpx + (c >> 3);
        const int ntile = __builtin_amdgcn_readfirstlane(tab[NE]); if (F >= ntile * NTN) return false;
        constexpr int BT = MOE_BT, PG = 32 / BT;
        const int blk = F / (BT * NTN), r = F - blk * (BT * NTN), nb = (ntile - blk * BT) < BT ? (ntile - blk * BT) : BT;
        int png, rr; if (nb == BT) { png = r / 32; rr = r & 31; } else { const int gs = nb * PG; png = r / gs; rr = r - png * gs; }
        const int T = blk * BT + rr / PG;
        u.aux = __builtin_amdgcn_readfirstlane(tab[TB_TE + T]); u.pm = __builtin_amdgcn_readfirstlane(tab[TB_TM + T]); u.pn = png * PG + (rr % PG); return true;
    }
};
constexpr int W_SCALE_LOG2 = 5, ACT_SCALE_LOG2 = 2;
struct ProbP6 {
    static constexpr bool F8 = true, GATHER = true; static constexpr int ldaB = DM; static constexpr int scaleB = 0x01010101 * (127 - W_SCALE_LOG2), scaleA = 0x7f7f7f7f;
    const char* A; const char* Bt; int K, ldbB; MoeOrder<16> ord;
    const int* list; const float* rsl; const float* b1; unsigned char* act;
    __device__ __forceinline__ bool next(int i, Unit& u) const { return ord.next(i, u); }
    __device__ __forceinline__ unsigned rot(const Unit& u) const { return 0u; }
    __device__ __forceinline__ void a_fetch(const Unit& u, LAS unsigned char* lds, int wid) const {
        if (wid == 0) { const __amdgpu_buffer_rsrc_t rl = __builtin_amdgcn_make_buffer_rsrc((void*)list, 0, 0x7ffffffe, 0x00020000);
            __builtin_amdgcn_raw_ptr_buffer_load_lds(rl, (LAS unsigned*)(lds + TAB_OFF + TB_LIST * 4), 16, (threadIdx.x & 63) * 16, (int)(((unsigned)u.aux * (unsigned)MR + (unsigned)u.pm * 256u) * 4u), 0, 0); }
    }
    __device__ __forceinline__ void a_addr(const Unit& u, const int (&Rr)[2], const int (&Cc)[2], unsigned (&o)[2][2], unsigned& base, LAS unsigned char* lds) const {
        base = 0u; const int cnt_e = __builtin_amdgcn_readfirstlane(ord.tab[TB_CNT + u.aux]); const LAS int* lb = (const LAS int*)(lds + TAB_OFF) + TB_LIST; const int lastv = cnt_e - 1 - u.pm * 256;
#pragma unroll
        for (int h = 0; h < 2; ++h)
#pragma unroll
            for (int i = 0; i < 2; ++i) { int sl = h * 128 + Rr[i]; sl = sl < lastv ? sl : lastv; const int tok = lb[sl] >> 2; o[h][i] = (unsigned)tok * (unsigned)DM + (unsigned)Cc[i]; }
    }
    __device__ __forceinline__ void e_fetch(const Unit& u, LAS unsigned char* lds, int wid, int par) const {
        lds += par * 3072;
        if (wid == 1) { const __amdgpu_buffer_rsrc_t r = __builtin_amdgcn_make_buffer_rsrc((void*)rsl, 0, 0x7ffffffe, 0x00020000);
            __builtin_amdgcn_raw_ptr_buffer_load_lds(r, (LAS unsigned*)(lds + TAB_OFF + TB_E0 * 4), 16, (threadIdx.x & 63) * 16, (int)(((unsigned)u.aux * (unsigned)MR + (unsigned)u.pm * 256u) * 4u), 0, 0); }
        if (wid == 2) { const __amdgpu_buffer_rsrc_t r = __builtin_amdgcn_make_buffer_rsrc((void*)b1, 0, 0x7ffffffe, 0x00020000);
            __builtin_amdgcn_raw_ptr_buffer_load_lds(r, (LAS unsigned*)(lds + TAB_OFF + TB_E1 * 4), 16, (threadIdx.x & 63) * 16, (int)(((unsigned)u.aux * 4096u + (unsigned)u.pn * 256u) * 4u), 0, 0); }
    }
    __device__ __forceinline__ unsigned b_base(const Unit& u) const { return ((unsigned)u.aux * 4096u + (unsigned)u.pn * 256u) * (unsigned)DM; }
    __device__ __forceinline__ void epi(const f32x4 (&acc)[2][2][4][2], const Unit& u, int wr, int wc, int fr, int fq, LAS unsigned char* lds) const {
        const LAS float* rsb = (const LAS float*)(lds + TAB_OFF) + TB_E0; const LAS float* bb1 = (const LAS float*)(lds + TAB_OFF) + TB_E1;
        typedef float f32x2 __attribute__((ext_vector_type(2)));
        const int cnt_e = __builtin_amdgcn_readfirstlane(ord.tab[TB_CNT + u.aux]), rbase = __builtin_amdgcn_readfirstlane(ord.tab[u.aux]) * 256;
        f32x4 bg[2], bl[2];
#pragma unroll
        for (int bj = 0; bj < 2; ++bj) { const LAS float* bp = bb1 + bj * 128 + wc * 32 + fq * 8; const f32x4 x0 = *(const LAS f32x4*)bp, x1 = *(const LAS f32x4*)(bp + 4);
            bg[bj] = (f32x4){x0[0], x0[2], x1[0], x1[2]}; bl[bj] = (f32x4){x0[1], x0[3], x1[1], x1[3]}; }
        constexpr float AS = (float)(1 << ACT_SCALE_LOG2), NC = -1.702f * 1.4426950408889634f;
#pragma unroll
        for (int ai = 0; ai < 2; ++ai)
#pragma unroll
            for (int m = 0; m < 4; ++m) {
                const int slot = u.pm * 256 + ai * 128 + wr * 64 + m * 16 + fr; const bool valid = slot < cnt_e;
                const float rs = valid ? rsb[ai * 128 + wr * 64 + m * 16 + fr] * (1.0f / (float)(1 << W_SCALE_LOG2)) : 0.f;
#pragma unroll
                for (int bj = 0; bj < 2; ++bj) {
                    const f32x4 a0 = acc[ai][bj][m][0], a1 = acc[ai][bj][m][1];
                    f32x4 g = (f32x4){a0[0], a0[2], a1[0], a1[2]} * rs + bg[bj], l = (f32x4){a0[1], a0[3], a1[1], a1[3]} * rs + bl[bj];
#pragma unroll
                    for (int q = 0; q < 4; ++q) { g[q] = fminf(g[q], 7.0f); l[q] = __builtin_amdgcn_fmed3f(l[q], -7.0f, 7.0f); }
                    f32x4 e = g * NC, lp = l * AS + AS;
#pragma unroll
                    for (int q = 0; q < 4; ++q) e[q] = __builtin_amdgcn_rcpf(1.0f + __builtin_amdgcn_exp2f(e[q]));
                    const f32x4 o = (g * e) * lp;
                    if (valid) { int w = 0; w = __builtin_amdgcn_cvt_pk_fp8_f32(o[0], o[1], w, false); w = __builtin_amdgcn_cvt_pk_fp8_f32(o[2], o[3], w, true);
                        *(unsigned*)(act + (size_t)(rbase + slot) * DFF + u.pn * 128 + bj * 64 + wc * 16 + fq * 4) = (unsigned)w; }
                }
            }
    }
};
struct ProbP7 {
    static constexpr bool F8 = true, GATHER = false; static constexpr int ldaB = DFF; static constexpr int scaleB = 0x01010101 * (127 - W_SCALE_LOG2), scaleA = 0x01010101 * (127 - ACT_SCALE_LOG2);
    const char* A; const char* Bt; int K, ldbB; MoeOrder<8> ord;
    const int* list; const float* gate; const float* b2; bf16_t* yb;
    __device__ __forceinline__ bool next(int i, Unit& u) const { return ord.next(i, u); }
    __device__ __forceinline__ unsigned rot(const Unit& u) const { return 0u; }
    __device__ __forceinline__ void a_addr(const Unit& u, const int (&Rr)[2], const int (&Cc)[2], unsigned (&o)[2][2], unsigned& base, LAS unsigned char*) const {
        base = (unsigned)(__builtin_amdgcn_readfirstlane(ord.tab[u.aux]) + u.pm) * 256u * (unsigned)DFF;
#pragma unroll
        for (int h = 0; h < 2; ++h)
#pragma unroll
            for (int i = 0; i < 2; ++i) o[h][i] = (unsigned)((h * 128 + Rr[i]) * DFF + Cc[i]);
    }
    __device__ __forceinline__ void e_fetch(const Unit& u, LAS unsigned char* lds, int wid, int par) const {
        lds += par * 3072;
        const int so = (int)(((unsigned)u.aux * (unsigned)MR + (unsigned)u.pm * 256u) * 4u);
        if (wid == 1) { const __amdgpu_buffer_rsrc_t r = __builtin_amdgcn_make_buffer_rsrc((void*)gate, 0, 0x7ffffffe, 0x00020000);
            __builtin_amdgcn_raw_ptr_buffer_load_lds(r, (LAS unsigned*)(lds + TAB_OFF + TB_E0 * 4), 16, (threadIdx.x & 63) * 16, so, 0, 0); }
        if (wid == 2) { const __amdgpu_buffer_rsrc_t r = __builtin_amdgcn_make_buffer_rsrc((void*)b2, 0, 0x7ffffffe, 0x00020000);
            __builtin_amdgcn_raw_ptr_buffer_load_lds(r, (LAS unsigned*)(lds + TAB_OFF + TB_E1 * 4), 16, (threadIdx.x & 63) * 16, (int)(((unsigned)u.aux * (unsigned)DM + (unsigned)u.pn * 256u) * 4u), 0, 0); }
        if (wid == 3) { const __amdgpu_buffer_rsrc_t r = __builtin_amdgcn_make_buffer_rsrc((void*)list, 0, 0x7ffffffe, 0x00020000);
            __builtin_amdgcn_raw_ptr_buffer_load_lds(r, (LAS unsigned*)(lds + TAB_OFF + TB_E2 * 4), 16, (threadIdx.x & 63) * 16, so, 0, 0); }
    }
    __device__ __forceinline__ unsigned b_base(const Unit& u) const { return ((unsigned)u.aux * (unsigned)DM + (unsigned)u.pn * 256u) * (unsigned)DFF; }
    __device__ __forceinline__ void epi(const f32x4 (&acc)[2][2][4][2], const Unit& u, int wr, int wc, int fr, int fq, LAS unsigned char* lds) const {
        const int cnt_e = __builtin_amdgcn_readfirstlane(ord.tab[TB_CNT + u.aux]);
        const LAS float* gtb = (const LAS float*)(lds + TAB_OFF) + TB_E0; const LAS float* bb2 = (const LAS float*)(lds + TAB_OFF) + TB_E1; const LAS int* idb = (const LAS int*)(lds + TAB_OFF) + TB_E2;
        const int col = u.pn * 256 + wc * 32 + fq * 8;
        f32x4 bb[2][2];
#pragma unroll
        for (int bj = 0; bj < 2; ++bj) { const LAS float* bp = bb2 + bj * 128 + wc * 32 + fq * 8; bb[bj][0] = *(const LAS f32x4*)bp; bb[bj][1] = *(const LAS f32x4*)(bp + 4); }
#pragma unroll
        for (int ai = 0; ai < 2; ++ai)
#pragma unroll
            for (int m = 0; m < 4; ++m) {
                const int rl = ai * 128 + wr * 64 + m * 16 + fr, slot = u.pm * 256 + rl; const bool valid = slot < cnt_e;
                const int id = valid ? idb[rl] : 0; const float g = valid ? gtb[rl] : 0.f, gs = g * (1.0f / (float)(1 << (W_SCALE_LOG2 + ACT_SCALE_LOG2)));
                bf16_t* orow = yb + (size_t)id * DM + col;
#pragma unroll
                for (int bj = 0; bj < 2; ++bj) {
                    const f32x4 y0 = acc[ai][bj][m][0] * gs + bb[bj][0] * g, y1 = acc[ai][bj][m][1] * gs + bb[bj][1] * g;
                    if (valid) *(u32x4*)(orow + bj * 128) = pack8(y0, y1);
                }
            }
    }
};
}
namespace att {
using f32x16 = __attribute__((ext_vector_type(16))) float;
using s16x4 = __attribute__((ext_vector_type(4))) short;
constexpr int SHM_V = 16384, SHM_KN = 16384, SHM_KR = 8192, SHM_BUF = SHM_V + SHM_KN + SHM_KR, NBUF = 3, WS_OFF = NBUF * SHM_BUF;
#define ATT_SBAR() __builtin_amdgcn_sched_barrier(0)
__device__ __forceinline__ int crow(int r, int hi) { return (r & 3) + 8 * (r >> 2) + 4 * hi; }
__device__ __forceinline__ unsigned cvtpk(float lo, float hi) { unsigned r; asm volatile("v_cvt_pk_bf16_f32 %0, %1, %2" : "=v"(r) : "v"(lo), "v"(hi)); return r; }
__device__ __forceinline__ int v_st(int k, int c) { const int kk = (k & ~0xC) | ((k & 4) << 1) | ((k & 8) >> 1); return ((kk >> 3) * 4 + (c >> 5)) * 512 + ((kk & 7) * 32 + (c & 31)) * 2; }
__device__ __forceinline__ int v_rd_base(int lane) { return ((lane & 3) << 3) | (((lane >> 2) & 3) << 6) | (((lane >> 4) & 1) << 5) | (((lane >> 5) & 1) << 8); }
constexpr int v_rd_off(int d0, int ks, int half) { return d0 * 512 + ks * 4096 + half * 2048; }
template <int OFF> __device__ __forceinline__ s16x4 tr_read(int vb) { s16x4 r; asm volatile("ds_read_b64_tr_b16 %0, %1 offset:%2" : "=&v"(r) : "v"(vb), "i"(OFF) : "memory"); return r; }
template <int D0> __device__ __forceinline__ void pv_one(f32x16& od, int vb, bf16x8 pa0, bf16x8 pa1, bf16x8 pa2, bf16x8 pa3) {
    const s16x4 l0 = tr_read<v_rd_off(D0, 0, 0)>(vb), h0 = tr_read<v_rd_off(D0, 0, 1)>(vb), l1 = tr_read<v_rd_off(D0, 1, 0)>(vb), h1 = tr_read<v_rd_off(D0, 1, 1)>(vb);
    const s16x4 l2 = tr_read<v_rd_off(D0, 2, 0)>(vb), h2 = tr_read<v_rd_off(D0, 2, 1)>(vb), l3 = tr_read<v_rd_off(D0, 3, 0)>(vb), h3 = tr_read<v_rd_off(D0, 3, 1)>(vb);
    asm volatile("s_waitcnt lgkmcnt(0)" ::: "memory"); ATT_SBAR();
#define ATT_PK(L, H) (bf16x8){L[0], L[1], L[2], L[3], H[0], H[1], H[2], H[3]}
    od = __builtin_amdgcn_mfma_f32_32x32x16_bf16(pa0, ATT_PK(l0, h0), od, 0, 0, 0);
    od = __builtin_amdgcn_mfma_f32_32x32x16_bf16(pa1, ATT_PK(l1, h1), od, 0, 0, 0);
    od = __builtin_amdgcn_mfma_f32_32x32x16_bf16(pa2, ATT_PK(l2, h2), od, 0, 0, 0);
    od = __builtin_amdgcn_mfma_f32_32x32x16_bf16(pa3, ATT_PK(l3, h3), od, 0, 0, 0);
#undef ATT_PK
}
template <int D0, int HK> __device__ __forceinline__ void pv_half(f32x16& od, int vb, bf16x8 pa0, bf16x8 pa1) {
    const s16x4 l0 = tr_read<v_rd_off(D0, 2 * HK, 0)>(vb), h0 = tr_read<v_rd_off(D0, 2 * HK, 1)>(vb), l1 = tr_read<v_rd_off(D0, 2 * HK + 1, 0)>(vb), h1 = tr_read<v_rd_off(D0, 2 * HK + 1, 1)>(vb);
    asm volatile("s_waitcnt lgkmcnt(0)" ::: "memory"); ATT_SBAR();
#define ATT_PK(L, H) (bf16x8){L[0], L[1], L[2], L[3], H[0], H[1], H[2], H[3]}
    od = __builtin_amdgcn_mfma_f32_32x32x16_bf16(pa0, ATT_PK(l0, h0), od, 0, 0, 0);
    od = __builtin_amdgcn_mfma_f32_32x32x16_bf16(pa1, ATT_PK(l1, h1), od, 0, 0, 0);
#undef ATT_PK
}
__device__ __forceinline__ void attn_unit(int b, int h, int u, const bf16_t* __restrict__ QB, const bf16_t* __restrict__ KN, const bf16_t* __restrict__ KR, const bf16_t* __restrict__ VB,
                                          bf16_t* __restrict__ MIX, LAS char* lds, const int tid) {
    const int wid = tid >> 6, lane = tid & 63, r32 = lane & 31, hi = lane >> 5;
    const int qc = (0x22331100u >> (4 * wid)) & 3, half = wid & 1;
    const int c0 = 4 * u - 3, ntw = c0 + qc + 1, ntmax = 4 * u + 1;
    const size_t rowb = (size_t)b * LP;
    const int qrow0 = 64 * (c0 + qc) + 32 * half;
    LAS float* wsf = (LAS float*)(lds + WS_OFF) + wid * 64; LAS float* li_l = wsf; LAS float* al_l = wsf + 32;
    bf16x8 qr[12];
    { const bf16_t* Qw = QB + (rowb + qrow0 + r32) * 1536 + h * QKD + hi * 8;
#pragma unroll
      for (int d0 = 0; d0 < 12; ++d0) qr[d0] = *(const bf16x8*)(Qw + d0 * 16); }
    unsigned gk0, gv0, gr;
    { const int w = wid;
      { const int row = 32 * (w & 1) + (lane >> 1), hh = (lane & 1) ^ ((row >> 3) & 1);
        gk0 = (unsigned)(row * 1024 + h * 128 + (w >> 1) * 16 + hh * 8); gr = (unsigned)(row * 64 + (w >> 1) * 16 + hh * 8); }
      { const int st = 4 * w + (lane >> 5), kk = (st >> 2) * 8 + ((lane >> 2) & 7), k = (kk & ~0xC) | ((kk & 4) << 1) | ((kk & 8) >> 1), c = (st & 3) * 32 + (lane & 3) * 8; gv0 = (unsigned)(k * 1024 + h * 128 + c); } }
    const bf16_t* KNb = KN + rowb * 1024; const bf16_t* VBb = VB + rowb * 1024; const bf16_t* KRb = KR + rowb * 64;
    const unsigned wq = (unsigned)wid * 2048u, wk = (unsigned)wid * 1024u;
    const int kb0 = (int)(uintptr_t)lds + SHM_V + r32 * 32 + ((hi ^ ((r32 >> 3) & 1)) << 4);
    const int vb0 = (int)(uintptr_t)lds + v_rd_base(lane);
#define ATT_DMA(gp, lp) __builtin_amdgcn_global_load_lds((const unsigned*)(gp), (LAS unsigned*)(lp), 16, 0, 0)
#define ATT_STAGE(j_, bf_) do { LAS char* bb_ = lds + (bf_) * SHM_BUF; const size_t ko_ = (size_t)(j_) * 64; \
    ATT_DMA(KNb + ko_ * 1024 + gk0, bb_ + SHM_V + wk); ATT_DMA(KNb + ko_ * 1024 + gk0 + 64, bb_ + SHM_V + 8192 + wk); \
    ATT_DMA(VBb + ko_ * 1024 + gv0, bb_ + wq); ATT_DMA(VBb + ko_ * 1024 + gv0 + 64, bb_ + wq + 1024); ATT_DMA(KRb + ko_ * 64 + gr, bb_ + SHM_V + 16384 + wk); } while (0)
#define ATT_WAIT_BAR(N) asm volatile("s_waitcnt vmcnt(" #N ") lgkmcnt(0)\n\ts_barrier" ::: "memory")
    float m_reg = -1e30f, l_reg = 0.f; f32x16 o[4];
#pragma unroll
    for (int d = 0; d < 4; ++d)
#pragma unroll
        for (int r = 0; r < 16; ++r) o[d][r] = 0.f;
    ATT_STAGE(0, 0); if (ntmax > 1) { ATT_STAGE(1, 1); ATT_WAIT_BAR(5); } else { ATT_WAIT_BAR(0); }
    int bf = 0;
    for (int j = 0; j < ntmax; ++j) {
        const int bf2 = bf == 0 ? 2 : bf - 1;
        const bool st2 = j + 2 < ntmax;
        if (st2) ATT_STAGE(j + 2, bf2);
        if (j < ntw) {
            const int vb = vb0 + bf * SHM_BUF, kb = kb0 + bf * SHM_BUF;
#pragma unroll
            for (int hk = 0; hk < 2; ++hk) {
                if (j == 0 && hk == 0) continue;
                f32x16 p0;
#pragma unroll
                for (int r = 0; r < 16; ++r) p0[r] = 0.f;
#pragma unroll
                for (int d0 = 0; d0 < 12; ++d0) {
                    const bf16x8 b0 = *(const LAS bf16x8*)(uintptr_t)(unsigned)(kb + d0 * 2048 + hk * 1024);
                    p0 = __builtin_amdgcn_mfma_f32_32x32x16_bf16(b0, qr[d0], p0, 0, 0, 0); }
                if (j == 0) {
#pragma unroll
                    for (int r = 0; r < 8; ++r) p0[r] = -1e30f;
                }
                float pmax = p0[0];
#pragma unroll
                for (int r = 1; r < 16; ++r) pmax = fmaxf(pmax, p0[r]);
                { auto sw = __builtin_amdgcn_permlane32_swap(__float_as_uint(pmax), __float_as_uint(pmax), false, false); pmax = fmaxf(__uint_as_float(sw[0]), __uint_as_float(sw[1])); }
                float mn, alpha;
                if (__all(pmax - m_reg <= 8.0f)) { mn = m_reg; alpha = 1.f; }
                else { mn = fmaxf(m_reg, pmax); alpha = __builtin_amdgcn_exp2f(m_reg - mn); m_reg = mn; }
                float ps = 0.f;
#pragma unroll
                for (int r = 0; r < 16; ++r) { p0[r] = __builtin_amdgcn_exp2f(p0[r] - mn); ps += p0[r]; }
                { auto sw = __builtin_amdgcn_permlane32_swap(__float_as_uint(ps), __float_as_uint(ps), false, false); ps = __uint_as_float(sw[0]) + __uint_as_float(sw[1]); }
                l_reg = l_reg * alpha + ps;
                bf16x8 pa0, pa1;
#define ATT_PK4(Pv, BASE, OUT) do { unsigned a0 = cvtpk(Pv[BASE + 0], Pv[BASE + 1]), a1 = cvtpk(Pv[BASE + 2], Pv[BASE + 3]); \
    unsigned b0_ = cvtpk(Pv[BASE + 4], Pv[BASE + 5]), b1_ = cvtpk(Pv[BASE + 6], Pv[BASE + 7]); \
    auto r0 = __builtin_amdgcn_permlane32_swap(a0, b0_, false, false); auto r1 = __builtin_amdgcn_permlane32_swap(a1, b1_, false, false); \
    u32x4 w = {r0[0], r1[0], r0[1], r1[1]}; OUT = *reinterpret_cast<bf16x8*>(&w); } while (0)
                ATT_PK4(p0, 0, pa0); ATT_PK4(p0, 8, pa1);
#undef ATT_PK4
                if (__any(alpha < 1.f)) { if (hi == 0) al_l[r32] = alpha; asm volatile("s_waitcnt lgkmcnt(0)" ::: "memory");
#pragma unroll
                    for (int d = 0; d < 4; ++d)
#pragma unroll
                        for (int r = 0; r < 16; ++r) o[d][r] *= al_l[crow(r, hi)]; }
                if (hk == 0) { pv_half<0, 0>(o[0], vb, pa0, pa1); pv_half<1, 0>(o[1], vb, pa0, pa1); pv_half<2, 0>(o[2], vb, pa0, pa1); pv_half<3, 0>(o[3], vb, pa0, pa1); }
                else         { pv_half<0, 1>(o[0], vb, pa0, pa1); pv_half<1, 1>(o[1], vb, pa0, pa1); pv_half<2, 1>(o[2], vb, pa0, pa1); pv_half<3, 1>(o[3], vb, pa0, pa1); }
            }
        }
        if (st2) ATT_WAIT_BAR(5); else ATT_WAIT_BAR(0);
        bf = bf == 2 ? 0 : bf + 1;
    }
    if (hi == 0) li_l[r32] = l_reg;
    asm volatile("s_waitcnt lgkmcnt(0)" ::: "memory");
    bf16_t* Ow = MIX + (rowb + qrow0) * DM + POOLW + h * 128 + r32;
#pragma unroll
    for (int r = 0; r < 16; ++r) { const int orow = crow(r, hi); const float rli = __builtin_amdgcn_rcpf(li_l[orow]);
#pragma unroll
        for (int d0 = 0; d0 < 4; ++d0) Ow[(size_t)orow * DM + d0 * 32] = (bf16_t)f2bf(o[d0][r] * rli); }
#undef ATT_DMA
#undef ATT_STAGE
#undef ATT_WAIT_BAR
}
__device__ __forceinline__ void attn_phase(const unsigned char* ws, unsigned char* wsw, LAS char* lds, int G, int bx, const int tid) {
    const bf16_t* QB = (const bf16_t*)(ws + WS_QB); const bf16_t* KN = (const bf16_t*)(ws + WS_KN); const bf16_t* KR = (const bf16_t*)(ws + WS_KR); const bf16_t* VB = (const bf16_t*)(ws + WS_VB);
    bf16_t* MIX = (bf16_t*)(wsw + WS_MIX);
    for (int c = bx; c < 256; c += G) {
        const int x = c & 7, y = c >> 3, bh = 8 * (y >> 2) + x, p = y & 3, b = bh >> 3, h = bh & 7;
#pragma unroll 1
        for (int k = 0; k < 2; ++k) attn_unit(b, h, k == 0 ? 8 - p : 1 + p, QB, KN, KR, VB, MIX, lds, tid);
    }
}
}
#define XB_TMO      128
#define XB_XCNT(j)  (256  + 64 * (j))
#define XB_XSUB(j)  (1280 + 64 * (j))
#define XB_XGEN(j)  (2304 + 64 * (j))
#define XB_TOP      3328
#define XB_TOPGEN   3392
#define XCD_BAR_WORDS 3456
#define XB_SPIN_CAP (1u << 18)
__device__ __forceinline__ unsigned xb_ld(unsigned* p)              { return __hip_atomic_load(p, __ATOMIC_RELAXED, __HIP_MEMORY_SCOPE_AGENT); }
__device__ __forceinline__ unsigned xb_add(unsigned* p, unsigned v) { return __hip_atomic_fetch_add(p, v, __ATOMIC_RELAXED, __HIP_MEMORY_SCOPE_AGENT); }
__device__ __forceinline__ unsigned xb_xcc_id() { return (unsigned)__builtin_amdgcn_s_getreg((3 << 11) | 20) & 0xFu; }
#define XB_SPIN(cond, bar) do { unsigned _sp = 0; while (cond) { __builtin_amdgcn_s_sleep(1); \
    if ((++_sp & 255u) == 0u) { if (xb_ld(&(bar)[XB_TMO])) break; if (_sp > XB_SPIN_CAP) { atomicAdd(&(bar)[XB_TMO], 1u); break; } } } } while (0)
struct XcdBarrier { unsigned* bar; unsigned x; volatile LAS unsigned* st; };
__device__ __forceinline__ XcdBarrier xcd_barrier_post(unsigned* bar, volatile LAS unsigned* st) {
    XcdBarrier b; b.bar = bar; b.x = xb_xcc_id(); b.st = st;
    if (threadIdx.x == 0) (void)xb_add(&bar[XB_XCNT(b.x)], 1u);
    return b;
}
__device__ __forceinline__ void xcd_barrier_complete(unsigned* bar, unsigned x, unsigned& nloc, unsigned& nx) {
    const unsigned G = gridDim.x * gridDim.y * gridDim.z;
    unsigned sum, cnt, mine, sp = 0u;
    for (;;) {
        sum = 0u; cnt = 0u; mine = 0u;
#pragma unroll
        for (unsigned j = 0; j < 16; ++j) { const unsigned c = xb_ld(&bar[XB_XCNT(j)]); sum += c; cnt += (c > 0u) ? 1u : 0u; mine = (j == x) ? c : mine; }
        if (sum == G) break;
        __builtin_amdgcn_s_sleep(1);
        if ((++sp & 255u) == 0u) { if (xb_ld(&bar[XB_TMO])) break; if (sp > XB_SPIN_CAP) { atomicAdd(&bar[XB_TMO], 1u); break; } }
    }
    nloc = mine > 0u ? mine : 1u; nx = cnt > 0u ? cnt : 1u;
}
__device__ __forceinline__ void xcd_barrier(const XcdBarrier& b) {
    asm volatile("s_waitcnt vmcnt(0)" ::: "memory");
    __syncthreads();
    if (threadIdx.x == 0) {
        unsigned* bar = b.bar;
        __builtin_amdgcn_s_waitcnt(0);
        unsigned nloc = b.st[0], nx = b.st[1];
        if (nloc == 0u) { xcd_barrier_complete(bar, b.x, nloc, nx); b.st[0] = nloc; b.st[1] = nx; }
        const unsigned old = xb_add(&bar[XB_XSUB(b.x)], 1u);
        const unsigned gen = old / nloc;
        if (old + 1u == (gen + 1u) * nloc) {
            __builtin_amdgcn_fence(__ATOMIC_RELEASE, "agent");
            asm volatile("s_waitcnt vmcnt(0)" ::: "memory");
            const unsigned og = xb_add(&bar[XB_TOP], 1u);
            const unsigned tg = og / nx;
            if (og + 1u == (tg + 1u) * nx) xb_add(&bar[XB_TOPGEN], 1u);
            else XB_SPIN(xb_ld(&bar[XB_TOPGEN]) == tg, bar);
            __builtin_amdgcn_fence(__ATOMIC_ACQUIRE, "agent");
            xb_add(&bar[XB_XGEN(b.x)], 1u);
            asm volatile("s_waitcnt vmcnt(0)" ::: "memory");
        } else {
            XB_SPIN(xb_ld(&bar[XB_XGEN(b.x)]) == gen, bar);
            __builtin_amdgcn_fence(__ATOMIC_ACQUIRE, "agent");
            asm volatile("s_waitcnt vmcnt(0)" ::: "memory");
        }
    }
    __syncthreads();
}
constexpr int CW_BAR = 4096;

constexpr int CVS_P1 = 0, CVS_P2 = 3072, CVS_P3 = 4352, CVS_P3B = 8192, CVS_P4 = 8448, CVS_P6 = 11776;
static_assert(CVS_P1 + 16 * 7 + 80 * 13 + 160 * 12 == CVS_P2 && CVS_P2 + 140 * 4 + 24 * 7 + 92 * 6 == CVS_P3 && CVS_P3 + 256 * 15 == CV_ITEMS_W1 && CVS_P3B == CV_ITEMS_W1 && CVS_P3B + 256 == CVS_P4 && CVS_P4 + 256 * 13 == CVS_P6 && CVS_P6 + 512 == CV_ITEMS, "conversion plan");
constexpr int PH_P0 = 0, PH_P1 = 1, PH_P1B = 2, PH_P2 = 3, PH_P3 = 4, PH_P4 = 5, PH_P5 = 6, PH_P6 = 7, PH_P7 = 8, PH_P8 = 9, PH_END = 10;
struct Args { Ptrs P; int ph_lo, ph_hi, use_bar, pad; };
#define CAS __attribute__((address_space(4)))
__device__ __forceinline__ void load_ptrs(const CAS Args* a, Ptrs& P) { P.x = a->P.x; P.meta = a->P.meta; P.g_attn = a->P.g_attn; P.w_in = a->P.w_in; P.g_q = a->P.g_q; P.w_uq = a->P.w_uq; P.g_kv = a->P.g_kv; P.w_ukv = a->P.w_ukv; P.pool_w = a->P.pool_w; P.pool_scale = a->P.pool_scale; P.w_o = a->P.w_o; P.g_ffn = a->P.g_ffn; P.w_router = a->P.w_router; P.b_router = a->P.b_router; P.w1 = a->P.w1; P.b1 = a->P.b1; P.w2 = a->P.w2; P.b2 = a->P.b2; P.g_final = a->P.g_final; P.out = a->P.out; P.ws = a->P.ws; }
__global__ void __launch_bounds__(NWAVES * 64, 2) mk_fwd(Args args) {
    extern __shared__ __attribute__((aligned(16))) unsigned char lds_raw[];
    LAS unsigned char* lds = (LAS unsigned char*)lds_raw;
    const int G = gridDim.x, bx = blockIdx.x;
#define PHASE_IDS int tid; asm volatile("v_mov_b32 %0, %1" : "=v"(tid) : "v"(threadIdx.x)); const int lane = tid & 63, wave = __builtin_amdgcn_readfirstlane(tid >> 6); \
    const long gw = (long)bx * NWAVES + wave, NGW = (long)G * NWAVES; (void)lane; (void)gw; (void)NGW; \
    const CAS Args* ap_ = (const CAS Args*)__builtin_amdgcn_kernarg_segment_ptr(); asm volatile("" : "+s"(ap_)); Ptrs P; load_ptrs(ap_, P); unsigned char* const ws = P.ws
    volatile LAS unsigned* MISC = (volatile LAS unsigned*)(lds + MISC_OFF);
    if (threadIdx.x < 64) MISC[threadIdx.x] = 0u;
    __syncthreads();
    XcdBarrier bar; bar.bar = (unsigned*)(args.P.ws + WS_CTL) + CW_BAR; bar.x = 0; bar.st = nullptr;
    if (args.use_bar) bar = xcd_barrier_post((unsigned*)(args.P.ws + WS_CTL) + CW_BAR, MISC + 8);
    const int lo = args.ph_lo, hi = args.ph_hi;
#define IN(k) (lo <= (k) && (k) < hi)
    const bool cv_first = ((bx >> 3) & 1) != 0;
#define CV_CALL(W1, F, S, N) do { const CAS Args* ap2_ = (const CAS Args*)__builtin_amdgcn_kernarg_segment_ptr(); asm volatile("" : "+s"(ap2_)); Ptrs Pc_; load_ptrs(ap2_, Pc_); cv_slice<W1>(Pc_, lds_raw, tid, (F), (S), (N)); } while (0)
#define CV_DEAL(W1, S, ca, ka, cb, kb, kc) do { if (G == 256) { int f_, s_, n_; if (bx < (ca)) { f_ = (S) + bx; s_ = (ca); n_ = (ka); } else if (bx < (cb)) { f_ = (S) + (ca) * (ka) + (bx - (ca)); s_ = (cb) - (ca); n_ = (kb); } \
        else { f_ = (S) + (ca) * (ka) + ((cb) - (ca)) * (kb) + (bx - (cb)); s_ = 256 - (cb); n_ = (kc); } CV_CALL(W1, f_, s_, n_); } \
    else { const int tot_ = (ca) * (ka) + ((cb) - (ca)) * (kb) + (256 - (cb)) * (kc); for (int it_ = (S) + bx; it_ < (S) + tot_; it_ += G) CV_CALL(W1, it_, 0, 1); } } while (0)
#define CV_SLICE(W1, S, N) CV_DEAL(W1, S, 0, 0, 0, 0, N)
#define SEAM(k) do { if (IN(k) && IN((k) + 1)) xcd_barrier(bar); } while (0)

    if (IN(PH_P0)) { PHASE_IDS;
        float* scr = (float*)lds_raw + wave * (64 * 65);
        for (long it = gw; it < I_TOTAL; it += NGW) p0_item(P, it, scr, lane);
        for (long p = gw; p < MP; p += NGW) p0_hn_row(P, (int)p, lane);
        { u32x4* z = (u32x4*)(ws + WS_WIN + (size_t)INW * DM * 2); const long n16 = (long)(DM - INW) * DM * 2 / 16;
          for (long i = (long)bx * 512 + tid; i < n16; i += (long)G * 512) z[i] = (u32x4){0u, 0u, 0u, 0u}; }
        { float* ct = (float*)(ws + WS_ROPE); float* st = ct + LSEQ * 32;
          for (long i = (long)bx * 512 + tid; i < LSEQ * 32; i += (long)G * 512) { const int pos = (int)(i / 32), j = (int)(i % 32);
              const float inv = 1.0f / powf(10000.0f, (float)(2 * j) / 64.0f); const float ang = (float)pos * inv; ct[i] = cosf(ang); st[i] = sinf(ang); } }
        { float* wr = (float*)(ws + WS_WR);
          for (long i = (long)bx * 512 + tid; i < DM * NE; i += (long)G * 512) { const int k = (int)(i / NE), e = (int)(i % NE); wr[((k >> 2) * NE + e) * 4 + (k & 3)] = P.w_router[i] * P.g_ffn[k]; } }
        __syncthreads();
    }
    SEAM(PH_P0);
    if (IN(PH_P1)) { PHASE_IDS;
        pg8::ProbP1 pb; pb.A = (const char*)(ws + WS_HN); pb.Bt = (const char*)(ws + WS_WIN); pb.K = DM; pb.lda = DM; pb.ldaB = 2 * DM; pb.ldb = DM; pb.ldbB = 2 * DM; pb.ord.init(MP / 256, 8, G, bx);
        pb.proj = (bf16_t*)(ws + WS_PROJ); pb.kr = (bf16_t*)(ws + WS_KR); pb.rope = (const float*)(ws + WS_ROPE); pb.ssqp = (float*)(ws + WS_RSQ);
        if (cv_first) CV_DEAL(true, CVS_P1, 16, 7, 96, 13, 12);
        pg8::gemm_phase<pg8::ProbP1, true>(lds + RING_OFF, pb, tid);
        if (!cv_first) CV_DEAL(true, CVS_P1, 16, 7, 96, 13, 12);
    }
    if (IN(PH_P1) && IN(PH_P2)) xcd_barrier(bar);
    if (IN(PH_P2)) { PHASE_IDS;
        for (long m = gw; m < MP; m += NGW) p1b_row(P, (int)m, lane);
        if (cv_first) CV_DEAL(true, CVS_P2, 140, 4, 164, 7, 6);
        { pg8::ProbP2q pb; pb.A = (const char*)(ws + WS_PROJ) + 1024 * 2; pb.Bt = (const char*)(ws + WS_WUQ); pb.K = QLORA; pb.lda = DM; pb.ldaB = 2 * DM; pb.ldb = QLORA; pb.ldbB = 2 * QLORA; pb.ord.init(MP / 256, 6, G, bx);
          pb.qb = (bf16_t*)(ws + WS_QB); pb.rsq = (const float*)(ws + WS_RSQ); pb.rope = (const float*)(ws + WS_ROPE);
          pg8::gemm_phase<pg8::ProbP2q, true>(lds + RING_OFF, pb, tid); }
        { pg8::ProbP2kv pb; pb.A = (const char*)(ws + WS_PROJ) + 1536 * 2; pb.Bt = (const char*)(ws + WS_WUKV); pb.K = KVLORA; pb.lda = DM; pb.ldaB = 2 * DM; pb.ldb = KVLORA; pb.ldbB = 2 * KVLORA; pb.ord.init(MP / 256, 8, G, (bx + 116) % G);
          pb.kn = (bf16_t*)(ws + WS_KN); pb.vb = (bf16_t*)(ws + WS_VB); pb.rskv = (const float*)(ws + WS_RSQ);
          pg8::gemm_phase<pg8::ProbP2kv, true>(lds + RING_OFF, pb, tid); }
        if (!cv_first) CV_DEAL(true, CVS_P2, 140, 4, 164, 7, 6);
    }
    SEAM(PH_P2);
    if (IN(PH_P3)) { PHASE_IDS;
        if (cv_first) { CV_SLICE(true, CVS_P3, 15); CV_SLICE(false, CVS_P3B, 1); }
        att::attn_phase(ws, ws, (LAS char*)(lds + RING_OFF), G, bx, tid);
        { pg8::ProbPool pb; pb.A = (const char*)(ws + WS_DP); pb.Bt = (const char*)(ws + WS_WPOOL); pb.K = 256; pb.lda = POOLW; pb.ldaB = 2 * POOLW; pb.ldb = 256; pb.ldbB = 2 * 256; pb.ord.init(MP / 256, 4, G, bx);
          pb.mix = (bf16_t*)(ws + WS_MIX); pb.pscale = P.pool_scale;
          pg8::gemm_phase<pg8::ProbPool, true>(lds + RING_OFF, pb, tid); }
        if (!cv_first) { CV_SLICE(true, CVS_P3, 15); CV_SLICE(false, CVS_P3B, 1); }
    }
    SEAM(PH_P3);
    if (IN(PH_P4)) { PHASE_IDS;
        pg8::ProbP4 pb; pb.A = (const char*)(ws + WS_MIX); pb.Bt = (const char*)(ws + WS_WO); pb.K = DM; pb.lda = DM; pb.ldaB = 2 * DM; pb.ldb = DM; pb.ldbB = 2 * DM; pb.ord.init(MR / 256, 8, G, bx);
        pb.x = P.x; pb.h2 = P.out; pb.h2f8 = ws + WS_H2B;
        pg8::gemm_phase<pg8::ProbP4, true>(lds + RING_OFF, pb, tid);
    }
    SEAM(PH_P4);
    if (IN(PH_P5)) { PHASE_IDS; for (int blk = bx; blk < MR / 64; blk += G) p5_block(P, blk, lds_raw, tid); }
    SEAM(PH_P5);
    if (IN(PH_P6)) { PHASE_IDS;
        pg8::moe_table(lds, (const unsigned*)(ws + WS_CTL) + CW_CNT, tid);
        pg8::ProbP6 pb; pb.A = (const char*)(ws + WS_H2B); pb.Bt = (const char*)(ws + WS_W1); pb.K = DM; pb.ldbB = DM; pb.ord.tab = (const LAS int*)(lds + TAB_OFF); pb.ord.G = G; pb.ord.c = bx;
        pb.list = (const int*)(ws + WS_LIST); pb.rsl = (const float*)(ws + WS_RSL); pb.b1 = P.b1; pb.act = ws + WS_ACT;
        const int split = 2 + 4 * ((bx >> 3) & 3);
        pb.ord.i0 = 0; pb.ord.i1 = split;
        pg8::gemm_phase<pg8::ProbP6, true>(lds + RING_OFF, pb, tid);
        CV_SLICE(false, CVS_P4, 13);
        pb.ord.i0 = split; pb.ord.i1 = 0x7fffffff;
        pg8::gemm_phase<pg8::ProbP6, true>(lds + RING_OFF, pb, tid);
        { const int U = ((const LAS int*)(lds + TAB_OFF))[NE] * 16, R = U % G, nidle = G - R, rank0 = (G & 7) ? bx : (bx & 7) * (G >> 3) + (bx >> 3);
          const bool few = nidle < 64; const int nshare = few ? G : nidle, rank = few ? rank0 : rank0 - R;
          if (rank >= 0) { const int cnt_ = (CV_ITEMS - CVS_P6 - rank + nshare - 1) / nshare; CV_CALL(false, CVS_P6 + rank, nshare, cnt_); } }
    }
    SEAM(PH_P6);
    if (IN(PH_P7)) { PHASE_IDS;
        pg8::moe_table(lds, (const unsigned*)(ws + WS_CTL) + CW_CNT, tid);
        pg8::ProbP7 pb; pb.A = (const char*)(ws + WS_ACT); pb.Bt = (const char*)(ws + WS_W2); pb.K = DFF; pb.ldbB = DFF; pb.ord.tab = (const LAS int*)(lds + TAB_OFF); pb.ord.G = G; pb.ord.c = bx; pb.ord.i0 = 0; pb.ord.i1 = 0x7fffffff;
        pb.list = (const int*)(ws + WS_LIST); pb.gate = (const float*)(ws + WS_GATE); pb.b2 = P.b2; pb.yb = (bf16_t*)(ws + WS_YB);
        pg8::gemm_phase<pg8::ProbP7, true>(lds + RING_OFF, pb, tid);
    }
    SEAM(PH_P7);
    if (IN(PH_P8)) { PHASE_IDS; for (long r = gw; r < MR; r += NGW) p8_row(P, (int)r, lane, P.out); }
#undef IN
#undef SEAM
}

extern "C" void kernel_launch(void* const* d_in, const int* in_sizes, int n_in, void* d_out, int out_size, void* d_ws, size_t ws_size, hipStream_t stream) {
    static int ok = 0; static int grid = 256;
    if (ok == 0) {
        if (n_in != 19 || in_sizes[0] != NB * SEQ * DM || out_size != MR * DM || ws_size < WS_END) { fprintf(stderr, "kernel_launch: shape mismatch n_in %d in0 %d out %d ws %zu\n", n_in, n_in > 0 ? in_sizes[0] : -1, out_size, ws_size); ok = -1; return; }
        if (hipFuncSetAttribute((const void*)mk_fwd, hipFuncAttributeMaxDynamicSharedMemorySize, LDS_BYTES) != hipSuccess) { fprintf(stderr, "hipFuncSetAttribute(mk) failed\n"); ok = -1; return; }
        int dev = 0, cus = 0; (void)hipGetDevice(&dev); (void)hipDeviceGetAttribute(&cus, hipDeviceAttributeMultiprocessorCount, dev); if (cus > 0) grid = cus;
        ok = 1;
    }
    if (ok < 0) return;
    Ptrs P{};
    const float** pp = (const float**)&P;
    for (int i = 0; i < 19; ++i) pp[i] = (const float*)d_in[i];
    P.out = (float*)d_out; P.ws = (unsigned char*)d_ws;
    unsigned char* ws = (unsigned char*)d_ws;
    (void)hipMemsetAsync(ws + WS_CTL, 0, CTL_ZERO_BYTES, stream);
    { Args a{}; a.P = P; a.ph_lo = 0; a.ph_hi = PH_END; a.use_bar = 1; a.pad = 0;
      hipLaunchKernelGGL(mk_fwd, dim3(grid), dim3(NWAVES * 64), LDS_BYTES, stream, a); }
}
```

```cpp
#include <hip/hip_runtime.h>
#include <cstdint>
#include <cstdio>

constexpr int NB = 8, SEQ = 2048, NMETA = 16, LSEQ = 2064, LP = 2112, PADR = 48, MP = NB * LP, MR = NB * SEQ;
constexpr int DM = 2048, POOLW = 1024, QLORA = 512, KVLORA = 256, QKROPE = 64, QKNOPE = 128, VDIM = 128, NH = 8, QKD = 192;
constexpr int INW = 1856, NE = 32, TOPK = 4, DFF = 2048;
constexpr float EPS = 1e-5f;
constexpr float C2 = 0.07216878364870322f * 1.4426950408889634f;
constexpr int ACT_ROWS = MR * TOPK + NE * 256;

typedef unsigned short bf16_t;
typedef unsigned u32x4 __attribute__((ext_vector_type(4)));
typedef float f32x4 __attribute__((ext_vector_type(4)));

constexpr size_t MiB = 1u << 20;
constexpr size_t WS_CTL = 0, CTL_ZERO_BYTES = 1 * MiB;
constexpr size_t WS_ROPE = 1 * MiB;
constexpr size_t WS_WR = 2 * MiB;
constexpr size_t WS_WIN = 4 * MiB;
constexpr size_t WS_WUQ = 12 * MiB;
constexpr size_t WS_WUKV = 14 * MiB;
constexpr size_t WS_WPOOL = 15 * MiB;
constexpr size_t WS_WO = 16 * MiB;
constexpr size_t WS_W1 = 24 * MiB;
constexpr size_t WS_W2 = 536 * MiB;
constexpr size_t WS_HN = 792 * MiB;
constexpr size_t WS_PROJ = 860 * MiB;
constexpr size_t WS_QB = 928 * MiB;
constexpr size_t WS_KN = 980 * MiB;
constexpr size_t WS_VB = 1014 * MiB;
constexpr size_t WS_KR = 1048 * MiB;
constexpr size_t WS_RSQ = 1051 * MiB;
constexpr size_t WS_RSKV = 1052 * MiB;
constexpr size_t WS_RS2 = 1053 * MiB;
constexpr size_t WS_DP = 1054 * MiB;
constexpr size_t WS_MIX = 1088 * MiB;
constexpr size_t WS_H2B = 1156 * MiB;
constexpr size_t WS_LIST = 1220 * MiB;
constexpr size_t WS_GATE = 1222 * MiB;
constexpr size_t WS_ACT = 1224 * MiB;
constexpr size_t WS_YB = 1512 * MiB;
constexpr size_t WS_RSL = 1768 * MiB;
constexpr size_t WS_END = 1770 * MiB;
constexpr int CW_CNT = 64;

struct Ptrs {
    const float *x, *meta, *g_attn, *w_in, *g_q, *w_uq, *g_kv, *w_ukv, *pool_w, *pool_scale, *w_o, *g_ffn, *w_router, *b_router, *w1, *b1, *w2, *b2, *g_final;
    float* out; unsigned char* ws;
};

__device__ __forceinline__ float bf2f(bf16_t v) { return __uint_as_float((unsigned)v << 16); }
__device__ __forceinline__ unsigned f2bf(float f) { unsigned u = __float_as_uint(f); return (u + 0x7fffu + ((u >> 16) & 1u)) >> 16; }
__device__ __forceinline__ unsigned pk2(float lo, float hi) { return f2bf(lo) | (f2bf(hi) << 16); }
__device__ __forceinline__ float wave_sum(float v) {
#pragma unroll
    for (int o = 1; o < 64; o <<= 1) v += __shfl_xor(v, o);
    return v;
}
__device__ __forceinline__ float wave_max(float v) {
#pragma unroll
    for (int o = 1; o < 64; o <<= 1) v = fmaxf(v, __shfl_xor(v, o));
    return v;
}

__device__ __forceinline__ void p0_hn_row(const Ptrs& P, int p, int lane) {
    bf16_t* hn = (bf16_t*)(P.ws + WS_HN) + (size_t)p * DM;
    const int b = p / LP, q = p % LP;
    unsigned long long* o8 = (unsigned long long*)hn + lane;
    if (q < PADR) {
#pragma unroll
        for (int j = 0; j < 8; ++j) o8[64 * j] = 0ull;
        return;
    }
    const int pos = q - PADR;
    const float* src = pos < NMETA ? P.meta + (size_t)pos * DM : P.x + ((size_t)b * SEQ + (pos - NMETA)) * DM;
    const f32x4* xr = (const f32x4*)src + lane;
    const f32x4* gr = (const f32x4*)P.g_attn + lane;
    f32x4 v[8]; float s = 0.f;
#pragma unroll
    for (int j = 0; j < 8; ++j) { v[j] = xr[64 * j]; s += (v[j].x * v[j].x + v[j].y * v[j].y) + (v[j].z * v[j].z + v[j].w * v[j].w); }
    const float rs = 1.0f / sqrtf(wave_sum(s) * (1.0f / DM) + EPS);
#pragma unroll
    for (int j = 0; j < 8; ++j) { const f32x4 g = gr[64 * j];
        o8[64 * j] = (unsigned long long)pk2(v[j].x * rs * g.x, v[j].y * rs * g.y) | ((unsigned long long)pk2(v[j].z * rs * g.z, v[j].w * rs * g.w) << 32); }
}
template <int MODE> __device__ __forceinline__ int nmap(int n) {
    if (MODE == 1) { if (n >= 1792) { const int j = n - 1792; return 1792 + (j < 32 ? 2 * j : 2 * (j - 32) + 1); } return n; }
    if (MODE == 2) { const int h = n / 192, d = n % 192; if (d >= 128) { const int j = d - 128; return h * 192 + 128 + (j < 32 ? 2 * j : 2 * (j - 32) + 1); } return n; }
    return n;
}
template <int MODE> __device__ __forceinline__ void p0_transpose_item(const float* W, int K, int N, bf16_t* WT, const float* gk, float* scr, int item, int lane) {
    const int nblk = N / 64, kb = item / nblk, nb = item % nblk, k0 = 64 * kb, n0 = 64 * nb;
    const int kl = lane >> 4, nl = (lane & 15) * 4;
#pragma unroll 4
    for (int i = 0; i < 16; ++i) { const int kk = kl + 4 * i; const f32x4 v = *(const f32x4*)(W + (size_t)(k0 + kk) * N + n0 + nl);
        const float g = gk ? gk[k0 + kk] : 1.0f;
        float* s = scr + kk * 65 + nl; s[0] = v.x * g; s[1] = v.y * g; s[2] = v.z * g; s[3] = v.w * g; }
    __builtin_amdgcn_s_waitcnt(0xc07f); asm volatile("" ::: "memory");
    const int c = lane & 7;
#pragma unroll
    for (int j = 0; j < 8; ++j) { const int n = (lane >> 3) + 8 * j; const float* s = scr + (8 * c) * 65 + n;
        u32x4 o; o.x = pk2(s[0 * 65], s[1 * 65]); o.y = pk2(s[2 * 65], s[3 * 65]); o.z = pk2(s[4 * 65], s[5 * 65]); o.w = pk2(s[6 * 65], s[7 * 65]);
        *(u32x4*)(WT + (size_t)nmap<MODE>(n0 + n) * K + k0 + 8 * c) = o; }
    __builtin_amdgcn_s_waitcnt(0xc07f); asm volatile("" ::: "memory");
}
__device__ __forceinline__ void p0_transpose_item_f8(const float* W, int K, int N, unsigned char* WT, const float* gk, float scale, float* scr, int item, int lane) {
    const int nblk = N / 64, kb = item / nblk, nb = item % nblk, k0 = 64 * kb, n0 = 64 * nb;
    const int kl = lane >> 4, nl = (lane & 15) * 4;
#pragma unroll 4
    for (int i = 0; i < 16; ++i) { const int kk = kl + 4 * i; const f32x4 v = *(const f32x4*)(W + (size_t)(k0 + kk) * N + n0 + nl);
        const float g = (gk ? gk[k0 + kk] : 1.0f) * scale;
        float* s = scr + kk * 65 + nl; s[0] = v.x * g; s[1] = v.y * g; s[2] = v.z * g; s[3] = v.w * g; }
    asm volatile("s_waitcnt lgkmcnt(0)" ::: "memory");
    const int c = lane & 7;
#pragma unroll
    for (int j = 0; j < 8; ++j) { const int n = (lane >> 3) + 8 * j; const float* s = scr + (8 * c) * 65 + n;
        int w0 = 0, w1 = 0;
        w0 = __builtin_amdgcn_cvt_pk_fp8_f32(s[0 * 65], s[1 * 65], w0, false); w0 = __builtin_amdgcn_cvt_pk_fp8_f32(s[2 * 65], s[3 * 65], w0, true);
        w1 = __builtin_amdgcn_cvt_pk_fp8_f32(s[4 * 65], s[5 * 65], w1, false); w1 = __builtin_amdgcn_cvt_pk_fp8_f32(s[6 * 65], s[7 * 65], w1, true);
        *(unsigned long long*)(WT + (size_t)(n0 + n) * K + k0 + 8 * c) = (unsigned long long)(unsigned)w0 | ((unsigned long long)(unsigned)w1 << 32); }
    asm volatile("s_waitcnt lgkmcnt(0)" ::: "memory");
}
constexpr int CV_ITEMS_W1 = NE * (DM / 128) * (4096 / 256), CV_ITEMS_W2 = NE * (DFF / 128) * (DM / 256), CV_ITEMS = CV_ITEMS_W1 + CV_ITEMS_W2;
struct CvItem { const float* src; unsigned char* dst; const float* gk; };
template <bool W1> __device__ __forceinline__ CvItem cv_decode(const Ptrs& P, int it) {
    CvItem c;
    if (W1) { const int e = it >> 8, r = it & 255, kb = r >> 4, nb = r & 15;
        c.src = P.w1 + (size_t)e * DM * 4096 + (size_t)kb * 128 * 4096 + nb * 256; c.dst = P.ws + WS_W1 + ((size_t)e * 4096 + nb * 256) * DM + kb * 128; c.gk = P.g_ffn + kb * 128; }
    else { const int j = it - CV_ITEMS_W1, e = j >> 7, r = j & 127, kb = r >> 3, nb = r & 7;
        c.src = P.w2 + (size_t)e * DFF * DM + (size_t)kb * 128 * DM + nb * 256; c.dst = P.ws + WS_W2 + ((size_t)e * DM + nb * 256) * DFF + kb * 128; c.gk = nullptr; }
    return c;
}
#define CV_LOAD(V, C) do { const __amdgpu_buffer_rsrc_t rs_ = __builtin_amdgcn_make_buffer_rsrc((void*)(C).src, 0, 0x7ffffffe, 0x00020000); \
        _Pragma("unroll") for (int i_ = 0; i_ < 16; ++i_) V[i_] = __builtin_bit_cast(f32x4, __builtin_amdgcn_raw_buffer_load_b128(rs_, lane * 16, (wave + 8 * i_) * NN * 4, 2  )); } while (0)
#define CV_PROCESS(V, C, NEXT_IDX) do { \
        _Pragma("unroll") for (int i_ = 0; i_ < 16; ++i_) { const int k_ = wave + 8 * i_; const float g_ = W1 ? (C).gk[k_] * 32.0f : 32.0f; float* s_ = scr + k_ * 257 + lane * 4; \
            s_[0] = V[i_].x * g_; s_[1] = V[i_].y * g_; s_[2] = V[i_].z * g_; s_[3] = V[i_].w * g_; } \
        unsigned char* dst_ = (C).dst; \
        { const int nx_ = (NEXT_IDX) < count ? (NEXT_IDX) : count - 1; (C) = cv_decode<W1>(P, first + nx_ * step); CV_LOAD(V, C); } \
        asm volatile("s_waitcnt lgkmcnt(0)\n\ts_barrier" ::: "memory"); \
          \
        _Pragma("unroll") for (int p_ = 0; p_ < 4; ++p_) { const int u_ = p_ * 8 + wave, nn_ = (u_ >> 1) * 16 + (lane >> 2), k0_ = (u_ & 1) * 64 + (lane & 3) * 16; \
            const float* t_ = scr + k0_ * 257 + nn_; u32x4 w_; \
            _Pragma("unroll") for (int d_ = 0; d_ < 4; ++d_) { int x_ = 0; x_ = __builtin_amdgcn_cvt_pk_fp8_f32(t_[(4 * d_) * 257], t_[(4 * d_ + 1) * 257], x_, false); \
                x_ = __builtin_amdgcn_cvt_pk_fp8_f32(t_[(4 * d_ + 2) * 257], t_[(4 * d_ + 3) * 257], x_, true); w_[d_] = (unsigned)x_; } \
            *(u32x4*)(dst_ + (size_t)nn_ * DM + k0_) = w_; } \
        asm volatile("s_waitcnt lgkmcnt(0)\n\ts_barrier" ::: "memory"); } while (0)
template <bool W1> __device__ __forceinline__ void cv_slice(const Ptrs& P, unsigned char* ldsg, int tid, int first, int step, int count) {
    if (count <= 0) return;
    constexpr int NN = W1 ? 4096 : DM;
    float* scr = (float*)ldsg;
    const int lane = tid & 63, wave = __builtin_amdgcn_readfirstlane(tid >> 6);
    f32x4 va[16];
    CvItem ca = cv_decode<W1>(P, first);
    CV_LOAD(va, ca);
    for (int n = 0; n < count; ++n) CV_PROCESS(va, ca, n + 1);
    asm volatile("s_waitcnt vmcnt(0)" ::: "memory");
}
#undef CV_LOAD
#undef CV_PROCESS
constexpr int I_WIN = (DM / 64) * (INW / 64), I_WUQ = (QLORA / 64) * (1536 / 64), I_WUKV = (KVLORA / 64) * (2048 / 64), I_POOL1 = 4 * 4, I_WO = 32 * 32,
              I_W1E = (DM / 64) * (4096 / 64), I_W2E = 32 * 32;
constexpr int I_SMALL = I_WIN + I_WUQ + I_WUKV + 4 * I_POOL1 + I_WO;
constexpr long I_TOTAL = (long)I_SMALL;
__device__ __forceinline__ void p0_item(const Ptrs& P, long it, float* scr, int lane) {
    unsigned char* ws = P.ws;
    if (it < I_SMALL) {
        int r = (int)it;
        if (r < I_WIN) { p0_transpose_item<1>(P.w_in, DM, INW, (bf16_t*)(ws + WS_WIN), nullptr, scr, r, lane); return; } r -= I_WIN;
        if (r < I_WUQ) { p0_transpose_item<2>(P.w_uq, QLORA, 1536, (bf16_t*)(ws + WS_WUQ), P.g_q, scr, r, lane); return; } r -= I_WUQ;
        if (r < I_WUKV) { p0_transpose_item<0>(P.w_ukv, KVLORA, 2048, (bf16_t*)(ws + WS_WUKV), P.g_kv, scr, r, lane); return; } r -= I_WUKV;
        if (r < 4 * I_POOL1) { const int g = r / I_POOL1; p0_transpose_item<0>(P.pool_w + (size_t)g * 65536, 256, 256, (bf16_t*)(ws + WS_WPOOL) + (size_t)g * 65536, nullptr, scr, r % I_POOL1, lane); return; } r -= 4 * I_POOL1;
        p0_transpose_item<0>(P.w_o, DM, DM, (bf16_t*)(ws + WS_WO), nullptr, scr, r, lane); return;
    }
    it -= I_SMALL;
    if (it < (long)NE * I_W1E) { const int e = (int)(it / I_W1E), r = (int)(it % I_W1E);
        p0_transpose_item_f8(P.w1 + (size_t)e * DM * 4096, DM, 4096, ws + WS_W1 + (size_t)e * 4096 * DM, P.g_ffn, 32.0f, scr, r, lane); return; }
    it -= (long)NE * I_W1E;
    { const int e = (int)(it / I_W2E), r = (int)(it % I_W2E);
      p0_transpose_item_f8(P.w2 + (size_t)e * DFF * DM, DFF, DM, ws + WS_W2 + (size_t)e * DM * DFF, nullptr, 32.0f, scr, r, lane); }
}
__device__ __forceinline__ void st4bf(bf16_t* p, float a, float b, float c, float d) { *(unsigned long long*)p = (unsigned long long)pk2(a, b) | ((unsigned long long)pk2(c, d) << 32); }
__device__ __forceinline__ void p1b_row(const Ptrs& P, int m, int lane) {
    const bf16_t* proj = (const bf16_t*)(P.ws + WS_PROJ);
    const bf16_t* row = proj + (size_t)m * DM;
    bf16_t* dp = (bf16_t*)(P.ws + WS_DP) + (size_t)m * POOLW;
    const int pos = (m % LP) - PADR;
    if (pos < 0) {
#pragma unroll
        for (int g = 0; g < 4; ++g) *(unsigned long long*)(dp + g * 256 + lane * 4) = 0ull;
        return;
    }
    unsigned long long ld[30];
    { int q = 0;
#pragma unroll
      for (int g = 0; g < 4; ++g)
#pragma unroll
          for (int j = 0; j < (2 << g); ++j) { const int jj = j < pos ? j : pos; ld[q++] = *(const unsigned long long*)(row - (size_t)jj * DM + g * 256 + lane * 4); } }
    { int q = 0;
#pragma unroll
      for (int g = 0; g < 4; ++g) { const int w = 2 << g; const int cntw = pos + 1 < w ? pos + 1 : w;
        float s0 = 0.f, s1 = 0.f, s2 = 0.f, s3 = 0.f, u0 = 0.f, u1 = 0.f, u2 = 0.f, u3 = 0.f;
#pragma unroll
        for (int j = 0; j < w; ++j) { const unsigned long long v = ld[q++]; const unsigned lo = (unsigned)v, hi = (unsigned)(v >> 32);
            const float mk = j < cntw ? 1.0f : 0.0f;
            const float a = __uint_as_float(lo << 16) * mk, b2 = __uint_as_float(lo & 0xffff0000u) * mk, cc = __uint_as_float(hi << 16) * mk, d = __uint_as_float(hi & 0xffff0000u) * mk;
            if (j == 0) { u0 = a; u1 = b2; u2 = cc; u3 = d; } s0 += a; s1 += b2; s2 += cc; s3 += d; }
        const float ic = 1.0f / (float)cntw;
        st4bf(dp + g * 256 + lane * 4, s0 * ic - u0, s1 * ic - u1, s2 * ic - u2, s3 * ic - u3); } }
}
typedef float f32x16_t __attribute__((ext_vector_type(16)));
__device__ __forceinline__ void p5_block(const Ptrs& P, int blk, unsigned char* ldsg, int tid) {
    const int lane = tid & 63, wave = tid >> 6, t = lane & 31, kk = lane >> 5, tg = wave >> 2, kq = wave & 3;
    float* part = (float*)ldsg;
    float* ssqp = part + 8 * 32 * 33;
    const bf16_t* arow = (const bf16_t*)(P.ws + WS_HN) + (size_t)(blk * 64 + tg * 32 + t) * DM + kq * 512 + 16 * kk;
    const f32x4* bptr = (const f32x4*)(P.ws + WS_WR) + ((kq * 128 + 4 * kk) * NE + t);
    f32x16_t acc;
#pragma unroll
    for (int r = 0; r < 16; ++r) acc[r] = 0.f;
    float ss = 0.f;
#pragma unroll 2
    for (int j = 0; j < 16; ++j) {
        f32x4 a[4], b[4]; const u32x4 d0 = *(const u32x4*)(arow + 32 * j), d1 = *(const u32x4*)(arow + 32 * j + 8);
#pragma unroll
        for (int q = 0; q < 4; ++q) b[q] = bptr[(8 * j + q) * NE];
        a[0] = (f32x4){__uint_as_float(d0[0] << 16), __uint_as_float(d0[0] & 0xffff0000u), __uint_as_float(d0[1] << 16), __uint_as_float(d0[1] & 0xffff0000u)};
        a[1] = (f32x4){__uint_as_float(d0[2] << 16), __uint_as_float(d0[2] & 0xffff0000u), __uint_as_float(d0[3] << 16), __uint_as_float(d0[3] & 0xffff0000u)};
        a[2] = (f32x4){__uint_as_float(d1[0] << 16), __uint_as_float(d1[0] & 0xffff0000u), __uint_as_float(d1[1] << 16), __uint_as_float(d1[1] & 0xffff0000u)};
        a[3] = (f32x4){__uint_as_float(d1[2] << 16), __uint_as_float(d1[2] & 0xffff0000u), __uint_as_float(d1[3] << 16), __uint_as_float(d1[3] & 0xffff0000u)};
#pragma unroll
        for (int q = 0; q < 4; ++q) {
            ss += (a[q].x * a[q].x + a[q].y * a[q].y) + (a[q].z * a[q].z + a[q].w * a[q].w);
            acc = __builtin_amdgcn_mfma_f32_32x32x2f32(a[q].x, b[q].x, acc, 0, 0, 0); acc = __builtin_amdgcn_mfma_f32_32x32x2f32(a[q].y, b[q].y, acc, 0, 0, 0);
            acc = __builtin_amdgcn_mfma_f32_32x32x2f32(a[q].z, b[q].z, acc, 0, 0, 0); acc = __builtin_amdgcn_mfma_f32_32x32x2f32(a[q].w, b[q].w, acc, 0, 0, 0);
        }
    }
    ss += __shfl_xor(ss, 32);
#pragma unroll
    for (int r = 0; r < 16; ++r) part[(wave * 32 + ((r & 3) + 8 * (r >> 2) + 4 * kk)) * 33 + t] = acc[r];
    if (kk == 0) ssqp[wave * 32 + t] = ss;
    __syncthreads();
    if (tid < 64) {
        const int tg2 = tid >> 5, ti = tid & 31, r = blk * 64 + tid;
        float lg[NE];
#pragma unroll
        for (int e = 0; e < NE; ++e) lg[e] = (part[((tg2 * 4 + 0) * 32 + ti) * 33 + e] + part[((tg2 * 4 + 1) * 32 + ti) * 33 + e]) + (part[((tg2 * 4 + 2) * 32 + ti) * 33 + e] + part[((tg2 * 4 + 3) * 32 + ti) * 33 + e]);
        const float ssq = (ssqp[(tg2 * 4 + 0) * 32 + ti] + ssqp[(tg2 * 4 + 1) * 32 + ti]) + (ssqp[(tg2 * 4 + 2) * 32 + ti] + ssqp[(tg2 * 4 + 3) * 32 + ti]);
        const float rs = 1.0f / sqrtf(ssq * (1.0f / DM) + EPS);
#pragma unroll
        for (int e = 0; e < NE; ++e) lg[e] = lg[e] * rs + P.b_router[e];
        ((float*)(P.ws + WS_RS2))[r] = rs;
        int idx[TOPK]; float val[TOPK]; unsigned used = 0u;
#pragma unroll
        for (int k = 0; k < TOPK; ++k) { float best = -INFINITY; int bi = 0;
#pragma unroll
            for (int e = 0; e < NE; ++e) { const bool ok = !((used >> e) & 1u) && lg[e] > best; best = ok ? lg[e] : best; bi = ok ? e : bi; }
            used |= 1u << bi; idx[k] = bi; val[k] = best; }
        float den = 0.f, pe[TOPK];
#pragma unroll
        for (int k = 0; k < TOPK; ++k) { pe[k] = __expf(val[k] - val[0]); den += pe[k]; }
        unsigned* cnt = (unsigned*)(P.ws + WS_CTL) + CW_CNT; int* list = (int*)(P.ws + WS_LIST); float* gate = (float*)(P.ws + WS_GATE); float* rsl = (float*)(P.ws + WS_RSL);
        unsigned* lcnt = (unsigned*)(ssqp + 8 * 32); unsigned* lbase = lcnt + NE;
        if (tid < NE) lcnt[tid] = 0u;
        unsigned rk[TOPK];
#pragma unroll
        for (int k = 0; k < TOPK; ++k) rk[k] = __hip_atomic_fetch_add(lcnt + idx[k], 1u, __ATOMIC_RELAXED, __HIP_MEMORY_SCOPE_WORKGROUP);
        if (tid < NE) { const unsigned n = lcnt[tid]; lbase[tid] = n ? atomicAdd(cnt + tid, n) : 0u; }
#pragma unroll
        for (int k = 0; k < TOPK; ++k) { const unsigned slot = lbase[idx[k]] + rk[k]; const size_t o = (size_t)idx[k] * MR + slot; list[o] = r * 4 + k; gate[o] = pe[k] / den; rsl[o] = rs; }
    }
    __syncthreads();
}
__device__ __forceinline__ void p8_row(const Ptrs& P, int r, int lane, float* outbase) {
    const bf16_t* h2 = (const bf16_t*)(P.ws + WS_HN) + (size_t)r * DM; float* orow = outbase + (size_t)r * DM; const unsigned char* yb = P.ws + WS_YB + (size_t)r * 4 * DM;
    f32x4 v[8]; float s = 0.f;
#pragma unroll
    for (int j = 0; j < 8; ++j) { const int c = 4 * lane + 256 * j;
        { const unsigned long long y = *(const unsigned long long*)(h2 + c); const unsigned lo = (unsigned)y, hi = (unsigned)(y >> 32);
          v[j] = (f32x4){__uint_as_float(lo << 16), __uint_as_float(lo & 0xffff0000u), __uint_as_float(hi << 16), __uint_as_float(hi & 0xffff0000u)}; }
#pragma unroll
        for (int k = 0; k < 4; ++k) { const unsigned y = *(const unsigned*)(yb + (size_t)k * DM + c); typedef float f2_t __attribute__((ext_vector_type(2)));
            const f2_t lo = __builtin_amdgcn_cvt_pk_f32_fp8((int)y, false), hi = __builtin_amdgcn_cvt_pk_f32_fp8((int)y, true);
            v[j].x += lo.x * (1.0f / 16.0f); v[j].y += lo.y * (1.0f / 16.0f); v[j].z += hi.x * (1.0f / 16.0f); v[j].w += hi.y * (1.0f / 16.0f); }
        s += (v[j].x * v[j].x + v[j].y * v[j].y) + (v[j].z * v[j].z + v[j].w * v[j].w); }
    const float rs = 1.0f / sqrtf(wave_sum(s) * (1.0f / DM) + EPS);
#pragma unroll
    for (int j = 0; j < 8; ++j) { const int c = 4 * lane + 256 * j; const f32x4 g = *(const f32x4*)(P.g_final + c);
        __builtin_nontemporal_store((f32x4){v[j].x * rs * g.x, v[j].y * rs * g.y, v[j].z * rs * g.z, v[j].w * rs * g.w}, (f32x4*)(orow + c)); }
}
#define LAS __attribute__((address_space(3)))
#define GAS __attribute__((address_space(1)))
typedef short bf16x8 __attribute__((ext_vector_type(8)));
typedef int v4i_t __attribute__((ext_vector_type(4)));
typedef GAS unsigned gu32;
#define RLX_AGENT __ATOMIC_RELAXED, __HIP_MEMORY_SCOPE_AGENT
constexpr int NWAVES = 8;
constexpr int RING_OFF = 0, RING_BYTES = 131072;
constexpr int TAB_OFF = 133 * 1024;
constexpr int MISC_OFF = 143 * 1024;
constexpr int LDS_BYTES = 147456;

namespace pg8 {
constexpr int BM = 256, BK = 64, HALF = 128, HTB = HALF * BK * 2, NXCD = 8, WGM = 8;
__host__ __device__ __forceinline__ int lds_byte(int r, int c) { const int st = (r >> 4) * 2 + (c >> 5), rr = r & 15, cc = c & 31, ob = rr * 64 + cc * 2; return st * 1024 + (ob ^ (((ob >> 9) & 1) << 5)); }
__host__ __device__ __forceinline__ void stage_rc(int b, int& R, int& C) { const int st = b / 1024, sb = b % 1024, swz = sb ^ (((sb >> 9) & 1) << 5); R = (st >> 1) * 16 + swz / 64; C = (st & 1) * 32 + (swz % 64) / 2; }
__host__ __device__ __forceinline__ void stage_rc_f8(int b, int& R, int& Cb) { const int s = b >> 4; R = s >> 3; const int q = s & 7; Cb = 32 * ((q >> 1) ^ ((R >> 1) & 3)) + 16 * (q & 1); }
__host__ __device__ __forceinline__ int perm32(int rho) { const int n = rho >> 4, i = rho & 15; return 8 * (i >> 2) + 4 * n + (i & 3); }
struct Unit { int pm, pn, aux; };
__device__ __forceinline__ unsigned cvt_pk_bf16(float lo, float hi) { unsigned r; asm volatile("v_cvt_pk_bf16_f32 %0, %1, %2" : "=v"(r) : "v"(lo), "v"(hi)); return r; }
__device__ __forceinline__ u32x4 pack8(const f32x4& a, const f32x4& b) { u32x4 w; w.x = cvt_pk_bf16(a[0], a[1]); w.y = cvt_pk_bf16(a[2], a[3]); w.z = cvt_pk_bf16(b[0], b[1]); w.w = cvt_pk_bf16(b[2], b[3]); return w; }

struct Order2D {
    int nM, nN, nwg, G, c;
    __device__ __forceinline__ void init(int nM_, int nN_, int G_, int c_) { nM = nM_; nN = nN_; nwg = nM * nN; G = G_; c = c_; }
    __device__ __forceinline__ bool next(int i, Unit& u) const {
        const long L = (long)i * G + c; if (L >= nwg) return false;
        int wgid = (int)L; { const int q = nwg / NXCD, r = nwg % NXCD, xcd = wgid % NXCD, off = wgid / NXCD; wgid = (xcd < r ? xcd * (q + 1) : r * (q + 1) + (xcd - r) * q) + off; }
        const int nig = WGM * nN, gid = wgid / nig, fm = gid * WGM, gsz = (nM - fm) < WGM ? (nM - fm) : WGM;
        u.pm = fm + ((wgid % nig) % gsz); u.pn = (wgid % nig) / gsz; u.aux = 0; return true;
    }
};

template <class Prob, bool ALIGN_EPI>
__device__ __forceinline__ void gemm_phase(LAS unsigned char* lds, const Prob& Pb, const int tid) {
    const int wid = __builtin_amdgcn_readfirstlane(tid >> 6), lane = tid & 63, wr = wid >> 2, wc = wid & 3, fr = lane & 15, fq = lane >> 4;
    constexpr bool F8 = Prob::F8;
    const int nt = F8 ? Pb.K / 128 : Pb.K / BK;
    constexpr bool GATHER = Prob::GATHER;
    int Rr[2], Cc[2]; unsigned voffB, voffA = 0u;
    { int R, C; if (F8) stage_rc_f8(tid * 16, R, C); else { stage_rc(tid * 16, R, C); C *= 2; }
      Rr[0] = R; Rr[1] = R + 64; Cc[0] = C; Cc[1] = C; const int Rb = (R & ~31) + perm32(R & 31); voffB = (unsigned)(Rb * Pb.ldbB + C);
      if constexpr (!GATHER) voffA = (unsigned)(R * Pb.ldaB + C); }
    const unsigned r64B = 64u * (unsigned)Pb.ldbB, r64A = GATHER ? 0u : 64u * (unsigned)Pb.ldaB;
    const unsigned kstep = 128u;
    const unsigned hstepB = (unsigned)HALF * Pb.ldbB;
    const unsigned ldsw = (unsigned)wid * 1024u;
    const int aoff = F8 ? (wr * 64 + fr) * 128 + ((fq ^ ((fr >> 1) & 3)) * 32) : lds_byte(wr * 64 + fr, fq * 8);
    const int boff = F8 ? (wc * 32 + fr) * 128 + ((fq ^ ((fr >> 1) & 3)) * 32) : lds_byte(wc * 32 + fr, fq * 8);
    const int aoff8 = aoff + (fq & 1) * 16, boff8 = boff + (fq & 1) * 16;
#define PG8_SA(b, h) (((b) * 2 + (h)) * HTB)
#define PG8_SB(b, h) ((4 + (b) * 2 + (h)) * HTB)
    const __amdgpu_buffer_rsrc_t rsA = __builtin_amdgcn_make_buffer_rsrc((void*)Pb.A, 0, 0x7ffffffe, 0x00020000), rsB = __builtin_amdgcn_make_buffer_rsrc((void*)Pb.Bt, 0, 0x7ffffffe, 0x00020000);
#define PG8_STAGE_B(bufoff, so) do { \
        __builtin_amdgcn_raw_ptr_buffer_load_lds(rsB, (LAS unsigned*)(lds + (bufoff) + ldsw), 16, voffB, (int)(so), 0, 0); \
        __builtin_amdgcn_raw_ptr_buffer_load_lds(rsB, (LAS unsigned*)(lds + (bufoff) + ldsw + 8192), 16, voffB, (int)((so) + r64B), 0, 0); } while (0)
#define PG8_STAGE_A(bufoff, so, h) do { if constexpr (GATHER) { \
        __builtin_amdgcn_raw_ptr_buffer_load_lds(rsA, (LAS unsigned*)(lds + (bufoff) + ldsw), 16, (h) ? ca10 : ca00, (int)(so), 0, 0); \
        __builtin_amdgcn_raw_ptr_buffer_load_lds(rsA, (LAS unsigned*)(lds + (bufoff) + ldsw + 8192), 16, (h) ? ca11 : ca01, (int)(so), 0, 0); } else { \
        __builtin_amdgcn_raw_ptr_buffer_load_lds(rsA, (LAS unsigned*)(lds + (bufoff) + ldsw), 16, voffA, (int)((so) + (h) * 2u * r64A), 0, 0); \
        __builtin_amdgcn_raw_ptr_buffer_load_lds(rsA, (LAS unsigned*)(lds + (bufoff) + ldsw + 8192), 16, voffA, (int)((so) + (h) * 2u * r64A + r64A), 0, 0); } } while (0)
#define PG8_LDA(dst, b, h) do { if constexpr (F8) { _Pragma("unroll") for (int m = 0; m < 4; ++m) { dst[m][0] = *(const LAS bf16x8*)(lds + PG8_SA(b, h) + m * 2048 + aoff8); dst[m][1] = *(const LAS bf16x8*)(lds + PG8_SA(b, h) + m * 2048 + (aoff8 ^ 16)); } } \
        else { _Pragma("unroll") for (int m = 0; m < 4; ++m) _Pragma("unroll") for (int k = 0; k < 2; ++k) dst[m][k] = *(const LAS bf16x8*)(lds + PG8_SA(b, h) + aoff + m * 2048 + k * 1024); } } while (0)
#define PG8_LDB(dst, b, h) do { if constexpr (F8) { _Pragma("unroll") for (int n = 0; n < 2; ++n) { dst[n][0] = *(const LAS bf16x8*)(lds + PG8_SB(b, h) + n * 2048 + boff8); dst[n][1] = *(const LAS bf16x8*)(lds + PG8_SB(b, h) + n * 2048 + (boff8 ^ 16)); } } \
        else { _Pragma("unroll") for (int n = 0; n < 2; ++n) _Pragma("unroll") for (int k = 0; k < 2; ++k) dst[n][k] = *(const LAS bf16x8*)(lds + PG8_SB(b, h) + boff + n * 2048 + k * 1024); } } while (0)
#define PG8_F8FRAG(x) __builtin_shufflevector(__builtin_bit_cast(v4i_t, x[0]), __builtin_bit_cast(v4i_t, x[1]), 0, 1, 2, 3, 4, 5, 6, 7)
#define PG8_MMA(ai, bj, At, Bt) do { __builtin_amdgcn_s_setprio(1); if constexpr (F8) { _Pragma("unroll") for (int m = 0; m < 4; ++m) _Pragma("unroll") for (int n = 0; n < 2; ++n) \
        acc[ai][bj][m][n] = __builtin_amdgcn_mfma_scale_f32_16x16x128_f8f6f4(PG8_F8FRAG(Bt[n]), PG8_F8FRAG(At[m]), acc[ai][bj][m][n], 0, 0, 0, 0x7f7f7f7f, 0, 0x7f7f7f7f); } \
        else { _Pragma("unroll") for (int m = 0; m < 4; ++m) _Pragma("unroll") for (int n = 0; n < 2; ++n) _Pragma("unroll") for (int k = 0; k < 2; ++k) \
        acc[ai][bj][m][n] = __builtin_amdgcn_mfma_f32_16x16x32_bf16(Bt[n][k], At[m][k], acc[ai][bj][m][n], 0, 0, 0); } __builtin_amdgcn_s_setprio(0); } while (0)
#define PG8_WAIT_V(n) asm volatile("s_waitcnt vmcnt(" #n ")" ::: "memory")
#define PG8_WAIT_L(n) asm volatile("s_waitcnt lgkmcnt(" #n ")" ::: "memory")
#define PG8_BAR __builtin_amdgcn_s_barrier()
#define PG8_SCHED __builtin_amdgcn_sched_barrier(0)
    Unit cur, nxt; int ui = 0;
    if (!Pb.next(0, cur)) return;
    const unsigned ktm = (unsigned)nt - 1u;
    unsigned rc = Pb.rot(cur), rn = 0u;
    f32x4 acc[2][2][4][2];
#pragma unroll
    for (int a = 0; a < 2; ++a)
#pragma unroll
        for (int b = 0; b < 2; ++b)
#pragma unroll
            for (int m = 0; m < 4; ++m)
#pragma unroll
                for (int n = 0; n < 2; ++n) acc[a][b][m][n] = (f32x4){0.f, 0.f, 0.f, 0.f};
    bf16x8 At[4][2], B0[2][2], B1[2][2];
    unsigned ca00 = 0, ca01 = 0, ca10 = 0, ca11 = 0;
    unsigned cA, nA;
    if constexpr (GATHER) { Pb.a_fetch(cur, lds, wid); asm volatile("s_waitcnt vmcnt(0)" ::: "memory"); __builtin_amdgcn_s_barrier(); }
    Pb.e_fetch(cur, lds, wid, 0);
    { unsigned o[2][2]; Pb.a_addr(cur, Rr, Cc, o, cA, lds); ca00 = o[0][0]; ca01 = o[0][1]; ca10 = o[1][0]; ca11 = o[1][1]; }
    unsigned cB = Pb.b_base(cur);
    { const unsigned k0 = (rc & ktm) * kstep;
    PG8_STAGE_B(PG8_SB(0, 0), cB + k0); PG8_STAGE_B(PG8_SB(0, 1), cB + k0 + hstepB); PG8_STAGE_A(PG8_SA(0, 0), cA + k0, 0); PG8_STAGE_A(PG8_SA(0, 1), cA + k0, 1);
    if (wr == 1) PG8_BAR;
    PG8_WAIT_V(2); PG8_BAR;
    PG8_STAGE_B(PG8_SB(1, 0), cB + k0 + kstep); PG8_STAGE_A(PG8_SA(1, 0), cA + k0 + kstep, 0); PG8_STAGE_B(PG8_SB(1, 1), cB + k0 + hstepB + kstep); }
    PG8_WAIT_V(6); PG8_BAR;
    for (;;) {
        const bool has_next = Pb.next(ui + 1, nxt);
        unsigned nB;
        if (has_next) { if constexpr (GATHER) Pb.a_fetch(nxt, lds, wid); else { unsigned o[2][2]; Pb.a_addr(nxt, Rr, Cc, o, nA, lds); } nB = Pb.b_base(nxt); rn = Pb.rot(nxt); }
        else { nA = cA; nB = cB; rn = rc; }
        for (int t = 0; t < nt; t += 2) {
            const bool last = (t == nt - 2);
            const unsigned a1 = cA + (((unsigned)(t + 1) + rc) & ktm) * kstep;
            PG8_LDB(B0, 0, 0); PG8_LDB(B1, 0, 1); PG8_SCHED; PG8_LDA(At, 0, 0); PG8_STAGE_A(PG8_SA(1, 1), a1, 1);
            PG8_WAIT_V(8); PG8_WAIT_L(0); PG8_BAR; PG8_MMA(0, 0, At, B0); PG8_MMA(0, 1, At, B1); PG8_BAR; PG8_SCHED;
            const unsigned k2 = last ? (rn & ktm) * kstep : (((unsigned)(t + 2) + rc) & ktm) * kstep;
            const unsigned a2 = (last ? nA : cA) + k2, b2 = (last ? nB : cB) + k2;
            const unsigned a3 = a2 + kstep, b3 = b2 + kstep;
            if constexpr (GATHER) { if (last && has_next) { unsigned o[2][2]; Pb.a_addr(nxt, Rr, Cc, o, nA, lds); ca00 = o[0][0]; ca01 = o[0][1]; ca10 = o[1][0]; ca11 = o[1][1]; } }
            PG8_LDA(At, 0, 1); PG8_STAGE_B(PG8_SB(0, 0), b2); PG8_STAGE_B(PG8_SB(0, 1), b2 + hstepB); PG8_STAGE_A(PG8_SA(0, 0), a2, 0);
            PG8_WAIT_V(8); PG8_WAIT_L(0); PG8_BAR; PG8_MMA(1, 0, At, B0); PG8_MMA(1, 1, At, B1); PG8_BAR; PG8_SCHED;
            PG8_LDB(B0, 1, 0); PG8_LDB(B1, 1, 1); PG8_SCHED; PG8_LDA(At, 1, 0); PG8_STAGE_A(PG8_SA(0, 1), a2, 1);
            PG8_WAIT_V(8); PG8_WAIT_L(0); PG8_BAR; PG8_MMA(0, 0, At, B0); PG8_MMA(0, 1, At, B1); PG8_BAR; PG8_SCHED;
            PG8_LDA(At, 1, 1); PG8_STAGE_B(PG8_SB(1, 0), b3); PG8_STAGE_B(PG8_SB(1, 1), b3 + hstepB); PG8_STAGE_A(PG8_SA(1, 0), a3, 0);
            PG8_WAIT_V(8); PG8_WAIT_L(0); PG8_BAR; PG8_MMA(1, 0, At, B0); PG8_MMA(1, 1, At, B1); PG8_BAR; PG8_SCHED;
        }
        if constexpr (ALIGN_EPI) { if (wr == 0) PG8_BAR; }
        { int tl = tid; asm volatile("" : "+v"(tl));
          const int ln = tl & 63; Pb.epi(acc, cur, wr, wc, ln & 15, ln >> 4, lds + (ui & 1) * 3072); }
        if (!has_next) break;
#pragma unroll
        for (int a = 0; a < 2; ++a)
#pragma unroll
            for (int b = 0; b < 2; ++b)
#pragma unroll
                for (int m = 0; m < 4; ++m)
#pragma unroll
                    for (int n = 0; n < 2; ++n) acc[a][b][m][n] = (f32x4){0.f, 0.f, 0.f, 0.f};
        _Pragma("unroll") for (int a = 0; a < 2; ++a) _Pragma("unroll") for (int b = 0; b < 2; ++b) _Pragma("unroll") for (int m = 0; m < 4; ++m) asm volatile("" : "+v"(acc[a][b][m][0]), "+v"(acc[a][b][m][1]));
        cur = nxt; cA = nA; cB = nB; rc = rn; ++ui;
        Pb.e_fetch(cur, lds, wid, ui & 1);
        if constexpr (ALIGN_EPI) { if (wr == 1) PG8_BAR; }
    }
    PG8_WAIT_V(0);
    if constexpr (!ALIGN_EPI) { if (wr == 0) PG8_BAR; }
    PG8_BAR;
#undef PG8_SA
#undef PG8_SB
#undef PG8_STAGE_A
#undef PG8_STAGE_B
#undef PG8_LDA
#undef PG8_LDB
#undef PG8_MMA
#undef PG8_F8FRAG
#undef PG8_WAIT_V
#undef PG8_WAIT_L
#undef PG8_BAR
#undef PG8_SCHED
}
}
namespace pg8 {
#define PG8_EPI_LOOP for (int ai = 0; ai < 2; ++ai) _Pragma("unroll") for (int m = 0; m < 4; ++m) _Pragma("unroll") for (int bj = 0; bj < 2; ++bj)
__device__ __forceinline__ void rope4(const float* rope, int pos, int i0, f32x4& a, f32x4& b) {
    const f32x4 c = *(const f32x4*)(rope + pos * 32 + i0), s = *(const f32x4*)(rope + LSEQ * 32 + pos * 32 + i0);
    const f32x4 r0 = {a[0] * c[0] - a[1] * s[0], a[1] * c[0] + a[0] * s[0], a[2] * c[1] - a[3] * s[1], a[3] * c[1] + a[2] * s[1]};
    const f32x4 r1 = {b[0] * c[2] - b[1] * s[2], b[1] * c[2] + b[0] * s[2], b[2] * c[3] - b[3] * s[3], b[3] * c[3] + b[2] * s[3]};
    a = r0; b = r1;
}
__device__ __forceinline__ float clamp448(float v) { return __builtin_amdgcn_fmed3f(v, -448.0f, 448.0f); }
__device__ __forceinline__ unsigned pack4_f8(float a, float b, float c, float d) { int w = 0; w = __builtin_amdgcn_cvt_pk_fp8_f32(clamp448(a), clamp448(b), w, false); w = __builtin_amdgcn_cvt_pk_fp8_f32(clamp448(c), clamp448(d), w, true); return (unsigned)w; }
__device__ __forceinline__ unsigned long long pack8_f8(const f32x4& a, const f32x4& b) { return (unsigned long long)pack4_f8(a[0], a[1], a[2], a[3]) | ((unsigned long long)pack4_f8(b[0], b[1], b[2], b[3]) << 32); }
struct DenseBase {
    static constexpr bool F8 = false, GATHER = false; static constexpr int scaleA = 0, scaleB = 0;
    const char* A; const char* Bt; int K, lda, ldb, ldaB, ldbB; Order2D ord;
    __device__ __forceinline__ bool next(int i, Unit& u) const { return ord.next(i, u); }
    __device__ __forceinline__ unsigned rot(const Unit&) const { return 0u; }
    __device__ __forceinline__ void e_fetch(const Unit&, LAS unsigned char*, int, int) const {}
    __device__ __forceinline__ void a_addr(const Unit& u, const int (&Rr)[2], const int (&Cc)[2], unsigned (&o)[2][2], unsigned& base, LAS unsigned char*) const {
        base = (unsigned)u.pm * 256u * (unsigned)lda * 2u;
#pragma unroll
        for (int h = 0; h < 2; ++h)
#pragma unroll
            for (int i = 0; i < 2; ++i) o[h][i] = (unsigned)((h * 128 + Rr[i]) * lda * 2 + Cc[i]);
    }
    __device__ __forceinline__ unsigned b_base(const Unit& u) const { return (unsigned)u.pn * 256u * (unsigned)ldb * 2u; }
};
struct ProbP1 : DenseBase {
    bf16_t* proj; bf16_t* kr; const float* rope; float* ssqp;
    __device__ __forceinline__ void epi(const f32x4 (&acc)[2][2][4][2], const Unit& u, int wr, int wc, int fr, int fq, LAS unsigned char*) const {
        float ssq_acc[2][4];
#pragma unroll
        for (int a = 0; a < 2; ++a)
#pragma unroll
            for (int b = 0; b < 4; ++b) ssq_acc[a][b] = 0.f;
#pragma unroll
        PG8_EPI_LOOP {
            const int row = u.pm * 256 + ai * 128 + wr * 64 + m * 16 + fr, col = u.pn * 256 + bj * 128 + wc * 32 + fq * 8;
            f32x4 v0 = acc[ai][bj][m][0], v1 = acc[ai][bj][m][1];
            if (u.pn >= 4 && u.pn < 7) { const float q = (v0[0] * v0[0] + v0[1] * v0[1]) + (v0[2] * v0[2] + v0[3] * v0[3]) + (v1[0] * v1[0] + v1[1] * v1[1]) + (v1[2] * v1[2] + v1[3] * v1[3]);
                ssq_acc[ai][m] += q; }
            if (col < 1792) { *(u32x4*)(proj + (size_t)row * DM + col) = pack8(v0, v1); }
            else if (col < INW) { const int pos = (row % LP) - PADR;
                if (pos >= 0) rope4(rope, pos, (col - 1792) >> 1, v0, v1); else { v0 = (f32x4){0.f, 0.f, 0.f, 0.f}; v1 = v0; }
                *(u32x4*)(kr + (size_t)row * 64 + (col - 1792)) = pack8(v0, v1); }
        }
        if (u.pn >= 4 && u.pn < 7) {
            const int slot = u.pn < 6 ? (u.pn - 4) * 4 + wc : 8 + wc;
#pragma unroll
            for (int ai = 0; ai < 2; ++ai)
#pragma unroll
                for (int m = 0; m < 4; ++m) { float q = ssq_acc[ai][m]; q += __shfl_xor(q, 16); q += __shfl_xor(q, 32);
                    if (fq == 0) ssqp[(size_t)(u.pm * 256 + ai * 128 + wr * 64 + m * 16 + fr) * 12 + slot] = q; }
        }
    }
};
struct ProbP2q : DenseBase {
    bf16_t* qb; const float* rsq; const float* rope;
    __device__ __forceinline__ void epi(const f32x4 (&acc)[2][2][4][2], const Unit& u, int wr, int wc, int fr, int fq, LAS unsigned char*) const {
        float rsv[2][4];
#pragma unroll
        for (int ai = 0; ai < 2; ++ai)
#pragma unroll
            for (int m = 0; m < 4; ++m) { const float* pp = rsq + (size_t)(u.pm * 256 + ai * 128 + wr * 64 + m * 16 + fr) * 12; const f32x4 a = *(const f32x4*)pp, b = *(const f32x4*)(pp + 4);
                rsv[ai][m] = C2 / sqrtf(((a[0] + a[1]) + (a[2] + a[3]) + (b[0] + b[1]) + (b[2] + b[3])) * (1.0f / QLORA) + EPS); }
#pragma unroll
        PG8_EPI_LOOP {
            const int row = u.pm * 256 + ai * 128 + wr * 64 + m * 16 + fr, col = u.pn * 256 + bj * 128 + wc * 32 + fq * 8;
            const float s = rsv[ai][m]; f32x4 v0 = acc[ai][bj][m][0] * s, v1 = acc[ai][bj][m][1] * s;
            const int dd = col % QKD;
            if (dd >= QKNOPE) { const int pos = (row % LP) - PADR; if (pos >= 0) rope4(rope, pos, (dd - QKNOPE) >> 1, v0, v1); else { v0 = (f32x4){0.f, 0.f, 0.f, 0.f}; v1 = v0; } }
            *(u32x4*)(qb + (size_t)row * 1536 + col) = pack8(v0, v1);
        }
    }
};
struct ProbP2kv : DenseBase {
    bf16_t* kn; bf16_t* vb; const float* rskv;
    __device__ __forceinline__ void epi(const f32x4 (&acc)[2][2][4][2], const Unit& u, int wr, int wc, int fr, int fq, LAS unsigned char*) const {
#pragma unroll
        PG8_EPI_LOOP {
            const int row = u.pm * 256 + ai * 128 + wr * 64 + m * 16 + fr, c = wc * 32 + fq * 8;
            const f32x4 pk = *(const f32x4*)(rskv + (size_t)row * 12 + 8); const float s = 1.0f / sqrtf(((pk[0] + pk[1]) + (pk[2] + pk[3])) * (1.0f / KVLORA) + EPS); const f32x4 v0 = acc[ai][bj][m][0] * s, v1 = acc[ai][bj][m][1] * s;
            bf16_t* dst = (bj == 0 ? kn : vb) + (size_t)row * 1024 + u.pn * 128 + c;
            *(u32x4*)dst = pack8(v0, v1);
        }
    }
};
struct ProbPool : DenseBase {
    bf16_t* mix; const float* pscale;
    __device__ __forceinline__ void a_addr(const Unit& u, const int (&Rr)[2], const int (&Cc)[2], unsigned (&o)[2][2], unsigned& base, LAS unsigned char*) const {
        base = ((unsigned)u.pm * 256u * (unsigned)lda + (unsigned)u.pn * 256u) * 2u;
#pragma unroll
        for (int h = 0; h < 2; ++h)
#pragma unroll
            for (int i = 0; i < 2; ++i) o[h][i] = (unsigned)((h * 128 + Rr[i]) * lda * 2 + Cc[i]);
    }
    __device__ __forceinline__ unsigned b_base(const Unit& u) const { return (unsigned)u.pn * 65536u * 2u; }
    __device__ __forceinline__ void epi(const f32x4 (&acc)[2][2][4][2], const Unit& u, int wr, int wc, int fr, int fq, LAS unsigned char*) const {
#pragma unroll
        PG8_EPI_LOOP {
            const int row = u.pm * 256 + ai * 128 + wr * 64 + m * 16 + fr, c = u.pn * 256 + bj * 128 + wc * 32 + fq * 8;
            const f32x4 p0 = *(const f32x4*)(pscale + c), p1 = *(const f32x4*)(pscale + c + 4);
            *(u32x4*)(mix + (size_t)row * DM + c) = pack8(acc[ai][bj][m][0] * p0, acc[ai][bj][m][1] * p1);
        }
    }
};
struct ProbP4 : DenseBase {
    const float* x; bf16_t* h2; unsigned char* h2f8;
    __device__ __forceinline__ void a_addr(const Unit& u, const int (&Rr)[2], const int (&Cc)[2], unsigned (&o)[2][2], unsigned& base, LAS unsigned char*) const {
        base = (unsigned)((u.pm >> 3) * LP + 64 + (u.pm & 7) * 256) * (unsigned)lda * 2u;
#pragma unroll
        for (int h = 0; h < 2; ++h)
#pragma unroll
            for (int i = 0; i < 2; ++i) o[h][i] = (unsigned)((h * 128 + Rr[i]) * lda * 2 + Cc[i]);
    }
    __device__ __forceinline__ void epi(const f32x4 (&acc)[2][2][4][2], const Unit& u, int wr, int wc, int fr, int fq, LAS unsigned char*) const {
#pragma unroll
        PG8_EPI_LOOP {
            const int r = u.pm * 256 + ai * 128 + wr * 64 + m * 16 + fr, c = u.pn * 256 + bj * 128 + wc * 32 + fq * 8;
            const size_t off = (size_t)r * DM + c;
            const f32x4 o0 = *(const f32x4*)(x + off) + acc[ai][bj][m][0], o1 = *(const f32x4*)(x + off + 4) + acc[ai][bj][m][1];
            *(u32x4*)(h2 + off) = pack8(o0, o1); *(unsigned long long*)(h2f8 + off) = pack8_f8(o0, o1);
        }
    }
};
}
namespace pg8 {
constexpr int TB_CNT = 64, TB_TE = 128, TB_TM = 416, TB_LIST = 768, TB_E0 = 1024, TB_E1 = 1280, TB_E2 = 1536;
__device__ __forceinline__ void moe_table(LAS unsigned char* lds, const unsigned* cnt, const int tid) {
    LAS int* tab = (LAS int*)(lds + TAB_OFF);
    __syncthreads();
    if (tid < NE) tab[TB_CNT + tid] = (int)__hip_atomic_load(cnt + tid, RLX_AGENT);
    __syncthreads();
    if (tid == 0) { int s = 0; for (int e = 0; e < NE; ++e) { tab[e] = s; s += (tab[TB_CNT + e] + 255) >> 8; } tab[NE] = s; }
    __syncthreads();
    if (tid < 288) { int e = 0; for (; e < NE - 1; ++e) if (tid < tab[e + 1]) break; tab[TB_TE + tid] = e; tab[TB_TM + tid] = tid - tab[e]; }
    __syncthreads();
}
#ifndef MOE_BT
#define MOE_BT 8
#endif
template <int NTN> struct MoeOrder {
    const LAS int* tab; int G, c, i0, i1;
    __device__ __forceinline__ bool next(int i_, Unit& u) const {
        const int i = i0 + i_; if (i >= i1) return false;
        const int cpx = G >> 3; const int F = (G & 7) ? i * G + c : (i * 8 + (c & 7)) * cpx + (c >> 3);
        const int ntile = __builtin_amdgcn_readfirstlane(tab[NE]); if (F >= ntile * NTN) return false;
        constexpr int BT = MOE_BT, PG = 32 / BT;
        const int blk = F / (BT * NTN), r = F - blk * (BT * NTN), nb = (ntile - blk * BT) < BT ? (ntile - blk * BT) : BT;
        int png, rr; if (nb == BT) { png = r / 32; rr = r & 31; } else { const int gs = nb * PG; png = r / gs; rr = r - png * gs; }
        const int T = blk * BT + rr / PG;
        u.aux = __builtin_amdgcn_readfirstlane(tab[TB_TE + T]); u.pm = __builtin_amdgcn_readfirstlane(tab[TB_TM + T]); u.pn = png * PG + (rr % PG); return true;
    }
};
constexpr int W_SCALE_LOG2 = 5, ACT_SCALE_LOG2 = 2, YB_SCALE_LOG2 = 4;
struct ProbP6 {
    static constexpr bool F8 = true, GATHER = true; static constexpr int ldaB = DM; static constexpr int scaleB = 0x01010101 * (127 - W_SCALE_LOG2), scaleA = 0x7f7f7f7f;
    const char* A; const char* Bt; int K, ldbB; MoeOrder<16> ord;
    const int* list; const float* rsl; const float* b1; unsigned char* act;
    __device__ __forceinline__ bool next(int i, Unit& u) const { return ord.next(i, u); }
    __device__ __forceinline__ unsigned rot(const Unit& u) const { return 0u; }
    __device__ __forceinline__ void a_fetch(const Unit& u, LAS unsigned char* lds, int wid) const {
        if (wid == 0) { const __amdgpu_buffer_rsrc_t rl = __builtin_amdgcn_make_buffer_rsrc((void*)list, 0, 0x7ffffffe, 0x00020000);
            __builtin_amdgcn_raw_ptr_buffer_load_lds(rl, (LAS unsigned*)(lds + TAB_OFF + TB_LIST * 4), 16, (threadIdx.x & 63) * 16, (int)(((unsigned)u.aux * (unsigned)MR + (unsigned)u.pm * 256u) * 4u), 0, 0); }
    }
    __device__ __forceinline__ void a_addr(const Unit& u, const int (&Rr)[2], const int (&Cc)[2], unsigned (&o)[2][2], unsigned& base, LAS unsigned char* lds) const {
        base = 0u; const int cnt_e = __builtin_amdgcn_readfirstlane(ord.tab[TB_CNT + u.aux]); const LAS int* lb = (const LAS int*)(lds + TAB_OFF) + TB_LIST; const int lastv = cnt_e - 1 - u.pm * 256;
#pragma unroll
        for (int h = 0; h < 2; ++h)
#pragma unroll
            for (int i = 0; i < 2; ++i) { int sl = h * 128 + Rr[i]; sl = sl < lastv ? sl : lastv; const int tok = lb[sl] >> 2; o[h][i] = (unsigned)tok * (unsigned)DM + (unsigned)Cc[i]; }
    }
    __device__ __forceinline__ void e_fetch(const Unit& u, LAS unsigned char* lds, int wid, int par) const {
        lds += par * 3072;
        if (wid == 1) { const __amdgpu_buffer_rsrc_t r = __builtin_amdgcn_make_buffer_rsrc((void*)rsl, 0, 0x7ffffffe, 0x00020000);
            __builtin_amdgcn_raw_ptr_buffer_load_lds(r, (LAS unsigned*)(lds + TAB_OFF + TB_E0 * 4), 16, (threadIdx.x & 63) * 16, (int)(((unsigned)u.aux * (unsigned)MR + (unsigned)u.pm * 256u) * 4u), 0, 0); }
        if (wid == 2) { const __amdgpu_buffer_rsrc_t r = __builtin_amdgcn_make_buffer_rsrc((void*)b1, 0, 0x7ffffffe, 0x00020000);
            __builtin_amdgcn_raw_ptr_buffer_load_lds(r, (LAS unsigned*)(lds + TAB_OFF + TB_E1 * 4), 16, (threadIdx.x & 63) * 16, (int)(((unsigned)u.aux * 4096u + (unsigned)u.pn * 256u) * 4u), 0, 0); }
    }
    __device__ __forceinline__ unsigned b_base(const Unit& u) const { return ((unsigned)u.aux * 4096u + (unsigned)u.pn * 256u) * (unsigned)DM; }
    __device__ __forceinline__ void epi(const f32x4 (&acc)[2][2][4][2], const Unit& u, int wr, int wc, int fr, int fq, LAS unsigned char* lds) const {
        const LAS float* rsb = (const LAS float*)(lds + TAB_OFF) + TB_E0; const LAS float* bb1 = (const LAS float*)(lds + TAB_OFF) + TB_E1;
        typedef float f32x2 __attribute__((ext_vector_type(2)));
        const int cnt_e = __builtin_amdgcn_readfirstlane(ord.tab[TB_CNT + u.aux]), rbase = __builtin_amdgcn_readfirstlane(ord.tab[u.aux]) * 256;
        f32x4 bg[2], bl[2];
#pragma unroll
        for (int bj = 0; bj < 2; ++bj) { const LAS float* bp = bb1 + bj * 128 + wc * 32 + fq * 8; const f32x4 x0 = *(const LAS f32x4*)bp, x1 = *(const LAS f32x4*)(bp + 4);
            bg[bj] = (f32x4){x0[0], x0[2], x1[0], x1[2]}; bl[bj] = (f32x4){x0[1], x0[3], x1[1], x1[3]}; }
        constexpr float AS = (float)(1 << ACT_SCALE_LOG2), NC = -1.702f * 1.4426950408889634f;
#pragma unroll
        for (int ai = 0; ai < 2; ++ai)
#pragma unroll
            for (int m = 0; m < 4; ++m) {
                const int slot = u.pm * 256 + ai * 128 + wr * 64 + m * 16 + fr; const bool valid = slot < cnt_e;
                const float rs = valid ? rsb[ai * 128 + wr * 64 + m * 16 + fr] * (1.0f / (float)(1 << W_SCALE_LOG2)) : 0.f;
#pragma unroll
                for (int bj = 0; bj < 2; ++bj) {
                    const f32x4 a0 = acc[ai][bj][m][0], a1 = acc[ai][bj][m][1];
                    f32x4 g = (f32x4){a0[0], a0[2], a1[0], a1[2]} * rs + bg[bj], l = (f32x4){a0[1], a0[3], a1[1], a1[3]} * rs + bl[bj];
#pragma unroll
                    for (int q = 0; q < 4; ++q) { g[q] = fminf(g[q], 7.0f); l[q] = __builtin_amdgcn_fmed3f(l[q], -7.0f, 7.0f); }
                    f32x4 e = g * NC, lp = l * AS + AS;
#pragma unroll
                    for (int q = 0; q < 4; ++q) e[q] = __builtin_amdgcn_rcpf(1.0f + __builtin_amdgcn_exp2f(e[q]));
                    const f32x4 o = (g * e) * lp;
                    if (valid) { int w = 0; w = __builtin_amdgcn_cvt_pk_fp8_f32(o[0], o[1], w, false); w = __builtin_amdgcn_cvt_pk_fp8_f32(o[2], o[3], w, true);
                        *(unsigned*)(act + (size_t)(rbase + slot) * DFF + u.pn * 128 + bj * 64 + wc * 16 + fq * 4) = (unsigned)w; }
                }
            }
    }
};
struct ProbP7 {
    static constexpr bool F8 = true, GATHER = false; static constexpr int ldaB = DFF; static constexpr int scaleB = 0x01010101 * (127 - W_SCALE_LOG2), scaleA = 0x01010101 * (127 - ACT_SCALE_LOG2);
    const char* A; const char* Bt; int K, ldbB; MoeOrder<8> ord;
    const int* list; const float* gate; const float* b2; unsigned char* yb;
    __device__ __forceinline__ bool next(int i, Unit& u) const { return ord.next(i, u); }
    __device__ __forceinline__ unsigned rot(const Unit& u) const { return 0u; }
    __device__ __forceinline__ void a_addr(const Unit& u, const int (&Rr)[2], const int (&Cc)[2], unsigned (&o)[2][2], unsigned& base, LAS unsigned char*) const {
        base = (unsigned)(__builtin_amdgcn_readfirstlane(ord.tab[u.aux]) + u.pm) * 256u * (unsigned)DFF;
#pragma unroll
        for (int h = 0; h < 2; ++h)
#pragma unroll
            for (int i = 0; i < 2; ++i) o[h][i] = (unsigned)((h * 128 + Rr[i]) * DFF + Cc[i]);
    }
    __device__ __forceinline__ void e_fetch(const Unit& u, LAS unsigned char* lds, int wid, int par) const {
        lds += par * 3072;
        const int so = (int)(((unsigned)u.aux * (unsigned)MR + (unsigned)u.pm * 256u) * 4u);
        if (wid == 1) { const __amdgpu_buffer_rsrc_t r = __builtin_amdgcn_make_buffer_rsrc((void*)gate, 0, 0x7ffffffe, 0x00020000);
            __builtin_amdgcn_raw_ptr_buffer_load_lds(r, (LAS unsigned*)(lds + TAB_OFF + TB_E0 * 4), 16, (threadIdx.x & 63) * 16, so, 0, 0); }
        if (wid == 2) { const __amdgpu_buffer_rsrc_t r = __builtin_amdgcn_make_buffer_rsrc((void*)b2, 0, 0x7ffffffe, 0x00020000);
            __builtin_amdgcn_raw_ptr_buffer_load_lds(r, (LAS unsigned*)(lds + TAB_OFF + TB_E1 * 4), 16, (threadIdx.x & 63) * 16, (int)(((unsigned)u.aux * (unsigned)DM + (unsigned)u.pn * 256u) * 4u), 0, 0); }
        if (wid == 3) { const __amdgpu_buffer_rsrc_t r = __builtin_amdgcn_make_buffer_rsrc((void*)list, 0, 0x7ffffffe, 0x00020000);
            __builtin_amdgcn_raw_ptr_buffer_load_lds(r, (LAS unsigned*)(lds + TAB_OFF + TB_E2 * 4), 16, (threadIdx.x & 63) * 16, so, 0, 0); }
    }
    __device__ __forceinline__ unsigned b_base(const Unit& u) const { return ((unsigned)u.aux * (unsigned)DM + (unsigned)u.pn * 256u) * (unsigned)DFF; }
    __device__ __forceinline__ void epi(const f32x4 (&acc)[2][2][4][2], const Unit& u, int wr, int wc, int fr, int fq, LAS unsigned char* lds) const {
        const int cnt_e = __builtin_amdgcn_readfirstlane(ord.tab[TB_CNT + u.aux]);
        const LAS float* gtb = (const LAS float*)(lds + TAB_OFF) + TB_E0; const LAS float* bb2 = (const LAS float*)(lds + TAB_OFF) + TB_E1; const LAS int* idb = (const LAS int*)(lds + TAB_OFF) + TB_E2;
        const int col = u.pn * 256 + wc * 32 + fq * 8;
        f32x4 bb[2][2];
#pragma unroll
        for (int bj = 0; bj < 2; ++bj) { const LAS float* bp = bb2 + bj * 128 + wc * 32 + fq * 8; bb[bj][0] = *(const LAS f32x4*)bp; bb[bj][1] = *(const LAS f32x4*)(bp + 4); }
#pragma unroll
        for (int ai = 0; ai < 2; ++ai)
#pragma unroll
            for (int m = 0; m < 4; ++m) {
                const int rl = ai * 128 + wr * 64 + m * 16 + fr, slot = u.pm * 256 + rl; const bool valid = slot < cnt_e;
                const int id = valid ? idb[rl] : 0; const float g = valid ? gtb[rl] : 0.f, gs = g * (1.0f / (float)(1 << (W_SCALE_LOG2 + ACT_SCALE_LOG2)));
                unsigned char* orow = yb + (size_t)id * DM + col;
#pragma unroll
                for (int bj = 0; bj < 2; ++bj) {
                    const f32x4 y0 = (acc[ai][bj][m][0] * gs + bb[bj][0] * g) * (float)(1 << YB_SCALE_LOG2), y1 = (acc[ai][bj][m][1] * gs + bb[bj][1] * g) * (float)(1 << YB_SCALE_LOG2);
                    if (valid) *(unsigned long long*)(orow + bj * 128) = pack8_f8(y0, y1);
                }
            }
    }
};
}
namespace att {
using f32x16 = __attribute__((ext_vector_type(16))) float;
using s16x4 = __attribute__((ext_vector_type(4))) short;
constexpr int SHM_V = 16384, SHM_KN = 16384, SHM_KR = 8192, SHM_BUF = SHM_V + SHM_KN + SHM_KR, NBUF = 3, WS_OFF = NBUF * SHM_BUF;
#define ATT_SBAR() __builtin_amdgcn_sched_barrier(0)
__device__ __forceinline__ int crow(int r, int hi) { return (r & 3) + 8 * (r >> 2) + 4 * hi; }
__device__ __forceinline__ unsigned cvtpk(float lo, float hi) { unsigned r; asm volatile("v_cvt_pk_bf16_f32 %0, %1, %2" : "=v"(r) : "v"(lo), "v"(hi)); return r; }
__device__ __forceinline__ int v_st(int k, int c) { const int kk = (k & ~0xC) | ((k & 4) << 1) | ((k & 8) >> 1); return ((kk >> 3) * 4 + (c >> 5)) * 512 + ((kk & 7) * 32 + (c & 31)) * 2; }
__device__ __forceinline__ int v_rd_base(int lane) { return ((lane & 3) << 3) | (((lane >> 2) & 3) << 6) | (((lane >> 4) & 1) << 5) | (((lane >> 5) & 1) << 8); }
constexpr int v_rd_off(int d0, int ks, int half) { return d0 * 512 + ks * 4096 + half * 2048; }
template <int OFF> __device__ __forceinline__ s16x4 tr_read(int vb) { s16x4 r; asm volatile("ds_read_b64_tr_b16 %0, %1 offset:%2" : "=&v"(r) : "v"(vb), "i"(OFF) : "memory"); return r; }
template <int D0> __device__ __forceinline__ void pv_one(f32x16& od, int vb, bf16x8 pa0, bf16x8 pa1, bf16x8 pa2, bf16x8 pa3) {
    const s16x4 l0 = tr_read<v_rd_off(D0, 0, 0)>(vb), h0 = tr_read<v_rd_off(D0, 0, 1)>(vb), l1 = tr_read<v_rd_off(D0, 1, 0)>(vb), h1 = tr_read<v_rd_off(D0, 1, 1)>(vb);
    const s16x4 l2 = tr_read<v_rd_off(D0, 2, 0)>(vb), h2 = tr_read<v_rd_off(D0, 2, 1)>(vb), l3 = tr_read<v_rd_off(D0, 3, 0)>(vb), h3 = tr_read<v_rd_off(D0, 3, 1)>(vb);
    asm volatile("s_waitcnt lgkmcnt(0)" ::: "memory"); ATT_SBAR();
#define ATT_PK(L, H) (bf16x8){L[0], L[1], L[2], L[3], H[0], H[1], H[2], H[3]}
    od = __builtin_amdgcn_mfma_f32_32x32x16_bf16(pa0, ATT_PK(l0, h0), od, 0, 0, 0);
    od = __builtin_amdgcn_mfma_f32_32x32x16_bf16(pa1, ATT_PK(l1, h1), od, 0, 0, 0);
    od = __builtin_amdgcn_mfma_f32_32x32x16_bf16(pa2, ATT_PK(l2, h2), od, 0, 0, 0);
    od = __builtin_amdgcn_mfma_f32_32x32x16_bf16(pa3, ATT_PK(l3, h3), od, 0, 0, 0);
#undef ATT_PK
}
template <int D0, int HK> __device__ __forceinline__ void pv_half(f32x16& od, int vb, bf16x8 pa0, bf16x8 pa1) {
    const s16x4 l0 = tr_read<v_rd_off(D0, 2 * HK, 0)>(vb), h0 = tr_read<v_rd_off(D0, 2 * HK, 1)>(vb), l1 = tr_read<v_rd_off(D0, 2 * HK + 1, 0)>(vb), h1 = tr_read<v_rd_off(D0, 2 * HK + 1, 1)>(vb);
    asm volatile("s_waitcnt lgkmcnt(0)" ::: "memory"); ATT_SBAR();
#define ATT_PK(L, H) (bf16x8){L[0], L[1], L[2], L[3], H[0], H[1], H[2], H[3]}
    od = __builtin_amdgcn_mfma_f32_32x32x16_bf16(pa0, ATT_PK(l0, h0), od, 0, 0, 0);
    od = __builtin_amdgcn_mfma_f32_32x32x16_bf16(pa1, ATT_PK(l1, h1), od, 0, 0, 0);
#undef ATT_PK
}
__device__ __forceinline__ void attn_unit(int b, int h, int u, const bf16_t* __restrict__ QB, const bf16_t* __restrict__ KN, const bf16_t* __restrict__ KR, const bf16_t* __restrict__ VB,
                                          bf16_t* __restrict__ MIX, LAS char* lds, const int tid) {
    const int wid = tid >> 6, lane = tid & 63, r32 = lane & 31, hi = lane >> 5;
    const int qc = (0x22331100u >> (4 * wid)) & 3, half = wid & 1;
    const int c0 = 4 * u - 3, ntw = c0 + qc + 1, ntmax = 4 * u + 1;
    const size_t rowb = (size_t)b * LP;
    const int qrow0 = 64 * (c0 + qc) + 32 * half;
    LAS float* wsf = (LAS float*)(lds + WS_OFF) + wid * 64; LAS float* li_l = wsf; LAS float* al_l = wsf + 32;
    bf16x8 qr[12];
    { const bf16_t* Qw = QB + (rowb + qrow0 + r32) * 1536 + h * QKD + hi * 8;
#pragma unroll
      for (int d0 = 0; d0 < 12; ++d0) qr[d0] = *(const bf16x8*)(Qw + d0 * 16); }
    unsigned gk0, gv0, gr;
    { const int w = wid;
      { const int row = 32 * (w & 1) + (lane >> 1), hh = (lane & 1) ^ ((row >> 3) & 1);
        gk0 = (unsigned)(row * 1024 + h * 128 + (w >> 1) * 16 + hh * 8); gr = (unsigned)(row * 64 + (w >> 1) * 16 + hh * 8); }
      { const int st = 4 * w + (lane >> 5), kk = (st >> 2) * 8 + ((lane >> 2) & 7), k = (kk & ~0xC) | ((kk & 4) << 1) | ((kk & 8) >> 1), c = (st & 3) * 32 + (lane & 3) * 8; gv0 = (unsigned)(k * 1024 + h * 128 + c); } }
    const bf16_t* KNb = KN + rowb * 1024; const bf16_t* VBb = VB + rowb * 1024; const bf16_t* KRb = KR + rowb * 64;
    const unsigned wq = (unsigned)wid * 2048u, wk = (unsigned)wid * 1024u;
    const int kb0 = (int)(uintptr_t)lds + SHM_V + r32 * 32 + ((hi ^ ((r32 >> 3) & 1)) << 4);
    const int vb0 = (int)(uintptr_t)lds + v_rd_base(lane);
#define ATT_DMA(gp, lp) __builtin_amdgcn_global_load_lds((const unsigned*)(gp), (LAS unsigned*)(lp), 16, 0, 0)
#define ATT_STAGE(j_, bf_) do { LAS char* bb_ = lds + (bf_) * SHM_BUF; const size_t ko_ = (size_t)(j_) * 64; \
    ATT_DMA(KNb + ko_ * 1024 + gk0, bb_ + SHM_V + wk); ATT_DMA(KNb + ko_ * 1024 + gk0 + 64, bb_ + SHM_V + 8192 + wk); \
    ATT_DMA(VBb + ko_ * 1024 + gv0, bb_ + wq); ATT_DMA(VBb + ko_ * 1024 + gv0 + 64, bb_ + wq + 1024); ATT_DMA(KRb + ko_ * 64 + gr, bb_ + SHM_V + 16384 + wk); } while (0)
#define ATT_WAIT_BAR(N) asm volatile("s_waitcnt vmcnt(" #N ") lgkmcnt(0)\n\ts_barrier" ::: "memory")
    float m_reg = -1e30f, l_reg = 0.f; f32x16 o[4];
#pragma unroll
    for (int d = 0; d < 4; ++d)
#pragma unroll
        for (int r = 0; r < 16; ++r) o[d][r] = 0.f;
    ATT_STAGE(0, 0); if (ntmax > 1) { ATT_STAGE(1, 1); ATT_WAIT_BAR(5); } else { ATT_WAIT_BAR(0); }
    int bf = 0;
    for (int j = 0; j < ntmax; ++j) {
        const int bf2 = bf == 0 ? 2 : bf - 1;
        const bool st2 = j + 2 < ntmax;
        if (st2) ATT_STAGE(j + 2, bf2);
        if (j < ntw) {
            const int vb = vb0 + bf * SHM_BUF, kb = kb0 + bf * SHM_BUF;
#pragma unroll
            for (int hk = 0; hk < 2; ++hk) {
                if (j == 0 && hk == 0) continue;
                f32x16 p0;
#pragma unroll
                for (int r = 0; r < 16; ++r) p0[r] = 0.f;
#pragma unroll
                for (int d0 = 0; d0 < 12; ++d0) {
                    const bf16x8 b0 = *(const LAS bf16x8*)(uintptr_t)(unsigned)(kb + d0 * 2048 + hk * 1024);
                    p0 = __builtin_amdgcn_mfma_f32_32x32x16_bf16(b0, qr[d0], p0, 0, 0, 0); }
                if (j == 0) {
#pragma unroll
                    for (int r = 0; r < 8; ++r) p0[r] = -1e30f;
                }
                float pmax = p0[0];
#pragma unroll
                for (int r = 1; r < 16; ++r) pmax = fmaxf(pmax, p0[r]);
                { auto sw = __builtin_amdgcn_permlane32_swap(__float_as_uint(pmax), __float_as_uint(pmax), false, false); pmax = fmaxf(__uint_as_float(sw[0]), __uint_as_float(sw[1])); }
                float mn, alpha;
                if (__all(pmax - m_reg <= 8.0f)) { mn = m_reg; alpha = 1.f; }
                else { mn = fmaxf(m_reg, pmax); alpha = __builtin_amdgcn_exp2f(m_reg - mn); m_reg = mn; }
                float ps = 0.f;
#pragma unroll
                for (int r = 0; r < 16; ++r) { p0[r] = __builtin_amdgcn_exp2f(p0[r] - mn); ps += p0[r]; }
                { auto sw = __builtin_amdgcn_permlane32_swap(__float_as_uint(ps), __float_as_uint(ps), false, false); ps = __uint_as_float(sw[0]) + __uint_as_float(sw[1]); }
                l_reg = l_reg * alpha + ps;
                bf16x8 pa0, pa1;
#define ATT_PK4(Pv, BASE, OUT) do { unsigned a0 = cvtpk(Pv[BASE + 0], Pv[BASE + 1]), a1 = cvtpk(Pv[BASE + 2], Pv[BASE + 3]); \
    unsigned b0_ = cvtpk(Pv[BASE + 4], Pv[BASE + 5]), b1_ = cvtpk(Pv[BASE + 6], Pv[BASE + 7]); \
    auto r0 = __builtin_amdgcn_permlane32_swap(a0, b0_, false, false); auto r1 = __builtin_amdgcn_permlane32_swap(a1, b1_, false, false); \
    u32x4 w = {r0[0], r1[0], r0[1], r1[1]}; OUT = *reinterpret_cast<bf16x8*>(&w); } while (0)
                ATT_PK4(p0, 0, pa0); ATT_PK4(p0, 8, pa1);
#undef ATT_PK4
                if (__any(alpha < 1.f)) { if (hi == 0) al_l[r32] = alpha; asm volatile("s_waitcnt lgkmcnt(0)" ::: "memory");
#pragma unroll
                    for (int d = 0; d < 4; ++d)
#pragma unroll
                        for (int r = 0; r < 16; ++r) o[d][r] *= al_l[crow(r, hi)]; }
                if (hk == 0) { pv_half<0, 0>(o[0], vb, pa0, pa1); pv_half<1, 0>(o[1], vb, pa0, pa1); pv_half<2, 0>(o[2], vb, pa0, pa1); pv_half<3, 0>(o[3], vb, pa0, pa1); }
                else         { pv_half<0, 1>(o[0], vb, pa0, pa1); pv_half<1, 1>(o[1], vb, pa0, pa1); pv_half<2, 1>(o[2], vb, pa0, pa1); pv_half<3, 1>(o[3], vb, pa0, pa1); }
            }
        }
        if (st2) ATT_WAIT_BAR(5); else ATT_WAIT_BAR(0);
        bf = bf == 2 ? 0 : bf + 1;
    }
    if (hi == 0) li_l[r32] = l_reg;
    asm volatile("s_waitcnt lgkmcnt(0)" ::: "memory");
    bf16_t* Ow = MIX + (rowb + qrow0) * DM + POOLW + h * 128 + r32;
#pragma unroll
    for (int r = 0; r < 16; ++r) { const int orow = crow(r, hi); const float rli = __builtin_amdgcn_rcpf(li_l[orow]);
#pragma unroll
        for (int d0 = 0; d0 < 4; ++d0) Ow[(size_t)orow * DM + d0 * 32] = (bf16_t)f2bf(o[d0][r] * rli); }
#undef ATT_DMA
#undef ATT_STAGE
#undef ATT_WAIT_BAR
}
__device__ __forceinline__ void attn_phase(const unsigned char* ws, unsigned char* wsw, LAS char* lds, int G, int bx, const int tid) {
    const bf16_t* QB = (const bf16_t*)(ws + WS_QB); const bf16_t* KN = (const bf16_t*)(ws + WS_KN); const bf16_t* KR = (const bf16_t*)(ws + WS_KR); const bf16_t* VB = (const bf16_t*)(ws + WS_VB);
    bf16_t* MIX = (bf16_t*)(wsw + WS_MIX);
    for (int c = bx; c < 256; c += G) {
        const int x = c & 7, y = c >> 3, bh = 8 * (y >> 2) + x, p = y & 3, b = bh >> 3, h = bh & 7;
#pragma unroll 1
        for (int k = 0; k < 2; ++k) attn_unit(b, h, k == 0 ? 8 - p : 1 + p, QB, KN, KR, VB, MIX, lds, tid);
    }
}
}
#define XB_TMO      128
#define XB_XCNT(j)  (256  + 64 * (j))
#define XB_XSUB(j)  (1280 + 64 * (j))
#define XB_XGEN(j)  (2304 + 64 * (j))
#define XB_TOP      3328
#define XB_TOPGEN   3392
#define XCD_BAR_WORDS 3456
#define XB_SPIN_CAP (1u << 18)
__device__ __forceinline__ unsigned xb_ld(unsigned* p)              { return __hip_atomic_load(p, __ATOMIC_RELAXED, __HIP_MEMORY_SCOPE_AGENT); }
__device__ __forceinline__ unsigned xb_add(unsigned* p, unsigned v) { return __hip_atomic_fetch_add(p, v, __ATOMIC_RELAXED, __HIP_MEMORY_SCOPE_AGENT); }
__device__ __forceinline__ unsigned xb_xcc_id() { return (unsigned)__builtin_amdgcn_s_getreg((3 << 11) | 20) & 0xFu; }
#define XB_SPIN(cond, bar) do { unsigned _sp = 0; while (cond) { __builtin_amdgcn_s_sleep(1); \
    if ((++_sp & 255u) == 0u) { if (xb_ld(&(bar)[XB_TMO])) break; if (_sp > XB_SPIN_CAP) { atomicAdd(&(bar)[XB_TMO], 1u); break; } } } } while (0)
struct XcdBarrier { unsigned* bar; unsigned x; volatile LAS unsigned* st; };
__device__ __forceinline__ XcdBarrier xcd_barrier_post(unsigned* bar, volatile LAS unsigned* st) {
    XcdBarrier b; b.bar = bar; b.x = xb_xcc_id(); b.st = st;
    if (threadIdx.x == 0) (void)xb_add(&bar[XB_XCNT(b.x)], 1u);
    return b;
}
__device__ __forceinline__ void xcd_barrier_complete(unsigned* bar, unsigned x, unsigned& nloc, unsigned& nx) {
    const unsigned G = gridDim.x * gridDim.y * gridDim.z;
    unsigned sum, cnt, mine, sp = 0u;
    for (;;) {
        sum = 0u; cnt = 0u; mine = 0u;
#pragma unroll
        for (unsigned j = 0; j < 16; ++j) { const unsigned c = xb_ld(&bar[XB_XCNT(j)]); sum += c; cnt += (c > 0u) ? 1u : 0u; mine = (j == x) ? c : mine; }
        if (sum == G) break;
        __builtin_amdgcn_s_sleep(1);
        if ((++sp & 255u) == 0u) { if (xb_ld(&bar[XB_TMO])) break; if (sp > XB_SPIN_CAP) { atomicAdd(&bar[XB_TMO], 1u); break; } }
    }
    nloc = mine > 0u ? mine : 1u; nx = cnt > 0u ? cnt : 1u;
}
__device__ __forceinline__ void xcd_barrier(const XcdBarrier& b) {
    asm volatile("s_waitcnt vmcnt(0)" ::: "memory");
    __syncthreads();
    if (threadIdx.x == 0) {
        unsigned* bar = b.bar;
        __builtin_amdgcn_s_waitcnt(0);
        unsigned nloc = b.st[0], nx = b.st[1];
        if (nloc == 0u) { xcd_barrier_complete(bar, b.x, nloc, nx); b.st[0] = nloc; b.st[1] = nx; }
        const unsigned old = xb_add(&bar[XB_XSUB(b.x)], 1u);
        const unsigned gen = old / nloc;
        if (old + 1u == (gen + 1u) * nloc) {
            __builtin_amdgcn_fence(__ATOMIC_RELEASE, "agent");
            asm volatile("s_waitcnt vmcnt(0)" ::: "memory");
            const unsigned og = xb_add(&bar[XB_TOP], 1u);
            const unsigned tg = og / nx;
            if (og + 1u == (tg + 1u) * nx) xb_add(&bar[XB_TOPGEN], 1u);
            else XB_SPIN(xb_ld(&bar[XB_TOPGEN]) == tg, bar);
            __builtin_amdgcn_fence(__ATOMIC_ACQUIRE, "agent");
            xb_add(&bar[XB_XGEN(b.x)], 1u);
            asm volatile("s_waitcnt vmcnt(0)" ::: "memory");
        } else {
            XB_SPIN(xb_ld(&bar[XB_XGEN(b.x)]) == gen, bar);
            __builtin_amdgcn_fence(__ATOMIC_ACQUIRE, "agent");
            asm volatile("s_waitcnt vmcnt(0)" ::: "memory");
        }
    }
    __syncthreads();
}
constexpr int CW_BAR = 4096;

constexpr int CVS_P1 = 0, CVS_P2 = 3072, CVS_P3 = 4352, CVS_P3B = 8192, CVS_P4 = 8448, CVS_P6 = 11776;
static_assert(CVS_P1 + 16 * 7 + 80 * 13 + 160 * 12 == CVS_P2 && CVS_P2 + 140 * 4 + 24 * 7 + 92 * 6 == CVS_P3 && CVS_P3 + 256 * 15 == CV_ITEMS_W1 && CVS_P3B == CV_ITEMS_W1 && CVS_P3B + 256 == CVS_P4 && CVS_P4 + 256 * 13 == CVS_P6 && CVS_P6 + 512 == CV_ITEMS, "conversion plan");
constexpr int PH_P0 = 0, PH_P1 = 1, PH_P1B = 2, PH_P2 = 3, PH_P3 = 4, PH_P4 = 5, PH_P5 = 6, PH_P6 = 7, PH_P7 = 8, PH_P8 = 9, PH_END = 10;
struct Args { Ptrs P; int ph_lo, ph_hi, use_bar, pad; };
#define CAS __attribute__((address_space(4)))
__device__ __forceinline__ void load_ptrs(const CAS Args* a, Ptrs& P) { P.x = a->P.x; P.meta = a->P.meta; P.g_attn = a->P.g_attn; P.w_in = a->P.w_in; P.g_q = a->P.g_q; P.w_uq = a->P.w_uq; P.g_kv = a->P.g_kv; P.w_ukv = a->P.w_ukv; P.pool_w = a->P.pool_w; P.pool_scale = a->P.pool_scale; P.w_o = a->P.w_o; P.g_ffn = a->P.g_ffn; P.w_router = a->P.w_router; P.b_router = a->P.b_router; P.w1 = a->P.w1; P.b1 = a->P.b1; P.w2 = a->P.w2; P.b2 = a->P.b2; P.g_final = a->P.g_final; P.out = a->P.out; P.ws = a->P.ws; }
__global__ void __launch_bounds__(NWAVES * 64, 2) mk_fwd(Args args) {
    extern __shared__ __attribute__((aligned(16))) unsigned char lds_raw[];
    LAS unsigned char* lds = (LAS unsigned char*)lds_raw;
    const int G = gridDim.x, bx = blockIdx.x;
#define PHASE_IDS int tid; asm volatile("v_mov_b32 %0, %1" : "=v"(tid) : "v"(threadIdx.x)); const int lane = tid & 63, wave = __builtin_amdgcn_readfirstlane(tid >> 6); \
    const long gw = (long)bx * NWAVES + wave, NGW = (long)G * NWAVES; (void)lane; (void)gw; (void)NGW; \
    const CAS Args* ap_ = (const CAS Args*)__builtin_amdgcn_kernarg_segment_ptr(); asm volatile("" : "+s"(ap_)); Ptrs P; load_ptrs(ap_, P); unsigned char* const ws = P.ws
    volatile LAS unsigned* MISC = (volatile LAS unsigned*)(lds + MISC_OFF);
    if (threadIdx.x < 64) MISC[threadIdx.x] = 0u;
    __syncthreads();
    XcdBarrier bar; bar.bar = (unsigned*)(args.P.ws + WS_CTL) + CW_BAR; bar.x = 0; bar.st = nullptr;
    if (args.use_bar) bar = xcd_barrier_post((unsigned*)(args.P.ws + WS_CTL) + CW_BAR, MISC + 8);
    const int lo = args.ph_lo, hi = args.ph_hi;
#define IN(k) (lo <= (k) && (k) < hi)
    const bool cv_first = ((bx >> 3) & 1) != 0;
#define CV_CALL(W1, F, S, N) do { const CAS Args* ap2_ = (const CAS Args*)__builtin_amdgcn_kernarg_segment_ptr(); asm volatile("" : "+s"(ap2_)); Ptrs Pc_; load_ptrs(ap2_, Pc_); cv_slice<W1>(Pc_, lds_raw, tid, (F), (S), (N)); } while (0)
#define CV_DEAL(W1, S, ca, ka, cb, kb, kc) do { if (G == 256) { int f_, s_, n_; if (bx < (ca)) { f_ = (S) + bx; s_ = (ca); n_ = (ka); } else if (bx < (cb)) { f_ = (S) + (ca) * (ka) + (bx - (ca)); s_ = (cb) - (ca); n_ = (kb); } \
        else { f_ = (S) + (ca) * (ka) + ((cb) - (ca)) * (kb) + (bx - (cb)); s_ = 256 - (cb); n_ = (kc); } CV_CALL(W1, f_, s_, n_); } \
    else { const int tot_ = (ca) * (ka) + ((cb) - (ca)) * (kb) + (256 - (cb)) * (kc); for (int it_ = (S) + bx; it_ < (S) + tot_; it_ += G) CV_CALL(W1, it_, 0, 1); } } while (0)
#define CV_SLICE(W1, S, N) CV_DEAL(W1, S, 0, 0, 0, 0, N)
#define SEAM(k) do { if (IN(k) && IN((k) + 1)) xcd_barrier(bar); } while (0)

    if (IN(PH_P0)) { PHASE_IDS;
        float* scr = (float*)lds_raw + wave * (64 * 65);
        for (long it = gw; it < I_TOTAL; it += NGW) p0_item(P, it, scr, lane);
        for (long p = gw; p < MP; p += NGW) p0_hn_row(P, (int)p, lane);
        { u32x4* z = (u32x4*)(ws + WS_WIN + (size_t)INW * DM * 2); const long n16 = (long)(DM - INW) * DM * 2 / 16;
          for (long i = (long)bx * 512 + tid; i < n16; i += (long)G * 512) z[i] = (u32x4){0u, 0u, 0u, 0u}; }
        { float* ct = (float*)(ws + WS_ROPE); float* st = ct + LSEQ * 32;
          for (long i = (long)bx * 512 + tid; i < LSEQ * 32; i += (long)G * 512) { const int pos = (int)(i / 32), j = (int)(i % 32);
              const float inv = 1.0f / powf(10000.0f, (float)(2 * j) / 64.0f); const float ang = (float)pos * inv; ct[i] = cosf(ang); st[i] = sinf(ang); } }
        { float* wr = (float*)(ws + WS_WR);
          for (long i = (long)bx * 512 + tid; i < DM * NE; i += (long)G * 512) { const int k = (int)(i / NE), e = (int)(i % NE); wr[((k >> 2) * NE + e) * 4 + (k & 3)] = P.w_router[i] * P.g_ffn[k]; } }
        __syncthreads();
    }
    SEAM(PH_P0);
    if (IN(PH_P1)) { PHASE_IDS;
        pg8::ProbP1 pb; pb.A = (const char*)(ws + WS_HN); pb.Bt = (const char*)(ws + WS_WIN); pb.K = DM; pb.lda = DM; pb.ldaB = 2 * DM; pb.ldb = DM; pb.ldbB = 2 * DM; pb.ord.init(MP / 256, 8, G, bx);
        pb.proj = (bf16_t*)(ws + WS_PROJ); pb.kr = (bf16_t*)(ws + WS_KR); pb.rope = (const float*)(ws + WS_ROPE); pb.ssqp = (float*)(ws + WS_RSQ);
        if (cv_first) CV_DEAL(true, CVS_P1, 16, 7, 96, 13, 12);
        pg8::gemm_phase<pg8::ProbP1, true>(lds + RING_OFF, pb, tid);
        if (!cv_first) CV_DEAL(true, CVS_P1, 16, 7, 96, 13, 12);
    }
    if (IN(PH_P1) && IN(PH_P2)) xcd_barrier(bar);
    if (IN(PH_P2)) { PHASE_IDS;
        for (long m = gw; m < MP; m += NGW) p1b_row(P, (int)m, lane);
        if (cv_first) CV_DEAL(true, CVS_P2, 140, 4, 164, 7, 6);
        { pg8::ProbP2q pb; pb.A = (const char*)(ws + WS_PROJ) + 1024 * 2; pb.Bt = (const char*)(ws + WS_WUQ); pb.K = QLORA; pb.lda = DM; pb.ldaB = 2 * DM; pb.ldb = QLORA; pb.ldbB = 2 * QLORA; pb.ord.init(MP / 256, 6, G, bx);
          pb.qb = (bf16_t*)(ws + WS_QB); pb.rsq = (const float*)(ws + WS_RSQ); pb.rope = (const float*)(ws + WS_ROPE);
          pg8::gemm_phase<pg8::ProbP2q, true>(lds + RING_OFF, pb, tid); }
        { pg8::ProbP2kv pb; pb.A = (const char*)(ws + WS_PROJ) + 1536 * 2; pb.Bt = (const char*)(ws + WS_WUKV); pb.K = KVLORA; pb.lda = DM; pb.ldaB = 2 * DM; pb.ldb = KVLORA; pb.ldbB = 2 * KVLORA; pb.ord.init(MP / 256, 8, G, (bx + 116) % G);
          pb.kn = (bf16_t*)(ws + WS_KN); pb.vb = (bf16_t*)(ws + WS_VB); pb.rskv = (const float*)(ws + WS_RSQ);
          pg8::gemm_phase<pg8::ProbP2kv, true>(lds + RING_OFF, pb, tid); }
        if (!cv_first) CV_DEAL(true, CVS_P2, 140, 4, 164, 7, 6);
    }
    SEAM(PH_P2);
    if (IN(PH_P3)) { PHASE_IDS;
        if (cv_first) { CV_SLICE(true, CVS_P3, 15); CV_SLICE(false, CVS_P3B, 1); }
        att::attn_phase(ws, ws, (LAS char*)(lds + RING_OFF), G, bx, tid);
        { pg8::ProbPool pb; pb.A = (const char*)(ws + WS_DP); pb.Bt = (const char*)(ws + WS_WPOOL); pb.K = 256; pb.lda = POOLW; pb.ldaB = 2 * POOLW; pb.ldb = 256; pb.ldbB = 2 * 256; pb.ord.init(MP / 256, 4, G, bx);
          pb.mix = (bf16_t*)(ws + WS_MIX); pb.pscale = P.pool_scale;
          pg8::gemm_phase<pg8::ProbPool, true>(lds + RING_OFF, pb, tid); }
        if (!cv_first) { CV_SLICE(true, CVS_P3, 15); CV_SLICE(false, CVS_P3B, 1); }
    }
    SEAM(PH_P3);
    if (IN(PH_P4)) { PHASE_IDS;
        pg8::ProbP4 pb; pb.A = (const char*)(ws + WS_MIX); pb.Bt = (const char*)(ws + WS_WO); pb.K = DM; pb.lda = DM; pb.ldaB = 2 * DM; pb.ldb = DM; pb.ldbB = 2 * DM; pb.ord.init(MR / 256, 8, G, bx);
        pb.x = P.x; pb.h2 = (bf16_t*)(ws + WS_HN); pb.h2f8 = ws + WS_H2B;
        pg8::gemm_phase<pg8::ProbP4, true>(lds + RING_OFF, pb, tid);
    }
    SEAM(PH_P4);
    if (IN(PH_P5)) { PHASE_IDS; for (int blk = bx; blk < MR / 64; blk += G) p5_block(P, blk, lds_raw, tid); }
    SEAM(PH_P5);
    if (IN(PH_P6)) { PHASE_IDS;
        pg8::moe_table(lds, (const unsigned*)(ws + WS_CTL) + CW_CNT, tid);
        pg8::ProbP6 pb; pb.A = (const char*)(ws + WS_H2B); pb.Bt = (const char*)(ws + WS_W1); pb.K = DM; pb.ldbB = DM; pb.ord.tab = (const LAS int*)(lds + TAB_OFF); pb.ord.G = G; pb.ord.c = bx;
        pb.list = (const int*)(ws + WS_LIST); pb.rsl = (const float*)(ws + WS_RSL); pb.b1 = P.b1; pb.act = ws + WS_ACT;
        const int split = 2 + 4 * ((bx >> 3) & 3);
        pb.ord.i0 = 0; pb.ord.i1 = split;
        pg8::gemm_phase<pg8::ProbP6, true>(lds + RING_OFF, pb, tid);
        CV_SLICE(false, CVS_P4, 13);
        pb.ord.i0 = split; pb.ord.i1 = 0x7fffffff;
        pg8::gemm_phase<pg8::ProbP6, true>(lds + RING_OFF, pb, tid);
        { const int U = ((const LAS int*)(lds + TAB_OFF))[NE] * 16, R = U % G, nidle = G - R, rank0 = (G & 7) ? bx : (bx & 7) * (G >> 3) + (bx >> 3);
          const bool few = nidle < 64; const int nshare = few ? G : nidle, rank = few ? rank0 : rank0 - R;
          if (rank >= 0) { const int cnt_ = (CV_ITEMS - CVS_P6 - rank + nshare - 1) / nshare; CV_CALL(false, CVS_P6 + rank, nshare, cnt_); } }
    }
    SEAM(PH_P6);
    if (IN(PH_P7)) { PHASE_IDS;
        pg8::moe_table(lds, (const unsigned*)(ws + WS_CTL) + CW_CNT, tid);
        pg8::ProbP7 pb; pb.A = (const char*)(ws + WS_ACT); pb.Bt = (const char*)(ws + WS_W2); pb.K = DFF; pb.ldbB = DFF; pb.ord.tab = (const LAS int*)(lds + TAB_OFF); pb.ord.G = G; pb.ord.c = bx; pb.ord.i0 = 0; pb.ord.i1 = 0x7fffffff;
        pb.list = (const int*)(ws + WS_LIST); pb.gate = (const float*)(ws + WS_GATE); pb.b2 = P.b2; pb.yb = ws + WS_YB;
        pg8::gemm_phase<pg8::ProbP7, true>(lds + RING_OFF, pb, tid);
    }
    SEAM(PH_P7);
    if (IN(PH_P8)) { PHASE_IDS; for (long r = gw; r < MR; r += NGW) p8_row(P, (int)r, lane, P.out); }
#undef IN
#undef SEAM
}

extern "C" void kernel_launch(void* const* d_in, const int* in_sizes, int n_in, void* d_out, int out_size, void* d_ws, size_t ws_size, hipStream_t stream) {
    static int ok = 0; static int grid = 256;
    if (ok == 0) {
        if (n_in != 19 || in_sizes[0] != NB * SEQ * DM || out_size != MR * DM || ws_size < WS_END) { fprintf(stderr, "kernel_launch: shape mismatch n_in %d in0 %d out %d ws %zu\n", n_in, n_in > 0 ? in_sizes[0] : -1, out_size, ws_size); ok = -1; return; }
        if (hipFuncSetAttribute((const void*)mk_fwd, hipFuncAttributeMaxDynamicSharedMemorySize, LDS_BYTES) != hipSuccess) { fprintf(stderr, "hipFuncSetAttribute(mk) failed\n"); ok = -1; return; }
        int dev = 0, cus = 0; (void)hipGetDevice(&dev); (void)hipDeviceGetAttribute(&cus, hipDeviceAttributeMultiprocessorCount, dev); if (cus > 0) grid = cus;
        ok = 1;
    }
    if (ok < 0) return;
    Ptrs P{};
    const float** pp = (const float**)&P;
    for (int i = 0; i < 19; ++i) pp[i] = (const float*)d_in[i];
    P.out = (float*)d_out; P.ws = (unsigned char*)d_ws;
    unsigned char* ws = (unsigned char*)d_ws;
    (void)hipMemsetAsync(ws + WS_CTL, 0, CTL_ZERO_BYTES, stream);
    { Args a{}; a.P = P; a.ph_lo = 0; a.ph_hi = PH_END; a.use_bar = 1; a.pad = 0;
      hipLaunchKernelGGL(mk_fwd, dim3(grid), dim3(NWAVES * 64), LDS_BYTES, stream, a); }
}
```

```cpp
#include <hip/hip_runtime.h>
#include <cstdint>
#include <cstdio>

constexpr int NB = 8, SEQ = 2048, NMETA = 16, LSEQ = 2064, LP = 2112, PADR = 48, MP = NB * LP, MR = NB * SEQ;
constexpr int DM = 2048, POOLW = 1024, QLORA = 512, KVLORA = 256, QKROPE = 64, QKNOPE = 128, VDIM = 128, NH = 8, QKD = 192;
constexpr int INW = 1856, NE = 32, TOPK = 4, DFF = 2048;
constexpr float EPS = 1e-5f;
constexpr float C2 = 0.07216878364870322f * 1.4426950408889634f;
constexpr int ACT_ROWS = MR * TOPK + NE * 256;

typedef unsigned short bf16_t;
typedef unsigned u32x4 __attribute__((ext_vector_type(4)));
typedef float f32x4 __attribute__((ext_vector_type(4)));

constexpr size_t MiB = 1u << 20;
constexpr size_t WS_CTL = 0, CTL_ZERO_BYTES = 1 * MiB;
constexpr size_t WS_ROPE = 1 * MiB;
constexpr size_t WS_WR = 2 * MiB;
constexpr size_t WS_WIN = 4 * MiB;
constexpr size_t WS_WUQ = 12 * MiB;
constexpr size_t WS_WUKV = 14 * MiB;
constexpr size_t WS_WPOOL = 15 * MiB;
constexpr size_t WS_WO = 16 * MiB;
constexpr size_t WS_W1 = 24 * MiB;
constexpr size_t WS_W2 = 536 * MiB;
constexpr size_t WS_HN = 792 * MiB;
constexpr size_t WS_PROJ = 860 * MiB;
constexpr size_t WS_QB = 928 * MiB;
constexpr size_t WS_KN = 980 * MiB;
constexpr size_t WS_VB = 1014 * MiB;
constexpr size_t WS_KR = 1048 * MiB;
constexpr size_t WS_RSQ = 1051 * MiB;
constexpr size_t WS_RSKV = 1052 * MiB;
constexpr size_t WS_RS2 = 1053 * MiB;
constexpr size_t WS_DP = 1054 * MiB;
constexpr size_t WS_MIX = 1088 * MiB;
constexpr size_t WS_H2B = 1156 * MiB;
constexpr size_t WS_LIST = 1220 * MiB;
constexpr size_t WS_GATE = 1222 * MiB;
constexpr size_t WS_ACT = 1224 * MiB;
constexpr size_t WS_YB = 1512 * MiB;
constexpr size_t WS_RSL = 1768 * MiB;
constexpr size_t WS_END = 1770 * MiB;
constexpr int CW_CNT = 64;

struct Ptrs {
    const float *x, *meta, *g_attn, *w_in, *g_q, *w_uq, *g_kv, *w_ukv, *pool_w, *pool_scale, *w_o, *g_ffn, *w_router, *b_router, *w1, *b1, *w2, *b2, *g_final;
    float* out; unsigned char* ws;
};

__device__ __forceinline__ float bf2f(bf16_t v) { return __uint_as_float((unsigned)v << 16); }
__device__ __forceinline__ unsigned f2bf(float f) { unsigned u = __float_as_uint(f); return (u + 0x7fffu + ((u >> 16) & 1u)) >> 16; }
__device__ __forceinline__ unsigned pk2(float lo, float hi) { return f2bf(lo) | (f2bf(hi) << 16); }
__device__ __forceinline__ float wave_sum(float v) {
#pragma unroll
    for (int o = 1; o < 64; o <<= 1) v += __shfl_xor(v, o);
    return v;
}
__device__ __forceinline__ float wave_max(float v) {
#pragma unroll
    for (int o = 1; o < 64; o <<= 1) v = fmaxf(v, __shfl_xor(v, o));
    return v;
}

__device__ __forceinline__ void p0_hn_row(const Ptrs& P, int p, int lane) {
    bf16_t* hn = (bf16_t*)(P.ws + WS_HN) + (size_t)p * DM;
    const int b = p / LP, q = p % LP;
    unsigned long long* o8 = (unsigned long long*)hn + lane;
    if (q < PADR) {
#pragma unroll
        for (int j = 0; j < 8; ++j) o8[64 * j] = 0ull;
        return;
    }
    const int pos = q - PADR;
    const float* src = pos < NMETA ? P.meta + (size_t)pos * DM : P.x + ((size_t)b * SEQ + (pos - NMETA)) * DM;
    const f32x4* xr = (const f32x4*)src + lane;
    const f32x4* gr = (const f32x4*)P.g_attn + lane;
    f32x4 v[8]; float s = 0.f;
#pragma unroll
    for (int j = 0; j < 8; ++j) { v[j] = xr[64 * j]; s += (v[j].x * v[j].x + v[j].y * v[j].y) + (v[j].z * v[j].z + v[j].w * v[j].w); }
    const float rs = 1.0f / sqrtf(wave_sum(s) * (1.0f / DM) + EPS);
#pragma unroll
    for (int j = 0; j < 8; ++j) { const f32x4 g = gr[64 * j];
        o8[64 * j] = (unsigned long long)pk2(v[j].x * rs * g.x, v[j].y * rs * g.y) | ((unsigned long long)pk2(v[j].z * rs * g.z, v[j].w * rs * g.w) << 32); }
}
template <int MODE> __device__ __forceinline__ int nmap(int n) {
    if (MODE == 1) { if (n >= 1792) { const int j = n - 1792; return 1792 + (j < 32 ? 2 * j : 2 * (j - 32) + 1); } return n; }
    if (MODE == 2) { const int h = n / 192, d = n % 192; if (d >= 128) { const int j = d - 128; return h * 192 + 128 + (j < 32 ? 2 * j : 2 * (j - 32) + 1); } return n; }
    return n;
}
template <int MODE> __device__ __forceinline__ void p0_transpose_item(const float* W, int K, int N, bf16_t* WT, const float* gk, float* scr, int item, int lane) {
    const int nblk = N / 64, kb = item / nblk, nb = item % nblk, k0 = 64 * kb, n0 = 64 * nb;
    const int kl = lane >> 4, nl = (lane & 15) * 4;
#pragma unroll 4
    for (int i = 0; i < 16; ++i) { const int kk = kl + 4 * i; const f32x4 v = *(const f32x4*)(W + (size_t)(k0 + kk) * N + n0 + nl);
        const float g = gk ? gk[k0 + kk] : 1.0f;
        float* s = scr + kk * 65 + nl; s[0] = v.x * g; s[1] = v.y * g; s[2] = v.z * g; s[3] = v.w * g; }
    __builtin_amdgcn_s_waitcnt(0xc07f); asm volatile("" ::: "memory");
    const int c = lane & 7;
#pragma unroll
    for (int j = 0; j < 8; ++j) { const int n = (lane >> 3) + 8 * j; const float* s = scr + (8 * c) * 65 + n;
        u32x4 o; o.x = pk2(s[0 * 65], s[1 * 65]); o.y = pk2(s[2 * 65], s[3 * 65]); o.z = pk2(s[4 * 65], s[5 * 65]); o.w = pk2(s[6 * 65], s[7 * 65]);
        *(u32x4*)(WT + (size_t)nmap<MODE>(n0 + n) * K + k0 + 8 * c) = o; }
    __builtin_amdgcn_s_waitcnt(0xc07f); asm volatile("" ::: "memory");
}
__device__ __forceinline__ void p0_transpose_item_f8(const float* W, int K, int N, unsigned char* WT, const float* gk, float scale, float* scr, int item, int lane) {
    const int nblk = N / 64, kb = item / nblk, nb = item % nblk, k0 = 64 * kb, n0 = 64 * nb;
    const int kl = lane >> 4, nl = (lane & 15) * 4;
#pragma unroll 4
    for (int i = 0; i < 16; ++i) { const int kk = kl + 4 * i; const f32x4 v = *(const f32x4*)(W + (size_t)(k0 + kk) * N + n0 + nl);
        const float g = (gk ? gk[k0 + kk] : 1.0f) * scale;
        float* s = scr + kk * 65 + nl; s[0] = v.x * g; s[1] = v.y * g; s[2] = v.z * g; s[3] = v.w * g; }
    asm volatile("s_waitcnt lgkmcnt(0)" ::: "memory");
    const int c = lane & 7;
#pragma unroll
    for (int j = 0; j < 8; ++j) { const int n = (lane >> 3) + 8 * j; const float* s = scr + (8 * c) * 65 + n;
        int w0 = 0, w1 = 0;
        w0 = __builtin_amdgcn_cvt_pk_fp8_f32(s[0 * 65], s[1 * 65], w0, false); w0 = __builtin_amdgcn_cvt_pk_fp8_f32(s[2 * 65], s[3 * 65], w0, true);
        w1 = __builtin_amdgcn_cvt_pk_fp8_f32(s[4 * 65], s[5 * 65], w1, false); w1 = __builtin_amdgcn_cvt_pk_fp8_f32(s[6 * 65], s[7 * 65], w1, true);
        *(unsigned long long*)(WT + (size_t)(n0 + n) * K + k0 + 8 * c) = (unsigned long long)(unsigned)w0 | ((unsigned long long)(unsigned)w1 << 32); }
    asm volatile("s_waitcnt lgkmcnt(0)" ::: "memory");
}
constexpr int CV_ITEMS_W1 = NE * (DM / 128) * (4096 / 256), CV_ITEMS_W2 = NE * (DFF / 128) * (DM / 256), CV_ITEMS = CV_ITEMS_W1 + CV_ITEMS_W2;
struct CvItem { const float* src; unsigned char* dst; const float* gk; };
template <bool W1> __device__ __forceinline__ CvItem cv_decode(const Ptrs& P, int it) {
    CvItem c;
    if (W1) { const int e = it >> 8, r = it & 255, kb = r >> 4, nb = r & 15;
        c.src = P.w1 + (size_t)e * DM * 4096 + (size_t)kb * 128 * 4096 + nb * 256; c.dst = P.ws + WS_W1 + ((size_t)e * 4096 + nb * 256) * DM + kb * 128; c.gk = P.g_ffn + kb * 128; }
    else { const int j = it - CV_ITEMS_W1, e = j >> 7, r = j & 127, kb = r >> 3, nb = r & 7;
        c.src = P.w2 + (size_t)e * DFF * DM + (size_t)kb * 128 * DM + nb * 256; c.dst = P.ws + WS_W2 + ((size_t)e * DM + nb * 256) * DFF + kb * 128; c.gk = nullptr; }
    return c;
}
#define CV_LOAD(V, C) do { const __amdgpu_buffer_rsrc_t rs_ = __builtin_amdgcn_make_buffer_rsrc((void*)(C).src, 0, 0x7ffffffe, 0x00020000); \
        _Pragma("unroll") for (int i_ = 0; i_ < 16; ++i_) V[i_] = __builtin_bit_cast(f32x4, __builtin_amdgcn_raw_buffer_load_b128(rs_, lane * 16, (wave + 8 * i_) * NN * 4, 2  )); } while (0)
#define CV_PROCESS(V, C, NEXT_IDX) do { \
        _Pragma("unroll") for (int i_ = 0; i_ < 16; ++i_) { const int k_ = wave + 8 * i_; const float g_ = W1 ? (C).gk[k_] * 32.0f : 32.0f; float* s_ = scr + k_ * 257 + lane * 4; \
            s_[0] = V[i_].x * g_; s_[1] = V[i_].y * g_; s_[2] = V[i_].z * g_; s_[3] = V[i_].w * g_; } \
        unsigned char* dst_ = (C).dst; \
        { const int nx_ = (NEXT_IDX) < count ? (NEXT_IDX) : count - 1; (C) = cv_decode<W1>(P, first + nx_ * step); CV_LOAD(V, C); } \
        asm volatile("s_waitcnt lgkmcnt(0)\n\ts_barrier" ::: "memory"); \
          \
        _Pragma("unroll") for (int p_ = 0; p_ < 4; ++p_) { const int u_ = p_ * 8 + wave, nn_ = (u_ >> 1) * 16 + (lane >> 2), k0_ = (u_ & 1) * 64 + (lane & 3) * 16; \
            const float* t_ = scr + k0_ * 257 + nn_; u32x4 w_; \
            _Pragma("unroll") for (int d_ = 0; d_ < 4; ++d_) { int x_ = 0; x_ = __builtin_amdgcn_cvt_pk_fp8_f32(t_[(4 * d_) * 257], t_[(4 * d_ + 1) * 257], x_, false); \
                x_ = __builtin_amdgcn_cvt_pk_fp8_f32(t_[(4 * d_ + 2) * 257], t_[(4 * d_ + 3) * 257], x_, true); w_[d_] = (unsigned)x_; } \
            *(u32x4*)(dst_ + (size_t)nn_ * DM + k0_) = w_; } \
        asm volatile("s_waitcnt lgkmcnt(0)\n\ts_barrier" ::: "memory"); } while (0)
template <bool W1> __device__ __forceinline__ void cv_slice(const Ptrs& P, unsigned char* ldsg, int tid, int first, int step, int count) {
    if (count <= 0) return;
    constexpr int NN = W1 ? 4096 : DM;
    float* scr = (float*)ldsg;
    const int lane = tid & 63, wave = __builtin_amdgcn_readfirstlane(tid >> 6);
    f32x4 va[16];
    CvItem ca = cv_decode<W1>(P, first);
    CV_LOAD(va, ca);
    for (int n = 0; n < count; ++n) CV_PROCESS(va, ca, n + 1);
    asm volatile("s_waitcnt vmcnt(0)" ::: "memory");
}
#undef CV_LOAD
#undef CV_PROCESS
constexpr int I_WIN = (DM / 64) * (INW / 64), I_WUQ = (QLORA / 64) * (1536 / 64), I_WUKV = (KVLORA / 64) * (2048 / 64), I_POOL1 = 4 * 4, I_WO = 32 * 32,
              I_W1E = (DM / 64) * (4096 / 64), I_W2E = 32 * 32;
constexpr int I_SMALL = I_WIN + I_WUQ + I_WUKV + 4 * I_POOL1 + I_WO;
constexpr long I_TOTAL = (long)I_SMALL;
__device__ __forceinline__ void p0_item(const Ptrs& P, long it, float* scr, int lane) {
    unsigned char* ws = P.ws;
    if (it < I_SMALL) {
        int r = (int)it;
        if (r < I_WIN) { p0_transpose_item<1>(P.w_in, DM, INW, (bf16_t*)(ws + WS_WIN), nullptr, scr, r, lane); return; } r -= I_WIN;
        if (r < I_WUQ) { p0_transpose_item<2>(P.w_uq, QLORA, 1536, (bf16_t*)(ws + WS_WUQ), P.g_q, scr, r, lane); return; } r -= I_WUQ;
        if (r < I_WUKV) { p0_transpose_item<0>(P.w_ukv, KVLORA, 2048, (bf16_t*)(ws + WS_WUKV), P.g_kv, scr, r, lane); return; } r -= I_WUKV;
        if (r < 4 * I_POOL1) { const int g = r / I_POOL1; p0_transpose_item<0>(P.pool_w + (size_t)g * 65536, 256, 256, (bf16_t*)(ws + WS_WPOOL) + (size_t)g * 65536, nullptr, scr, r % I_POOL1, lane); return; } r -= 4 * I_POOL1;
        p0_transpose_item<0>(P.w_o, DM, DM, (bf16_t*)(ws + WS_WO), nullptr, scr, r, lane); return;
    }
    it -= I_SMALL;
    if (it < (long)NE * I_W1E) { const int e = (int)(it / I_W1E), r = (int)(it % I_W1E);
        p0_transpose_item_f8(P.w1 + (size_t)e * DM * 4096, DM, 4096, ws + WS_W1 + (size_t)e * 4096 * DM, P.g_ffn, 32.0f, scr, r, lane); return; }
    it -= (long)NE * I_W1E;
    { const int e = (int)(it / I_W2E), r = (int)(it % I_W2E);
      p0_transpose_item_f8(P.w2 + (size_t)e * DFF * DM, DFF, DM, ws + WS_W2 + (size_t)e * DM * DFF, nullptr, 32.0f, scr, r, lane); }
}
__device__ __forceinline__ void st4bf(bf16_t* p, float a, float b, float c, float d) { *(unsigned long long*)p = (unsigned long long)pk2(a, b) | ((unsigned long long)pk2(c, d) << 32); }
__device__ __forceinline__ void p1b_row(const Ptrs& P, int m, int lane) {
    const bf16_t* proj = (const bf16_t*)(P.ws + WS_PROJ);
    const bf16_t* row = proj + (size_t)m * DM;
    bf16_t* dp = (bf16_t*)(P.ws + WS_DP) + (size_t)m * POOLW;
    const int pos = (m % LP) - PADR;
    if (pos < 0) {
#pragma unroll
        for (int g = 0; g < 4; ++g) *(unsigned long long*)(dp + g * 256 + lane * 4) = 0ull;
        return;
    }
    unsigned long long ld[30];
    { int q = 0;
#pragma unroll
      for (int g = 0; g < 4; ++g)
#pragma unroll
          for (int j = 0; j < (2 << g); ++j) { const int jj = j < pos ? j : pos; ld[q++] = *(const unsigned long long*)(row - (size_t)jj * DM + g * 256 + lane * 4); } }
    { int q = 0;
#pragma unroll
      for (int g = 0; g < 4; ++g) { const int w = 2 << g; const int cntw = pos + 1 < w ? pos + 1 : w;
        float s0 = 0.f, s1 = 0.f, s2 = 0.f, s3 = 0.f, u0 = 0.f, u1 = 0.f, u2 = 0.f, u3 = 0.f;
#pragma unroll
        for (int j = 0; j < w; ++j) { const unsigned long long v = ld[q++]; const unsigned lo = (unsigned)v, hi = (unsigned)(v >> 32);
            const float mk = j < cntw ? 1.0f : 0.0f;
            const float a = __uint_as_float(lo << 16) * mk, b2 = __uint_as_float(lo & 0xffff0000u) * mk, cc = __uint_as_float(hi << 16) * mk, d = __uint_as_float(hi & 0xffff0000u) * mk;
            if (j == 0) { u0 = a; u1 = b2; u2 = cc; u3 = d; } s0 += a; s1 += b2; s2 += cc; s3 += d; }
        const float ic = 1.0f / (float)cntw;
        st4bf(dp + g * 256 + lane * 4, s0 * ic - u0, s1 * ic - u1, s2 * ic - u2, s3 * ic - u3); } }
}
typedef float f32x16_t __attribute__((ext_vector_type(16)));
__device__ __forceinline__ void p5_block(const Ptrs& P, int blk, unsigned char* ldsg, int tid) {
    const int lane = tid & 63, wave = tid >> 6, t = lane & 31, kk = lane >> 5, tg = wave >> 2, kq = wave & 3;
    float* part = (float*)ldsg;
    float* ssqp = part + 8 * 32 * 33;
    const bf16_t* arow = (const bf16_t*)(P.ws + WS_HN) + (size_t)(blk * 64 + tg * 32 + t) * DM + kq * 512 + 16 * kk;
    const f32x4* bptr = (const f32x4*)(P.ws + WS_WR) + ((kq * 128 + 4 * kk) * NE + t);
    f32x16_t acc;
#pragma unroll
    for (int r = 0; r < 16; ++r) acc[r] = 0.f;
    float ss = 0.f;
#pragma unroll 2
    for (int j = 0; j < 16; ++j) {
        f32x4 a[4], b[4]; const u32x4 d0 = *(const u32x4*)(arow + 32 * j), d1 = *(const u32x4*)(arow + 32 * j + 8);
#pragma unroll
        for (int q = 0; q < 4; ++q) b[q] = bptr[(8 * j + q) * NE];
        a[0] = (f32x4){__uint_as_float(d0[0] << 16), __uint_as_float(d0[0] & 0xffff0000u), __uint_as_float(d0[1] << 16), __uint_as_float(d0[1] & 0xffff0000u)};
        a[1] = (f32x4){__uint_as_float(d0[2] << 16), __uint_as_float(d0[2] & 0xffff0000u), __uint_as_float(d0[3] << 16), __uint_as_float(d0[3] & 0xffff0000u)};
        a[2] = (f32x4){__uint_as_float(d1[0] << 16), __uint_as_float(d1[0] & 0xffff0000u), __uint_as_float(d1[1] << 16), __uint_as_float(d1[1] & 0xffff0000u)};
        a[3] = (f32x4){__uint_as_float(d1[2] << 16), __uint_as_float(d1[2] & 0xffff0000u), __uint_as_float(d1[3] << 16), __uint_as_float(d1[3] & 0xffff0000u)};
#pragma unroll
        for (int q = 0; q < 4; ++q) {
            ss += (a[q].x * a[q].x + a[q].y * a[q].y) + (a[q].z * a[q].z + a[q].w * a[q].w);
            acc = __builtin_amdgcn_mfma_f32_32x32x2f32(a[q].x, b[q].x, acc, 0, 0, 0); acc = __builtin_amdgcn_mfma_f32_32x32x2f32(a[q].y, b[q].y, acc, 0, 0, 0);
            acc = __builtin_amdgcn_mfma_f32_32x32x2f32(a[q].z, b[q].z, acc, 0, 0, 0); acc = __builtin_amdgcn_mfma_f32_32x32x2f32(a[q].w, b[q].w, acc, 0, 0, 0);
        }
    }
    ss += __shfl_xor(ss, 32);
#pragma unroll
    for (int r = 0; r < 16; ++r) part[(wave * 32 + ((r & 3) + 8 * (r >> 2) + 4 * kk)) * 33 + t] = acc[r];
    if (kk == 0) ssqp[wave * 32 + t] = ss;
    __syncthreads();
    if (tid < 64) {
        const int tg2 = tid >> 5, ti = tid & 31, r = blk * 64 + tid;
        float lg[NE];
#pragma unroll
        for (int e = 0; e < NE; ++e) lg[e] = (part[((tg2 * 4 + 0) * 32 + ti) * 33 + e] + part[((tg2 * 4 + 1) * 32 + ti) * 33 + e]) + (part[((tg2 * 4 + 2) * 32 + ti) * 33 + e] + part[((tg2 * 4 + 3) * 32 + ti) * 33 + e]);
        const float ssq = (ssqp[(tg2 * 4 + 0) * 32 + ti] + ssqp[(tg2 * 4 + 1) * 32 + ti]) + (ssqp[(tg2 * 4 + 2) * 32 + ti] + ssqp[(tg2 * 4 + 3) * 32 + ti]);
        const float rs = 1.0f / sqrtf(ssq * (1.0f / DM) + EPS);
#pragma unroll
        for (int e = 0; e < NE; ++e) lg[e] = lg[e] * rs + P.b_router[e];
        ((float*)(P.ws + WS_RS2))[r] = rs;
        int idx[TOPK]; float val[TOPK]; unsigned used = 0u;
#pragma unroll
        for (int k = 0; k < TOPK; ++k) { float best = -INFINITY; int bi = 0;
#pragma unroll
            for (int e = 0; e < NE; ++e) { const bool ok = !((used >> e) & 1u) && lg[e] > best; best = ok ? lg[e] : best; bi = ok ? e : bi; }
            used |= 1u << bi; idx[k] = bi; val[k] = best; }
        float den = 0.f, pe[TOPK];
#pragma unroll
        for (int k = 0; k < TOPK; ++k) { pe[k] = __expf(val[k] - val[0]); den += pe[k]; }
        unsigned* cnt = (unsigned*)(P.ws + WS_CTL) + CW_CNT; int* list = (int*)(P.ws + WS_LIST); float* gate = (float*)(P.ws + WS_GATE); float* rsl = (float*)(P.ws + WS_RSL);
        unsigned* lcnt = (unsigned*)(ssqp + 8 * 32); unsigned* lbase = lcnt + NE;
        if (tid < NE) lcnt[tid] = 0u;
        unsigned rk[TOPK];
#pragma unroll
        for (int k = 0; k < TOPK; ++k) rk[k] = __hip_atomic_fetch_add(lcnt + idx[k], 1u, __ATOMIC_RELAXED, __HIP_MEMORY_SCOPE_WORKGROUP);
        if (tid < NE) { const unsigned n = lcnt[tid]; lbase[tid] = n ? atomicAdd(cnt + tid, n) : 0u; }
#pragma unroll
        for (int k = 0; k < TOPK; ++k) { const unsigned slot = lbase[idx[k]] + rk[k]; const size_t o = (size_t)idx[k] * MR + slot; list[o] = r * 4 + k; gate[o] = pe[k] / den; rsl[o] = rs; }
    }
    __syncthreads();
}
__device__ __forceinline__ void p8_row(const Ptrs& P, int r, int lane, float* outbase) {
    const bf16_t* h2 = (const bf16_t*)(P.ws + WS_HN) + (size_t)r * DM; float* orow = outbase + (size_t)r * DM; const unsigned char* yb = P.ws + WS_YB + (size_t)r * 4 * DM;
    f32x4 v[8]; float s = 0.f;
#pragma unroll
    for (int j = 0; j < 8; ++j) { const int c = 4 * lane + 256 * j;
        { const unsigned long long y = *(const unsigned long long*)(h2 + c); const unsigned lo = (unsigned)y, hi = (unsigned)(y >> 32);
          v[j] = (f32x4){__uint_as_float(lo << 16), __uint_as_float(lo & 0xffff0000u), __uint_as_float(hi << 16), __uint_as_float(hi & 0xffff0000u)}; }
#pragma unroll
        for (int k = 0; k < 4; ++k) { const unsigned y = *(const unsigned*)(yb + (size_t)k * DM + c); typedef float f2_t __attribute__((ext_vector_type(2)));
            const f2_t lo = __builtin_amdgcn_cvt_pk_f32_fp8((int)y, false), hi = __builtin_amdgcn_cvt_pk_f32_fp8((int)y, true);
            v[j].x += lo.x * (1.0f / 16.0f); v[j].y += lo.y * (1.0f / 16.0f); v[j].z += hi.x * (1.0f / 16.0f); v[j].w += hi.y * (1.0f / 16.0f); }
        s += (v[j].x * v[j].x + v[j].y * v[j].y) + (v[j].z * v[j].z + v[j].w * v[j].w); }
    const float rs = 1.0f / sqrtf(wave_sum(s) * (1.0f / DM) + EPS);
#pragma unroll
    for (int j = 0; j < 8; ++j) { const int c = 4 * lane + 256 * j; const f32x4 g = *(const f32x4*)(P.g_final + c);
        __builtin_nontemporal_store((f32x4){v[j].x * rs * g.x, v[j].y * rs * g.y, v[j].z * rs * g.z, v[j].w * rs * g.w}, (f32x4*)(orow + c)); }
}
#define LAS __attribute__((address_space(3)))
#define GAS __attribute__((address_space(1)))
typedef short bf16x8 __attribute__((ext_vector_type(8)));
typedef int v4i_t __attribute__((ext_vector_type(4)));
typedef GAS unsigned gu32;
#define RLX_AGENT __ATOMIC_RELAXED, __HIP_MEMORY_SCOPE_AGENT
constexpr int NWAVES = 8;
constexpr int RING_OFF = 0, RING_BYTES = 131072;
constexpr int TAB_OFF = 133 * 1024;
constexpr int MISC_OFF = 143 * 1024;
constexpr int LDS_BYTES = 147456;

namespace pg8 {
constexpr int BM = 256, BK = 64, HALF = 128, HTB = HALF * BK * 2, NXCD = 8, WGM = 8;
__host__ __device__ __forceinline__ int lds_byte(int r, int c) { const int st = (r >> 4) * 2 + (c >> 5), rr = r & 15, cc = c & 31, ob = rr * 64 + cc * 2; return st * 1024 + (ob ^ (((ob >> 9) & 1) << 5)); }
__host__ __device__ __forceinline__ void stage_rc(int b, int& R, int& C) { const int st = b / 1024, sb = b % 1024, swz = sb ^ (((sb >> 9) & 1) << 5); R = (st >> 1) * 16 + swz / 64; C = (st & 1) * 32 + (swz % 64) / 2; }
__host__ __device__ __forceinline__ void stage_rc_f8(int b, int& R, int& Cb) { const int s = b >> 4; R = s >> 3; const int q = s & 7; Cb = 32 * ((q >> 1) ^ ((R >> 1) & 3)) + 16 * (q & 1); }
__host__ __device__ __forceinline__ int perm32(int rho) { const int n = rho >> 4, i = rho & 15; return 8 * (i >> 2) + 4 * n + (i & 3); }
struct Unit { int pm, pn, aux; };
__device__ __forceinline__ unsigned cvt_pk_bf16(float lo, float hi) { unsigned r; asm volatile("v_cvt_pk_bf16_f32 %0, %1, %2" : "=v"(r) : "v"(lo), "v"(hi)); return r; }
__device__ __forceinline__ u32x4 pack8(const f32x4& a, const f32x4& b) { u32x4 w; w.x = cvt_pk_bf16(a[0], a[1]); w.y = cvt_pk_bf16(a[2], a[3]); w.z = cvt_pk_bf16(b[0], b[1]); w.w = cvt_pk_bf16(b[2], b[3]); return w; }

struct Order2D {
    int nM, nN, nwg, G, c;
    __device__ __forceinline__ void init(int nM_, int nN_, int G_, int c_) { nM = nM_; nN = nN_; nwg = nM * nN; G = G_; c = c_; }
    __device__ __forceinline__ bool next(int i, Unit& u) const {
        const long L = (long)i * G + c; if (L >= nwg) return false;
        int wgid = (int)L; { const int q = nwg / NXCD, r = nwg % NXCD, xcd = wgid % NXCD, off = wgid / NXCD; wgid = (xcd < r ? xcd * (q + 1) : r * (q + 1) + (xcd - r) * q) + off; }
        const int nig = WGM * nN, gid = wgid / nig, fm = gid * WGM, gsz = (nM - fm) < WGM ? (nM - fm) : WGM;
        u.pm = fm + ((wgid % nig) % gsz); u.pn = (wgid % nig) / gsz; u.aux = 0; return true;
    }
};

template <class Prob, bool ALIGN_EPI>
__device__ __forceinline__ void gemm_phase(LAS unsigned char* lds, const Prob& Pb, const int tid) {
    const int wid = __builtin_amdgcn_readfirstlane(tid >> 6), lane = tid & 63, wr = wid >> 2, wc = wid & 3, fr = lane & 15, fq = lane >> 4;
    constexpr bool F8 = Prob::F8;
    const int nt = F8 ? Pb.K / 128 : Pb.K / BK;
    constexpr bool GATHER = Prob::GATHER;
    int Rr[2], Cc[2]; unsigned voffB, voffA = 0u;
    { int R, C; if (F8) stage_rc_f8(tid * 16, R, C); else { stage_rc(tid * 16, R, C); C *= 2; }
      Rr[0] = R; Rr[1] = R + 64; Cc[0] = C; Cc[1] = C; const int Rb = (R & ~31) + perm32(R & 31); voffB = (unsigned)(Rb * Pb.ldbB + C);
      if constexpr (!GATHER) voffA = (unsigned)(R * Pb.ldaB + C); }
    const unsigned r64B = 64u * (unsigned)Pb.ldbB, r64A = GATHER ? 0u : 64u * (unsigned)Pb.ldaB;
    const unsigned kstep = 128u;
    const unsigned hstepB = (unsigned)HALF * Pb.ldbB;
    const unsigned ldsw = (unsigned)wid * 1024u;
    const int aoff = F8 ? (wr * 64 + fr) * 128 + ((fq ^ ((fr >> 1) & 3)) * 32) : lds_byte(wr * 64 + fr, fq * 8);
    const int boff = F8 ? (wc * 32 + fr) * 128 + ((fq ^ ((fr >> 1) & 3)) * 32) : lds_byte(wc * 32 + fr, fq * 8);
    const int aoff8 = aoff + (fq & 1) * 16, boff8 = boff + (fq & 1) * 16;
#define PG8_SA(b, h) (((b) * 2 + (h)) * HTB)
#define PG8_SB(b, h) ((4 + (b) * 2 + (h)) * HTB)
    const __amdgpu_buffer_rsrc_t rsA = __builtin_amdgcn_make_buffer_rsrc((void*)Pb.A, 0, 0x7ffffffe, 0x00020000), rsB = __builtin_amdgcn_make_buffer_rsrc((void*)Pb.Bt, 0, 0x7ffffffe, 0x00020000);
#define PG8_STAGE_B(bufoff, so) do { \
        __builtin_amdgcn_raw_ptr_buffer_load_lds(rsB, (LAS unsigned*)(lds + (bufoff) + ldsw), 16, voffB, (int)(so), 0, 0); \
        __builtin_amdgcn_raw_ptr_buffer_load_lds(rsB, (LAS unsigned*)(lds + (bufoff) + ldsw + 8192), 16, voffB, (int)((so) + r64B), 0, 0); } while (0)
#define PG8_STAGE_A(bufoff, so, h) do { if constexpr (GATHER) { \
        __builtin_amdgcn_raw_ptr_buffer_load_lds(rsA, (LAS unsigned*)(lds + (bufoff) + ldsw), 16, (h) ? ca10 : ca00, (int)(so), 0, 0); \
        __builtin_amdgcn_raw_ptr_buffer_load_lds(rsA, (LAS unsigned*)(lds + (bufoff) + ldsw + 8192), 16, (h) ? ca11 : ca01, (int)(so), 0, 0); } else { \
        __builtin_amdgcn_raw_ptr_buffer_load_lds(rsA, (LAS unsigned*)(lds + (bufoff) + ldsw), 16, voffA, (int)((so) + (h) * 2u * r64A), 0, 0); \
        __builtin_amdgcn_raw_ptr_buffer_load_lds(rsA, (LAS unsigned*)(lds + (bufoff) + ldsw + 8192), 16, voffA, (int)((so) + (h) * 2u * r64A + r64A), 0, 0); } } while (0)
#define PG8_LDA(dst, b, h) do { if constexpr (F8) { _Pragma("unroll") for (int m = 0; m < 4; ++m) { dst[m][0] = *(const LAS bf16x8*)(lds + PG8_SA(b, h) + m * 2048 + aoff8); dst[m][1] = *(const LAS bf16x8*)(lds + PG8_SA(b, h) + m * 2048 + (aoff8 ^ 16)); } } \
        else { _Pragma("unroll") for (int m = 0; m < 4; ++m) _Pragma("unroll") for (int k = 0; k < 2; ++k) dst[m][k] = *(const LAS bf16x8*)(lds + PG8_SA(b, h) + aoff + m * 2048 + k * 1024); } } while (0)
#define PG8_LDB(dst, b, h) do { if constexpr (F8) { _Pragma("unroll") for (int n = 0; n < 2; ++n) { dst[n][0] = *(const LAS bf16x8*)(lds + PG8_SB(b, h) + n * 2048 + boff8); dst[n][1] = *(const LAS bf16x8*)(lds + PG8_SB(b, h) + n * 2048 + (boff8 ^ 16)); } } \
        else { _Pragma("unroll") for (int n = 0; n < 2; ++n) _Pragma("unroll") for (int k = 0; k < 2; ++k) dst[n][k] = *(const LAS bf16x8*)(lds + PG8_SB(b, h) + boff + n * 2048 + k * 1024); } } while (0)
#define PG8_F8FRAG(x) __builtin_shufflevector(__builtin_bit_cast(v4i_t, x[0]), __builtin_bit_cast(v4i_t, x[1]), 0, 1, 2, 3, 4, 5, 6, 7)
#define PG8_MMA(ai, bj, At, Bt) do { __builtin_amdgcn_s_setprio(1); if constexpr (F8) { _Pragma("unroll") for (int m = 0; m < 4; ++m) _Pragma("unroll") for (int n = 0; n < 2; ++n) \
        acc[ai][bj][m][n] = __builtin_amdgcn_mfma_scale_f32_16x16x128_f8f6f4(PG8_F8FRAG(Bt[n]), PG8_F8FRAG(At[m]), acc[ai][bj][m][n], 0, 0, 0, 0, 0, 0); }     \
        else { _Pragma("unroll") for (int m = 0; m < 4; ++m) _Pragma("unroll") for (int n = 0; n < 2; ++n) _Pragma("unroll") for (int k = 0; k < 2; ++k) \
        acc[ai][bj][m][n] = __builtin_amdgcn_mfma_f32_16x16x32_bf16(Bt[n][k], At[m][k], acc[ai][bj][m][n], 0, 0, 0); } __builtin_amdgcn_s_setprio(0); } while (0)
#define PG8_WAIT_V(n) asm volatile("s_waitcnt vmcnt(" #n ")" ::: "memory")
#define PG8_WAIT_L(n) asm volatile("s_waitcnt lgkmcnt(" #n ")" ::: "memory")
#define PG8_BAR __builtin_amdgcn_s_barrier()
#define PG8_SCHED __builtin_amdgcn_sched_barrier(0)
    Unit cur, nxt; int ui = 0;
    if (!Pb.next(0, cur)) return;
    const unsigned ktm = (unsigned)nt - 1u;
    unsigned rc = Pb.rot(cur), rn = 0u;
    f32x4 acc[2][2][4][2];
#pragma unroll
    for (int a = 0; a < 2; ++a)
#pragma unroll
        for (int b = 0; b < 2; ++b)
#pragma unroll
            for (int m = 0; m < 4; ++m)
#pragma unroll
                for (int n = 0; n < 2; ++n) acc[a][b][m][n] = (f32x4){0.f, 0.f, 0.f, 0.f};
    bf16x8 At[4][2], B0[2][2], B1[2][2];
    unsigned ca00 = 0, ca01 = 0, ca10 = 0, ca11 = 0;
    unsigned cA, nA;
    if constexpr (GATHER) { Pb.a_fetch(cur, lds, wid); asm volatile("s_waitcnt vmcnt(0)" ::: "memory"); __builtin_amdgcn_s_barrier(); }
    Pb.e_fetch(cur, lds, wid, 0);
    { unsigned o[2][2]; Pb.a_addr(cur, Rr, Cc, o, cA, lds); ca00 = o[0][0]; ca01 = o[0][1]; ca10 = o[1][0]; ca11 = o[1][1]; }
    unsigned cB = Pb.b_base(cur);
    { const unsigned k0 = (rc & ktm) * kstep;
    PG8_STAGE_B(PG8_SB(0, 0), cB + k0); PG8_STAGE_B(PG8_SB(0, 1), cB + k0 + hstepB); PG8_STAGE_A(PG8_SA(0, 0), cA + k0, 0); PG8_STAGE_A(PG8_SA(0, 1), cA + k0, 1);
    if (wr == 1) PG8_BAR;
    PG8_WAIT_V(2); PG8_BAR;
    PG8_STAGE_B(PG8_SB(1, 0), cB + k0 + kstep); PG8_STAGE_A(PG8_SA(1, 0), cA + k0 + kstep, 0); PG8_STAGE_B(PG8_SB(1, 1), cB + k0 + hstepB + kstep); }
    PG8_WAIT_V(6); PG8_BAR;
    for (;;) {
        const bool has_next = Pb.next(ui + 1, nxt);
        unsigned nB;
        if (has_next) { if constexpr (GATHER) Pb.a_fetch(nxt, lds, wid); else { unsigned o[2][2]; Pb.a_addr(nxt, Rr, Cc, o, nA, lds); } nB = Pb.b_base(nxt); rn = Pb.rot(nxt); }
        else { nA = cA; nB = cB; rn = rc; }
        for (int t = 0; t < nt; t += 2) {
            const bool last = (t == nt - 2);
            const unsigned a1 = cA + (((unsigned)(t + 1) + rc) & ktm) * kstep;
            PG8_LDB(B0, 0, 0); PG8_LDB(B1, 0, 1); PG8_SCHED; PG8_LDA(At, 0, 0); PG8_STAGE_A(PG8_SA(1, 1), a1, 1);
            PG8_WAIT_V(8); PG8_WAIT_L(0); PG8_BAR; PG8_MMA(0, 0, At, B0); PG8_MMA(0, 1, At, B1); PG8_BAR; PG8_SCHED;
            const unsigned k2 = last ? (rn & ktm) * kstep : (((unsigned)(t + 2) + rc) & ktm) * kstep;
            const unsigned a2 = (last ? nA : cA) + k2, b2 = (last ? nB : cB) + k2;
            const unsigned a3 = a2 + kstep, b3 = b2 + kstep;
            if constexpr (GATHER) { if (last && has_next) { unsigned o[2][2]; Pb.a_addr(nxt, Rr, Cc, o, nA, lds); ca00 = o[0][0]; ca01 = o[0][1]; ca10 = o[1][0]; ca11 = o[1][1]; } }
            PG8_LDA(At, 0, 1); PG8_STAGE_B(PG8_SB(0, 0), b2); PG8_STAGE_B(PG8_SB(0, 1), b2 + hstepB); PG8_STAGE_A(PG8_SA(0, 0), a2, 0);
            PG8_WAIT_V(8); PG8_WAIT_L(0); PG8_BAR; PG8_MMA(1, 0, At, B0); PG8_MMA(1, 1, At, B1); PG8_BAR; PG8_SCHED;
            PG8_LDB(B0, 1, 0); PG8_LDB(B1, 1, 1); PG8_SCHED; PG8_LDA(At, 1, 0); PG8_STAGE_A(PG8_SA(0, 1), a2, 1);
            PG8_WAIT_V(8); PG8_WAIT_L(0); PG8_BAR; PG8_MMA(0, 0, At, B0); PG8_MMA(0, 1, At, B1); PG8_BAR; PG8_SCHED;
            PG8_LDA(At, 1, 1); PG8_STAGE_B(PG8_SB(1, 0), b3); PG8_STAGE_B(PG8_SB(1, 1), b3 + hstepB); PG8_STAGE_A(PG8_SA(1, 0), a3, 0);
            PG8_WAIT_V(8); PG8_WAIT_L(0); PG8_BAR; PG8_MMA(1, 0, At, B0); PG8_MMA(1, 1, At, B1); PG8_BAR; PG8_SCHED;
        }
        if constexpr (ALIGN_EPI) { if (wr == 0) PG8_BAR; }
        { int tl = tid; asm volatile("" : "+v"(tl));
          const int ln = tl & 63; Pb.epi(acc, cur, wr, wc, ln & 15, ln >> 4, lds + (ui & 1) * 3072); }
        if (!has_next) break;
#pragma unroll
        for (int a = 0; a < 2; ++a)
#pragma unroll
            for (int b = 0; b < 2; ++b)
#pragma unroll
                for (int m = 0; m < 4; ++m)
#pragma unroll
                    for (int n = 0; n < 2; ++n) acc[a][b][m][n] = (f32x4){0.f, 0.f, 0.f, 0.f};
        _Pragma("unroll") for (int a = 0; a < 2; ++a) _Pragma("unroll") for (int b = 0; b < 2; ++b) _Pragma("unroll") for (int m = 0; m < 4; ++m) asm volatile("" : "+v"(acc[a][b][m][0]), "+v"(acc[a][b][m][1]));
        cur = nxt; cA = nA; cB = nB; rc = rn; ++ui;
        Pb.e_fetch(cur, lds, wid, ui & 1);
        if constexpr (ALIGN_EPI) { if (wr == 1) PG8_BAR; }
    }
    PG8_WAIT_V(0);
    if constexpr (!ALIGN_EPI) { if (wr == 0) PG8_BAR; }
    PG8_BAR;
#undef PG8_SA
#undef PG8_SB
#undef PG8_STAGE_A
#undef PG8_STAGE_B
#undef PG8_LDA
#undef PG8_LDB
#undef PG8_MMA
#undef PG8_F8FRAG
#undef PG8_WAIT_V
#undef PG8_WAIT_L
#undef PG8_BAR
#undef PG8_SCHED
}
}
namespace pg8 {
#define PG8_EPI_LOOP for (int ai = 0; ai < 2; ++ai) _Pragma("unroll") for (int m = 0; m < 4; ++m) _Pragma("unroll") for (int bj = 0; bj < 2; ++bj)
__device__ __forceinline__ void rope4(const float* rope, int pos, int i0, f32x4& a, f32x4& b) {
    const f32x4 c = *(const f32x4*)(rope + pos * 32 + i0), s = *(const f32x4*)(rope + LSEQ * 32 + pos * 32 + i0);
    const f32x4 r0 = {a[0] * c[0] - a[1] * s[0], a[1] * c[0] + a[0] * s[0], a[2] * c[1] - a[3] * s[1], a[3] * c[1] + a[2] * s[1]};
    const f32x4 r1 = {b[0] * c[2] - b[1] * s[2], b[1] * c[2] + b[0] * s[2], b[2] * c[3] - b[3] * s[3], b[3] * c[3] + b[2] * s[3]};
    a = r0; b = r1;
}
__device__ __forceinline__ float clamp448(float v) { return __builtin_amdgcn_fmed3f(v, -448.0f, 448.0f); }
__device__ __forceinline__ unsigned pack4_f8(float a, float b, float c, float d) { int w = 0; w = __builtin_amdgcn_cvt_pk_fp8_f32(clamp448(a), clamp448(b), w, false); w = __builtin_amdgcn_cvt_pk_fp8_f32(clamp448(c), clamp448(d), w, true); return (unsigned)w; }
__device__ __forceinline__ unsigned long long pack8_f8(const f32x4& a, const f32x4& b) { return (unsigned long long)pack4_f8(a[0], a[1], a[2], a[3]) | ((unsigned long long)pack4_f8(b[0], b[1], b[2], b[3]) << 32); }
struct DenseBase {
    static constexpr bool F8 = false, GATHER = false; static constexpr int scaleA = 0, scaleB = 0;
    const char* A; const char* Bt; int K, lda, ldb, ldaB, ldbB; Order2D ord;
    __device__ __forceinline__ bool next(int i, Unit& u) const { return ord.next(i, u); }
    __device__ __forceinline__ unsigned rot(const Unit&) const { return 0u; }
    __device__ __forceinline__ void e_fetch(const Unit&, LAS unsigned char*, int, int) const {}
    __device__ __forceinline__ void a_addr(const Unit& u, const int (&Rr)[2], const int (&Cc)[2], unsigned (&o)[2][2], unsigned& base, LAS unsigned char*) const {
        base = (unsigned)u.pm * 256u * (unsigned)lda * 2u;
#pragma unroll
        for (int h = 0; h < 2; ++h)
#pragma unroll
            for (int i = 0; i < 2; ++i) o[h][i] = (unsigned)((h * 128 + Rr[i]) * lda * 2 + Cc[i]);
    }
    __device__ __forceinline__ unsigned b_base(const Unit& u) const { return (unsigned)u.pn * 256u * (unsigned)ldb * 2u; }
};
struct ProbP1 : DenseBase {
    bf16_t* proj; bf16_t* kr; const float* rope; float* ssqp;
    __device__ __forceinline__ void epi(const f32x4 (&acc)[2][2][4][2], const Unit& u, int wr, int wc, int fr, int fq, LAS unsigned char*) const {
        float ssq_acc[2][4];
#pragma unroll
        for (int a = 0; a < 2; ++a)
#pragma unroll
            for (int b = 0; b < 4; ++b) ssq_acc[a][b] = 0.f;
#pragma unroll
        PG8_EPI_LOOP {
            const int row = u.pm * 256 + ai * 128 + wr * 64 + m * 16 + fr, col = u.pn * 256 + bj * 128 + wc * 32 + fq * 8;
            f32x4 v0 = acc[ai][bj][m][0], v1 = acc[ai][bj][m][1];
            if (u.pn >= 4 && u.pn < 7) { const float q = (v0[0] * v0[0] + v0[1] * v0[1]) + (v0[2] * v0[2] + v0[3] * v0[3]) + (v1[0] * v1[0] + v1[1] * v1[1]) + (v1[2] * v1[2] + v1[3] * v1[3]);
                ssq_acc[ai][m] += q; }
            if (col < 1792) { *(u32x4*)(proj + (size_t)row * DM + col) = pack8(v0, v1); }
            else if (col < INW) { const int pos = (row % LP) - PADR;
                if (pos >= 0) rope4(rope, pos, (col - 1792) >> 1, v0, v1); else { v0 = (f32x4){0.f, 0.f, 0.f, 0.f}; v1 = v0; }
                *(u32x4*)(kr + (size_t)row * 64 + (col - 1792)) = pack8(v0, v1); }
        }
        if (u.pn >= 4 && u.pn < 7) {
            const int slot = u.pn < 6 ? (u.pn - 4) * 4 + wc : 8 + wc;
#pragma unroll
            for (int ai = 0; ai < 2; ++ai)
#pragma unroll
                for (int m = 0; m < 4; ++m) { float q = ssq_acc[ai][m]; q += __shfl_xor(q, 16); q += __shfl_xor(q, 32);
                    if (fq == 0) ssqp[(size_t)(u.pm * 256 + ai * 128 + wr * 64 + m * 16 + fr) * 12 + slot] = q; }
        }
    }
};
struct ProbP2q : DenseBase {
    bf16_t* qb; const float* rsq; const float* rope;
    __device__ __forceinline__ void epi(const f32x4 (&acc)[2][2][4][2], const Unit& u, int wr, int wc, int fr, int fq, LAS unsigned char*) const {
        float rsv[2][4];
#pragma unroll
        for (int ai = 0; ai < 2; ++ai)
#pragma unroll
            for (int m = 0; m < 4; ++m) { const float* pp = rsq + (size_t)(u.pm * 256 + ai * 128 + wr * 64 + m * 16 + fr) * 12; const f32x4 a = *(const f32x4*)pp, b = *(const f32x4*)(pp + 4);
                rsv[ai][m] = C2 / sqrtf(((a[0] + a[1]) + (a[2] + a[3]) + (b[0] + b[1]) + (b[2] + b[3])) * (1.0f / QLORA) + EPS); }
#pragma unroll
        PG8_EPI_LOOP {
            const int row = u.pm * 256 + ai * 128 + wr * 64 + m * 16 + fr, col = u.pn * 256 + bj * 128 + wc * 32 + fq * 8;
            const float s = rsv[ai][m]; f32x4 v0 = acc[ai][bj][m][0] * s, v1 = acc[ai][bj][m][1] * s;
            const int dd = col % QKD;
            if (dd >= QKNOPE) { const int pos = (row % LP) - PADR; if (pos >= 0) rope4(rope, pos, (dd - QKNOPE) >> 1, v0, v1); else { v0 = (f32x4){0.f, 0.f, 0.f, 0.f}; v1 = v0; } }
            *(u32x4*)(qb + (size_t)row * 1536 + col) = pack8(v0, v1);
        }
    }
};
struct ProbP2kv : DenseBase {
    bf16_t* kn; bf16_t* vb; const float* rskv;
    __device__ __forceinline__ void epi(const f32x4 (&acc)[2][2][4][2], const Unit& u, int wr, int wc, int fr, int fq, LAS unsigned char*) const {
#pragma unroll
        PG8_EPI_LOOP {
            const int row = u.pm * 256 + ai * 128 + wr * 64 + m * 16 + fr, c = wc * 32 + fq * 8;
            const f32x4 pk = *(const f32x4*)(rskv + (size_t)row * 12 + 8); const float s = 1.0f / sqrtf(((pk[0] + pk[1]) + (pk[2] + pk[3])) * (1.0f / KVLORA) + EPS); const f32x4 v0 = acc[ai][bj][m][0] * s, v1 = acc[ai][bj][m][1] * s;
            bf16_t* dst = (bj == 0 ? kn : vb) + (size_t)row * 1024 + u.pn * 128 + c;
            *(u32x4*)dst = pack8(v0, v1);
        }
    }
};
struct ProbPool : DenseBase {
    bf16_t* mix; const float* pscale;
    __device__ __forceinline__ void a_addr(const Unit& u, const int (&Rr)[2], const int (&Cc)[2], unsigned (&o)[2][2], unsigned& base, LAS unsigned char*) const {
        base = ((unsigned)u.pm * 256u * (unsigned)lda + (unsigned)u.pn * 256u) * 2u;
#pragma unroll
        for (int h = 0; h < 2; ++h)
#pragma unroll
            for (int i = 0; i < 2; ++i) o[h][i] = (unsigned)((h * 128 + Rr[i]) * lda * 2 + Cc[i]);
    }
    __device__ __forceinline__ unsigned b_base(const Unit& u) const { return (unsigned)u.pn * 65536u * 2u; }
    __device__ __forceinline__ void epi(const f32x4 (&acc)[2][2][4][2], const Unit& u, int wr, int wc, int fr, int fq, LAS unsigned char*) const {
#pragma unroll
        PG8_EPI_LOOP {
            const int row = u.pm * 256 + ai * 128 + wr * 64 + m * 16 + fr, c = u.pn * 256 + bj * 128 + wc * 32 + fq * 8;
            const f32x4 p0 = *(const f32x4*)(pscale + c), p1 = *(const f32x4*)(pscale + c + 4);
            *(u32x4*)(mix + (size_t)row * DM + c) = pack8(acc[ai][bj][m][0] * p0, acc[ai][bj][m][1] * p1);
        }
    }
};
struct ProbP4 : DenseBase {
    const float* x; bf16_t* h2; unsigned char* h2f8;
    __device__ __forceinline__ void a_addr(const Unit& u, const int (&Rr)[2], const int (&Cc)[2], unsigned (&o)[2][2], unsigned& base, LAS unsigned char*) const {
        base = (unsigned)((u.pm >> 3) * LP + 64 + (u.pm & 7) * 256) * (unsigned)lda * 2u;
#pragma unroll
        for (int h = 0; h < 2; ++h)
#pragma unroll
            for (int i = 0; i < 2; ++i) o[h][i] = (unsigned)((h * 128 + Rr[i]) * lda * 2 + Cc[i]);
    }
    __device__ __forceinline__ void epi(const f32x4 (&acc)[2][2][4][2], const Unit& u, int wr, int wc, int fr, int fq, LAS unsigned char*) const {
#pragma unroll
        PG8_EPI_LOOP {
            const int r = u.pm * 256 + ai * 128 + wr * 64 + m * 16 + fr, c = u.pn * 256 + bj * 128 + wc * 32 + fq * 8;
            const size_t off = (size_t)r * DM + c;
            const f32x4 o0 = *(const f32x4*)(x + off) + acc[ai][bj][m][0], o1 = *(const f32x4*)(x + off + 4) + acc[ai][bj][m][1];
            *(u32x4*)(h2 + off) = pack8(o0, o1); *(unsigned long long*)(h2f8 + off) = pack8_f8(o0, o1);
        }
    }
};
}
namespace pg8 {
constexpr int TB_CNT = 64, TB_TE = 128, TB_TM = 416, TB_LIST = 768, TB_E0 = 1024, TB_E1 = 1280, TB_E2 = 1536;
__device__ __forceinline__ void moe_table(LAS unsigned char* lds, const unsigned* cnt, const int tid) {
    LAS int* tab = (LAS int*)(lds + TAB_OFF);
    __syncthreads();
    if (tid < NE) tab[TB_CNT + tid] = (int)__hip_atomic_load(cnt + tid, RLX_AGENT);
    __syncthreads();
    if (tid == 0) { int s = 0; for (int e = 0; e < NE; ++e) { tab[e] = s; s += (tab[TB_CNT + e] + 255) >> 8; } tab[NE] = s; }
    __syncthreads();
    if (tid < 288) { int e = 0; for (; e < NE - 1; ++e) if (tid < tab[e + 1]) break; tab[TB_TE + tid] = e; tab[TB_TM + tid] = tid - tab[e]; }
    __syncthreads();
}
#ifndef MOE_BT
#define MOE_BT 8
#endif
template <int NTN> struct MoeOrder {
    const LAS int* tab; int G, c, i0, i1;
    __device__ __forceinline__ bool next(int i_, Unit& u) const {
        const int i = i0 + i_; if (i >= i1) return false;
        const int cpx = G >> 3; const int F = (G & 7) ? i * G + c : (i * 8 + (c & 7)) * cpx + (c >> 3);
        const int ntile = __builtin_amdgcn_readfirstlane(tab[NE]); if (F >= ntile * NTN) return false;
        constexpr int BT = MOE_BT, PG = 32 / BT;
        const int blk = F / (BT * NTN), r = F - blk * (BT * NTN), nb = (ntile - blk * BT) < BT ? (ntile - blk * BT) : BT;
        int png, rr; if (nb == BT) { png = r / 32; rr = r & 31; } else { const int gs = nb * PG; png = r / gs; rr = r - png * gs; }
        const int T = blk * BT + rr / PG;
        u.aux = __builtin_amdgcn_readfirstlane(tab[TB_TE + T]); u.pm = __builtin_amdgcn_readfirstlane(tab[TB_TM + T]); u.pn = png * PG + (rr % PG); return true;
    }
};
constexpr int W_SCALE_LOG2 = 5, ACT_SCALE_LOG2 = 2, YB_SCALE_LOG2 = 4;
struct ProbP6 {
    static constexpr bool F8 = true, GATHER = true; static constexpr int ldaB = DM; static constexpr int scaleB = 0x01010101 * (127 - W_SCALE_LOG2), scaleA = 0x7f7f7f7f;
    const char* A; const char* Bt; int K, ldbB; MoeOrder<16> ord;
    const int* list; const float* rsl; const float* b1; unsigned char* act;
    __device__ __forceinline__ bool next(int i, Unit& u) const { return ord.next(i, u); }
    __device__ __forceinline__ unsigned rot(const Unit& u) const { return 0u; }
    __device__ __forceinline__ void a_fetch(const Unit& u, LAS unsigned char* lds, int wid) const {
        if (wid == 0) { const __amdgpu_buffer_rsrc_t rl = __builtin_amdgcn_make_buffer_rsrc((void*)list, 0, 0x7ffffffe, 0x00020000);
            __builtin_amdgcn_raw_ptr_buffer_load_lds(rl, (LAS unsigned*)(lds + TAB_OFF + TB_LIST * 4), 16, (threadIdx.x & 63) * 16, (int)(((unsigned)u.aux * (unsigned)MR + (unsigned)u.pm * 256u) * 4u), 0, 0); }
    }
    __device__ __forceinline__ void a_addr(const Unit& u, const int (&Rr)[2], const int (&Cc)[2], unsigned (&o)[2][2], unsigned& base, LAS unsigned char* lds) const {
        base = 0u; const int cnt_e = __builtin_amdgcn_readfirstlane(ord.tab[TB_CNT + u.aux]); const LAS int* lb = (const LAS int*)(lds + TAB_OFF) + TB_LIST; const int lastv = cnt_e - 1 - u.pm * 256;
#pragma unroll
        for (int h = 0; h < 2; ++h)
#pragma unroll
            for (int i = 0; i < 2; ++i) { int sl = h * 128 + Rr[i]; sl = sl < lastv ? sl : lastv; const int tok = lb[sl] >> 2; o[h][i] = (unsigned)tok * (unsigned)DM + (unsigned)Cc[i]; }
    }
    __device__ __forceinline__ void e_fetch(const Unit& u, LAS unsigned char* lds, int wid, int par) const {
        lds += par * 3072;
        if (wid == 1) { const __amdgpu_buffer_rsrc_t r = __builtin_amdgcn_make_buffer_rsrc((void*)rsl, 0, 0x7ffffffe, 0x00020000);
            __builtin_amdgcn_raw_ptr_buffer_load_lds(r, (LAS unsigned*)(lds + TAB_OFF + TB_E0 * 4), 16, (threadIdx.x & 63) * 16, (int)(((unsigned)u.aux * (unsigned)MR + (unsigned)u.pm * 256u) * 4u), 0, 0); }
        if (wid == 2) { const __amdgpu_buffer_rsrc_t r = __builtin_amdgcn_make_buffer_rsrc((void*)b1, 0, 0x7ffffffe, 0x00020000);
            __builtin_amdgcn_raw_ptr_buffer_load_lds(r, (LAS unsigned*)(lds + TAB_OFF + TB_E1 * 4), 16, (threadIdx.x & 63) * 16, (int)(((unsigned)u.aux * 4096u + (unsigned)u.pn * 256u) * 4u), 0, 0); }
    }
    __device__ __forceinline__ unsigned b_base(const Unit& u) const { return ((unsigned)u.aux * 4096u + (unsigned)u.pn * 256u) * (unsigned)DM; }
    __device__ __forceinline__ void epi(const f32x4 (&acc)[2][2][4][2], const Unit& u, int wr, int wc, int fr, int fq, LAS unsigned char* lds) const {
        const LAS float* rsb = (const LAS float*)(lds + TAB_OFF) + TB_E0; const LAS float* bb1 = (const LAS float*)(lds + TAB_OFF) + TB_E1;
        typedef float f32x2 __attribute__((ext_vector_type(2)));
        const int cnt_e = __builtin_amdgcn_readfirstlane(ord.tab[TB_CNT + u.aux]), rbase = __builtin_amdgcn_readfirstlane(ord.tab[u.aux]) * 256;
        f32x4 bg[2], bl[2];
#pragma unroll
        for (int bj = 0; bj < 2; ++bj) { const LAS float* bp = bb1 + bj * 128 + wc * 32 + fq * 8; const f32x4 x0 = *(const LAS f32x4*)bp, x1 = *(const LAS f32x4*)(bp + 4);
            bg[bj] = (f32x4){x0[0], x0[2], x1[0], x1[2]}; bl[bj] = (f32x4){x0[1], x0[3], x1[1], x1[3]}; }
        constexpr float AS = (float)(1 << ACT_SCALE_LOG2), NC = -1.702f * 1.4426950408889634f;
#pragma unroll
        for (int ai = 0; ai < 2; ++ai)
#pragma unroll
            for (int m = 0; m < 4; ++m) {
                const int slot = u.pm * 256 + ai * 128 + wr * 64 + m * 16 + fr; const bool valid = slot < cnt_e;
                const float rs = valid ? rsb[ai * 128 + wr * 64 + m * 16 + fr] * (1.0f / (float)(1 << W_SCALE_LOG2)) : 0.f;
#pragma unroll
                for (int bj = 0; bj < 2; ++bj) {
                    const f32x4 a0 = acc[ai][bj][m][0], a1 = acc[ai][bj][m][1];
                    f32x4 g = (f32x4){a0[0], a0[2], a1[0], a1[2]} * rs + bg[bj], l = (f32x4){a0[1], a0[3], a1[1], a1[3]} * rs + bl[bj];
#pragma unroll
                    for (int q = 0; q < 4; ++q) { g[q] = fminf(g[q], 7.0f); l[q] = __builtin_amdgcn_fmed3f(l[q], -7.0f, 7.0f); }
                    f32x4 e = g * NC, lp = l * AS + AS;
#pragma unroll
                    for (int q = 0; q < 4; ++q) e[q] = __builtin_amdgcn_rcpf(1.0f + __builtin_amdgcn_exp2f(e[q]));
                    const f32x4 o = (g * e) * lp;
                    if (valid) { int w = 0; w = __builtin_amdgcn_cvt_pk_fp8_f32(o[0], o[1], w, false); w = __builtin_amdgcn_cvt_pk_fp8_f32(o[2], o[3], w, true);
                        *(unsigned*)(act + (size_t)(rbase + slot) * DFF + u.pn * 128 + bj * 64 + wc * 16 + fq * 4) = (unsigned)w; }
                }
            }
    }
};
struct ProbP7 {
    static constexpr bool F8 = true, GATHER = false; static constexpr int ldaB = DFF; static constexpr int scaleB = 0x01010101 * (127 - W_SCALE_LOG2), scaleA = 0x01010101 * (127 - ACT_SCALE_LOG2);
    const char* A; const char* Bt; int K, ldbB; MoeOrder<8> ord;
    const int* list; const float* gate; const float* b2; unsigned char* yb;
    __device__ __forceinline__ bool next(int i, Unit& u) const { return ord.next(i, u); }
    __device__ __forceinline__ unsigned rot(const Unit& u) const { return 0u; }
    __device__ __forceinline__ void a_addr(const Unit& u, const int (&Rr)[2], const int (&Cc)[2], unsigned (&o)[2][2], unsigned& base, LAS unsigned char*) const {
        base = (unsigned)(__builtin_amdgcn_readfirstlane(ord.tab[u.aux]) + u.pm) * 256u * (unsigned)DFF;
#pragma unroll
        for (int h = 0; h < 2; ++h)
#pragma unroll
            for (int i = 0; i < 2; ++i) o[h][i] = (unsigned)((h * 128 + Rr[i]) * DFF + Cc[i]);
    }
    __device__ __forceinline__ void e_fetch(const Unit& u, LAS unsigned char* lds, int wid, int par) const {
        lds += par * 3072;
        const int so = (int)(((unsigned)u.aux * (unsigned)MR + (unsigned)u.pm * 256u) * 4u);
        if (wid == 1) { const __amdgpu_buffer_rsrc_t r = __builtin_amdgcn_make_buffer_rsrc((void*)gate, 0, 0x7ffffffe, 0x00020000);
            __builtin_amdgcn_raw_ptr_buffer_load_lds(r, (LAS unsigned*)(lds + TAB_OFF + TB_E0 * 4), 16, (threadIdx.x & 63) * 16, so, 0, 0); }
        if (wid == 2) { const __amdgpu_buffer_rsrc_t r = __builtin_amdgcn_make_buffer_rsrc((void*)b2, 0, 0x7ffffffe, 0x00020000);
            __builtin_amdgcn_raw_ptr_buffer_load_lds(r, (LAS unsigned*)(lds + TAB_OFF + TB_E1 * 4), 16, (threadIdx.x & 63) * 16, (int)(((unsigned)u.aux * (unsigned)DM + (unsigned)u.pn * 256u) * 4u), 0, 0); }
        if (wid == 3) { const __amdgpu_buffer_rsrc_t r = __builtin_amdgcn_make_buffer_rsrc((void*)list, 0, 0x7ffffffe, 0x00020000);
            __builtin_amdgcn_raw_ptr_buffer_load_lds(r, (LAS unsigned*)(lds + TAB_OFF + TB_E2 * 4), 16, (threadIdx.x & 63) * 16, so, 0, 0); }
    }
    __device__ __forceinline__ unsigned b_base(const Unit& u) const { return ((unsigned)u.aux * (unsigned)DM + (unsigned)u.pn * 256u) * (unsigned)DFF; }
    __device__ __forceinline__ void epi(const f32x4 (&acc)[2][2][4][2], const Unit& u, int wr, int wc, int fr, int fq, LAS unsigned char* lds) const {
        const int cnt_e = __builtin_amdgcn_readfirstlane(ord.tab[TB_CNT + u.aux]);
        const LAS float* gtb = (const LAS float*)(lds + TAB_OFF) + TB_E0; const LAS float* bb2 = (const LAS float*)(lds + TAB_OFF) + TB_E1; const LAS int* idb = (const LAS int*)(lds + TAB_OFF) + TB_E2;
        const int col = u.pn * 256 + wc * 32 + fq * 8;
        f32x4 bb[2][2];
#pragma unroll
        for (int bj = 0; bj < 2; ++bj) { const LAS float* bp = bb2 + bj * 128 + wc * 32 + fq * 8; bb[bj][0] = *(const LAS f32x4*)bp; bb[bj][1] = *(const LAS f32x4*)(bp + 4); }
#pragma unroll
        for (int ai = 0; ai < 2; ++ai)
#pragma unroll
            for (int m = 0; m < 4; ++m) {
                const int rl = ai * 128 + wr * 64 + m * 16 + fr, slot = u.pm * 256 + rl; const bool valid = slot < cnt_e;
                const int id = valid ? idb[rl] : 0; const float g = valid ? gtb[rl] : 0.f, gs = g * (1.0f / (float)(1 << (W_SCALE_LOG2 + ACT_SCALE_LOG2)));
                unsigned char* orow = yb + (size_t)id * DM + col;
#pragma unroll
                for (int bj = 0; bj < 2; ++bj) {
                    const f32x4 y0 = (acc[ai][bj][m][0] * gs + bb[bj][0] * g) * (float)(1 << YB_SCALE_LOG2), y1 = (acc[ai][bj][m][1] * gs + bb[bj][1] * g) * (float)(1 << YB_SCALE_LOG2);
                    if (valid) *(unsigned long long*)(orow + bj * 128) = pack8_f8(y0, y1);
                }
            }
    }
};
}
namespace att {
using f32x16 = __attribute__((ext_vector_type(16))) float;
using s16x4 = __attribute__((ext_vector_type(4))) short;
constexpr int SHM_V = 16384, SHM_KN = 16384, SHM_KR = 8192, SHM_BUF = SHM_V + SHM_KN + SHM_KR, NBUF = 3, WS_OFF = NBUF * SHM_BUF;
#define ATT_SBAR() __builtin_amdgcn_sched_barrier(0)
__device__ __forceinline__ int crow(int r, int hi) { return (r & 3) + 8 * (r >> 2) + 4 * hi; }
__device__ __forceinline__ unsigned cvtpk(float lo, float hi) { unsigned r; asm volatile("v_cvt_pk_bf16_f32 %0, %1, %2" : "=v"(r) : "v"(lo), "v"(hi)); return r; }
__device__ __forceinline__ int v_st(int k, int c) { const int kk = (k & ~0xC) | ((k & 4) << 1) | ((k & 8) >> 1); return ((kk >> 3) * 4 + (c >> 5)) * 512 + ((kk & 7) * 32 + (c & 31)) * 2; }
__device__ __forceinline__ int v_rd_base(int lane) { return ((lane & 3) << 3) | (((lane >> 2) & 3) << 6) | (((lane >> 4) & 1) << 5) | (((lane >> 5) & 1) << 8); }
constexpr int v_rd_off(int d0, int ks, int half) { return d0 * 512 + ks * 4096 + half * 2048; }
template <int OFF> __device__ __forceinline__ s16x4 tr_read(int vb) { s16x4 r; asm volatile("ds_read_b64_tr_b16 %0, %1 offset:%2" : "=&v"(r) : "v"(vb), "i"(OFF) : "memory"); return r; }
template <int D0> __device__ __forceinline__ void pv_one(f32x16& od, int vb, bf16x8 pa0, bf16x8 pa1, bf16x8 pa2, bf16x8 pa3) {
    const s16x4 l0 = tr_read<v_rd_off(D0, 0, 0)>(vb), h0 = tr_read<v_rd_off(D0, 0, 1)>(vb), l1 = tr_read<v_rd_off(D0, 1, 0)>(vb), h1 = tr_read<v_rd_off(D0, 1, 1)>(vb);
    const s16x4 l2 = tr_read<v_rd_off(D0, 2, 0)>(vb), h2 = tr_read<v_rd_off(D0, 2, 1)>(vb), l3 = tr_read<v_rd_off(D0, 3, 0)>(vb), h3 = tr_read<v_rd_off(D0, 3, 1)>(vb);
    asm volatile("s_waitcnt lgkmcnt(0)" ::: "memory"); ATT_SBAR();
#define ATT_PK(L, H) (bf16x8){L[0], L[1], L[2], L[3], H[0], H[1], H[2], H[3]}
    od = __builtin_amdgcn_mfma_f32_32x32x16_bf16(pa0, ATT_PK(l0, h0), od, 0, 0, 0);
    od = __builtin_amdgcn_mfma_f32_32x32x16_bf16(pa1, ATT_PK(l1, h1), od, 0, 0, 0);
    od = __builtin_amdgcn_mfma_f32_32x32x16_bf16(pa2, ATT_PK(l2, h2), od, 0, 0, 0);
    od = __builtin_amdgcn_mfma_f32_32x32x16_bf16(pa3, ATT_PK(l3, h3), od, 0, 0, 0);
#undef ATT_PK
}
template <int D0, int HK> __device__ __forceinline__ void pv_half(f32x16& od, int vb, bf16x8 pa0, bf16x8 pa1) {
    const s16x4 l0 = tr_read<v_rd_off(D0, 2 * HK, 0)>(vb), h0 = tr_read<v_rd_off(D0, 2 * HK, 1)>(vb), l1 = tr_read<v_rd_off(D0, 2 * HK + 1, 0)>(vb), h1 = tr_read<v_rd_off(D0, 2 * HK + 1, 1)>(vb);
    asm volatile("s_waitcnt lgkmcnt(0)" ::: "memory"); ATT_SBAR();
#define ATT_PK(L, H) (bf16x8){L[0], L[1], L[2], L[3], H[0], H[1], H[2], H[3]}
    od = __builtin_amdgcn_mfma_f32_32x32x16_bf16(pa0, ATT_PK(l0, h0), od, 0, 0, 0);
    od = __builtin_amdgcn_mfma_f32_32x32x16_bf16(pa1, ATT_PK(l1, h1), od, 0, 0, 0);
#undef ATT_PK
}
__device__ __forceinline__ void attn_unit(int b, int h, int u, const bf16_t* __restrict__ QB, const bf16_t* __restrict__ KN, const bf16_t* __restrict__ KR, const bf16_t* __restrict__ VB,
                                          bf16_t* __restrict__ MIX, LAS char* lds, const int tid) {
    const int wid = tid >> 6, lane = tid & 63, r32 = lane & 31, hi = lane >> 5;
    const int qc = (0x22331100u >> (4 * wid)) & 3, half = wid & 1;
    const int c0 = 4 * u - 3, ntw = c0 + qc + 1, ntmax = 4 * u + 1;
    const size_t rowb = (size_t)b * LP;
    const int qrow0 = 64 * (c0 + qc) + 32 * half;
    LAS float* wsf = (LAS float*)(lds + WS_OFF) + wid * 64; LAS float* li_l = wsf; LAS float* al_l = wsf + 32;
    bf16x8 qr[12];
    { const bf16_t* Qw = QB + (rowb + qrow0 + r32) * 1536 + h * QKD + hi * 8;
#pragma unroll
      for (int d0 = 0; d0 < 12; ++d0) qr[d0] = *(const bf16x8*)(Qw + d0 * 16); }
    unsigned gk0, gv0, gr;
    { const int w = wid;
      { const int row = 32 * (w & 1) + (lane >> 1), hh = (lane & 1) ^ ((row >> 3) & 1);
        gk0 = (unsigned)(row * 1024 + h * 128 + (w >> 1) * 16 + hh * 8); gr = (unsigned)(row * 64 + (w >> 1) * 16 + hh * 8); }
      { const int st = 4 * w + (lane >> 5), kk = (st >> 2) * 8 + ((lane >> 2) & 7), k = (kk & ~0xC) | ((kk & 4) << 1) | ((kk & 8) >> 1), c = (st & 3) * 32 + (lane & 3) * 8; gv0 = (unsigned)(k * 1024 + h * 128 + c); } }
    const bf16_t* KNb = KN + rowb * 1024; const bf16_t* VBb = VB + rowb * 1024; const bf16_t* KRb = KR + rowb * 64;
    const unsigned wq = (unsigned)wid * 2048u, wk = (unsigned)wid * 1024u;
    const int kb0 = (int)(uintptr_t)lds + SHM_V + r32 * 32 + ((hi ^ ((r32 >> 3) & 1)) << 4);
    const int vb0 = (int)(uintptr_t)lds + v_rd_base(lane);
#define ATT_DMA(gp, lp) __builtin_amdgcn_global_load_lds((const unsigned*)(gp), (LAS unsigned*)(lp), 16, 0, 0)
#define ATT_STAGE(j_, bf_) do { LAS char* bb_ = lds + (bf_) * SHM_BUF; const size_t ko_ = (size_t)(j_) * 64; \
    ATT_DMA(KNb + ko_ * 1024 + gk0, bb_ + SHM_V + wk); ATT_DMA(KNb + ko_ * 1024 + gk0 + 64, bb_ + SHM_V + 8192 + wk); \
    ATT_DMA(VBb + ko_ * 1024 + gv0, bb_ + wq); ATT_DMA(VBb + ko_ * 1024 + gv0 + 64, bb_ + wq + 1024); ATT_DMA(KRb + ko_ * 64 + gr, bb_ + SHM_V + 16384 + wk); } while (0)
#define ATT_WAIT_BAR(N) asm volatile("s_waitcnt vmcnt(" #N ") lgkmcnt(0)\n\ts_barrier" ::: "memory")
    float m_reg = -1e30f, l_reg = 0.f; f32x16 o[4];
#pragma unroll
    for (int d = 0; d < 4; ++d)
#pragma unroll
        for (int r = 0; r < 16; ++r) o[d][r] = 0.f;
    ATT_STAGE(0, 0); if (ntmax > 1) { ATT_STAGE(1, 1); ATT_WAIT_BAR(5); } else { ATT_WAIT_BAR(0); }
    int bf = 0;
    for (int j = 0; j < ntmax; ++j) {
        const int bf2 = bf == 0 ? 2 : bf - 1;
        const bool st2 = j + 2 < ntmax;
        if (st2) ATT_STAGE(j + 2, bf2);
        if (j < ntw) {
            const int vb = vb0 + bf * SHM_BUF, kb = kb0 + bf * SHM_BUF;
#pragma unroll
            for (int hk = 0; hk < 2; ++hk) {
                if (j == 0 && hk == 0) continue;
                f32x16 p0;
#pragma unroll
                for (int r = 0; r < 16; ++r) p0[r] = 0.f;
#pragma unroll
                for (int d0 = 0; d0 < 12; ++d0) {
                    const bf16x8 b0 = *(const LAS bf16x8*)(uintptr_t)(unsigned)(kb + d0 * 2048 + hk * 1024);
                    p0 = __builtin_amdgcn_mfma_f32_32x32x16_bf16(b0, qr[d0], p0, 0, 0, 0); }
                if (j == 0) {
#pragma unroll
                    for (int r = 0; r < 8; ++r) p0[r] = -1e30f;
                }
                float pmax = p0[0];
#pragma unroll
                for (int r = 1; r < 16; ++r) pmax = fmaxf(pmax, p0[r]);
                { auto sw = __builtin_amdgcn_permlane32_swap(__float_as_uint(pmax), __float_as_uint(pmax), false, false); pmax = fmaxf(__uint_as_float(sw[0]), __uint_as_float(sw[1])); }
                float mn, alpha;
                if (__all(pmax - m_reg <= 8.0f)) { mn = m_reg; alpha = 1.f; }
                else { mn = fmaxf(m_reg, pmax); alpha = __builtin_amdgcn_exp2f(m_reg - mn); m_reg = mn; }
                float ps = 0.f;
#pragma unroll
                for (int r = 0; r < 16; ++r) { p0[r] = __builtin_amdgcn_exp2f(p0[r] - mn); ps += p0[r]; }
                { auto sw = __builtin_amdgcn_permlane32_swap(__float_as_uint(ps), __float_as_uint(ps), false, false); ps = __uint_as_float(sw[0]) + __uint_as_float(sw[1]); }
                l_reg = l_reg * alpha + ps;
                bf16x8 pa0, pa1;
#define ATT_PK4(Pv, BASE, OUT) do { unsigned a0 = cvtpk(Pv[BASE + 0], Pv[BASE + 1]), a1 = cvtpk(Pv[BASE + 2], Pv[BASE + 3]); \
    unsigned b0_ = cvtpk(Pv[BASE + 4], Pv[BASE + 5]), b1_ = cvtpk(Pv[BASE + 6], Pv[BASE + 7]); \
    auto r0 = __builtin_amdgcn_permlane32_swap(a0, b0_, false, false); auto r1 = __builtin_amdgcn_permlane32_swap(a1, b1_, false, false); \
    u32x4 w = {r0[0], r1[0], r0[1], r1[1]}; OUT = *reinterpret_cast<bf16x8*>(&w); } while (0)
                ATT_PK4(p0, 0, pa0); ATT_PK4(p0, 8, pa1);
#undef ATT_PK4
                if (__any(alpha < 1.f)) { if (hi == 0) al_l[r32] = alpha; asm volatile("s_waitcnt lgkmcnt(0)" ::: "memory");
#pragma unroll
                    for (int d = 0; d < 4; ++d)
#pragma unroll
                        for (int r = 0; r < 16; ++r) o[d][r] *= al_l[crow(r, hi)]; }
                if (hk == 0) { pv_half<0, 0>(o[0], vb, pa0, pa1); pv_half<1, 0>(o[1], vb, pa0, pa1); pv_half<2, 0>(o[2], vb, pa0, pa1); pv_half<3, 0>(o[3], vb, pa0, pa1); }
                else         { pv_half<0, 1>(o[0], vb, pa0, pa1); pv_half<1, 1>(o[1], vb, pa0, pa1); pv_half<2, 1>(o[2], vb, pa0, pa1); pv_half<3, 1>(o[3], vb, pa0, pa1); }
            }
        }
        if (st2) ATT_WAIT_BAR(5); else ATT_WAIT_BAR(0);
        bf = bf == 2 ? 0 : bf + 1;
    }
    if (hi == 0) li_l[r32] = l_reg;
    asm volatile("s_waitcnt lgkmcnt(0)" ::: "memory");
    bf16_t* Ow = MIX + (rowb + qrow0) * DM + POOLW + h * 128 + r32;
#pragma unroll
    for (int r = 0; r < 16; ++r) { const int orow = crow(r, hi); const float rli = __builtin_amdgcn_rcpf(li_l[orow]);
#pragma unroll
        for (int d0 = 0; d0 < 4; ++d0) Ow[(size_t)orow * DM + d0 * 32] = (bf16_t)f2bf(o[d0][r] * rli); }
#undef ATT_DMA
#undef ATT_STAGE
#undef ATT_WAIT_BAR
}
__device__ __forceinline__ void attn_phase(const unsigned char* ws, unsigned char* wsw, LAS char* lds, int G, int bx, const int tid) {
    const bf16_t* QB = (const bf16_t*)(ws + WS_QB); const bf16_t* KN = (const bf16_t*)(ws + WS_KN); const bf16_t* KR = (const bf16_t*)(ws + WS_KR); const bf16_t* VB = (const bf16_t*)(ws + WS_VB);
    bf16_t* MIX = (bf16_t*)(wsw + WS_MIX);
    for (int c = bx; c < 256; c += G) {
        const int x = c & 7, y = c >> 3, bh = 8 * (y >> 2) + x, p = y & 3, b = bh >> 3, h = bh & 7;
#pragma unroll 1
        for (int k = 0; k < 2; ++k) attn_unit(b, h, k == 0 ? 8 - p : 1 + p, QB, KN, KR, VB, MIX, lds, tid);
    }
}
}
#define XB_TMO      128
#define XB_XCNT(j)  (256  + 64 * (j))
#define XB_XSUB(j)  (1280 + 64 * (j))
#define XB_XGEN(j)  (2304 + 64 * (j))
#define XB_TOP      3328
#define XB_TOPGEN   3392
#define XCD_BAR_WORDS 3456
#define XB_SPIN_CAP (1u << 18)
__device__ __forceinline__ unsigned xb_ld(unsigned* p)              { return __hip_atomic_load(p, __ATOMIC_RELAXED, __HIP_MEMORY_SCOPE_AGENT); }
__device__ __forceinline__ unsigned xb_add(unsigned* p, unsigned v) { return __hip_atomic_fetch_add(p, v, __ATOMIC_RELAXED, __HIP_MEMORY_SCOPE_AGENT); }
__device__ __forceinline__ unsigned xb_xcc_id() { return (unsigned)__builtin_amdgcn_s_getreg((3 << 11) | 20) & 0xFu; }
#define XB_SPIN(cond, bar) do { unsigned _sp = 0; while (cond) { __builtin_amdgcn_s_sleep(1); \
    if ((++_sp & 255u) == 0u) { if (xb_ld(&(bar)[XB_TMO])) break; if (_sp > XB_SPIN_CAP) { atomicAdd(&(bar)[XB_TMO], 1u); break; } } } } while (0)
struct XcdBarrier { unsigned* bar; unsigned x; volatile LAS unsigned* st; };
__device__ __forceinline__ XcdBarrier xcd_barrier_post(unsigned* bar, volatile LAS unsigned* st) {
    XcdBarrier b; b.bar = bar; b.x = xb_xcc_id(); b.st = st;
    if (threadIdx.x == 0) (void)xb_add(&bar[XB_XCNT(b.x)], 1u);
    return b;
}
__device__ __forceinline__ void xcd_barrier_complete(unsigned* bar, unsigned x, unsigned& nloc, unsigned& nx) {
    const unsigned G = gridDim.x * gridDim.y * gridDim.z;
    unsigned sum, cnt, mine, sp = 0u;
    for (;;) {
        sum = 0u; cnt = 0u; mine = 0u;
#pragma unroll
        for (unsigned j = 0; j < 16; ++j) { const unsigned c = xb_ld(&bar[XB_XCNT(j)]); sum += c; cnt += (c > 0u) ? 1u : 0u; mine = (j == x) ? c : mine; }
        if (sum == G) break;
        __builtin_amdgcn_s_sleep(1);
        if ((++sp & 255u) == 0u) { if (xb_ld(&bar[XB_TMO])) break; if (sp > XB_SPIN_CAP) { atomicAdd(&bar[XB_TMO], 1u); break; } }
    }
    nloc = mine > 0u ? mine : 1u; nx = cnt > 0u ? cnt : 1u;
}
__device__ __forceinline__ void xcd_barrier(const XcdBarrier& b) {
    asm volatile("s_waitcnt vmcnt(0)" ::: "memory");
    __syncthreads();
    if (threadIdx.x == 0) {
        unsigned* bar = b.bar;
        __builtin_amdgcn_s_waitcnt(0);
        unsigned nloc = b.st[0], nx = b.st[1];
        if (nloc == 0u) { xcd_barrier_complete(bar, b.x, nloc, nx); b.st[0] = nloc; b.st[1] = nx; }
        const unsigned old = xb_add(&bar[XB_XSUB(b.x)], 1u);
        const unsigned gen = old / nloc;
        if (old + 1u == (gen + 1u) * nloc) {
            __builtin_amdgcn_fence(__ATOMIC_RELEASE, "agent");
            asm volatile("s_waitcnt vmcnt(0)" ::: "memory");
            const unsigned og = xb_add(&bar[XB_TOP], 1u);
            const unsigned tg = og / nx;
            if (og + 1u == (tg + 1u) * nx) xb_add(&bar[XB_TOPGEN], 1u);
            else XB_SPIN(xb_ld(&bar[XB_TOPGEN]) == tg, bar);
            __builtin_amdgcn_fence(__ATOMIC_ACQUIRE, "agent");
            xb_add(&bar[XB_XGEN(b.x)], 1u);
            asm volatile("s_waitcnt vmcnt(0)" ::: "memory");
        } else {
            XB_SPIN(xb_ld(&bar[XB_XGEN(b.x)]) == gen, bar);
            __builtin_amdgcn_fence(__ATOMIC_ACQUIRE, "agent");
            asm volatile("s_waitcnt vmcnt(0)" ::: "memory");
        }
    }
    __syncthreads();
}
constexpr int CW_BAR = 4096;

constexpr int CVS_P1 = 0, CVS_P2 = 3072, CVS_P3 = 4352, CVS_P3B = 8192, CVS_P4 = 8448, CVS_P6 = 11776;
static_assert(CVS_P1 + 16 * 7 + 80 * 13 + 160 * 12 == CVS_P2 && CVS_P2 + 140 * 4 + 24 * 7 + 92 * 6 == CVS_P3 && CVS_P3 + 256 * 15 == CV_ITEMS_W1 && CVS_P3B == CV_ITEMS_W1 && CVS_P3B + 256 == CVS_P4 && CVS_P4 + 256 * 13 == CVS_P6 && CVS_P6 + 512 == CV_ITEMS, "conversion plan");
constexpr int PH_P0 = 0, PH_P1 = 1, PH_P1B = 2, PH_P2 = 3, PH_P3 = 4, PH_P4 = 5, PH_P5 = 6, PH_P6 = 7, PH_P7 = 8, PH_P8 = 9, PH_END = 10;
struct Args { Ptrs P; int ph_lo, ph_hi, use_bar, pad; };
#define CAS __attribute__((address_space(4)))
__device__ __forceinline__ void load_ptrs(const CAS Args* a, Ptrs& P) { P.x = a->P.x; P.meta = a->P.meta; P.g_attn = a->P.g_attn; P.w_in = a->P.w_in; P.g_q = a->P.g_q; P.w_uq = a->P.w_uq; P.g_kv = a->P.g_kv; P.w_ukv = a->P.w_ukv; P.pool_w = a->P.pool_w; P.pool_scale = a->P.pool_scale; P.w_o = a->P.w_o; P.g_ffn = a->P.g_ffn; P.w_router = a->P.w_router; P.b_router = a->P.b_router; P.w1 = a->P.w1; P.b1 = a->P.b1; P.w2 = a->P.w2; P.b2 = a->P.b2; P.g_final = a->P.g_final; P.out = a->P.out; P.ws = a->P.ws; }
__global__ void __launch_bounds__(NWAVES * 64, 2) mk_fwd(Args args) {
    extern __shared__ __attribute__((aligned(16))) unsigned char lds_raw[];
    LAS unsigned char* lds = (LAS unsigned char*)lds_raw;
    const int G = gridDim.x, bx = blockIdx.x;
#define PHASE_IDS int tid; asm volatile("v_mov_b32 %0, %1" : "=v"(tid) : "v"(threadIdx.x)); const int lane = tid & 63, wave = __builtin_amdgcn_readfirstlane(tid >> 6); \
    const long gw = (long)bx * NWAVES + wave, NGW = (long)G * NWAVES; (void)lane; (void)gw; (void)NGW; \
    const CAS Args* ap_ = (const CAS Args*)__builtin_amdgcn_kernarg_segment_ptr(); asm volatile("" : "+s"(ap_)); Ptrs P; load_ptrs(ap_, P); unsigned char* const ws = P.ws
    volatile LAS unsigned* MISC = (volatile LAS unsigned*)(lds + MISC_OFF);
    if (threadIdx.x < 64) MISC[threadIdx.x] = 0u;
    __syncthreads();
    XcdBarrier bar; bar.bar = (unsigned*)(args.P.ws + WS_CTL) + CW_BAR; bar.x = 0; bar.st = nullptr;
    if (args.use_bar) bar = xcd_barrier_post((unsigned*)(args.P.ws + WS_CTL) + CW_BAR, MISC + 8);
    const int lo = args.ph_lo, hi = args.ph_hi;
#define IN(k) (lo <= (k) && (k) < hi)
    const bool cv_first = ((bx >> 3) & 1) != 0;
#define CV_CALL(W1, F, S, N) do { const CAS Args* ap2_ = (const CAS Args*)__builtin_amdgcn_kernarg_segment_ptr(); asm volatile("" : "+s"(ap2_)); Ptrs Pc_; load_ptrs(ap2_, Pc_); cv_slice<W1>(Pc_, lds_raw, tid, (F), (S), (N)); } while (0)
#define CV_DEAL(W1, S, ca, ka, cb, kb, kc) do { if (G == 256) { int f_, s_, n_; if (bx < (ca)) { f_ = (S) + bx; s_ = (ca); n_ = (ka); } else if (bx < (cb)) { f_ = (S) + (ca) * (ka) + (bx - (ca)); s_ = (cb) - (ca); n_ = (kb); } \
        else { f_ = (S) + (ca) * (ka) + ((cb) - (ca)) * (kb) + (bx - (cb)); s_ = 256 - (cb); n_ = (kc); } CV_CALL(W1, f_, s_, n_); } \
    else { const int tot_ = (ca) * (ka) + ((cb) - (ca)) * (kb) + (256 - (cb)) * (kc); for (int it_ = (S) + bx; it_ < (S) + tot_; it_ += G) CV_CALL(W1, it_, 0, 1); } } while (0)
#define CV_SLICE(W1, S, N) CV_DEAL(W1, S, 0, 0, 0, 0, N)
#define SEAM(k) do { if (IN(k) && IN((k) + 1)) xcd_barrier(bar); } while (0)

    if (IN(PH_P0)) { PHASE_IDS;
        float* scr = (float*)lds_raw + wave * (64 * 65);
        for (long it = gw; it < I_TOTAL; it += NGW) p0_item(P, it, scr, lane);
        for (long p = gw; p < MP; p += NGW) p0_hn_row(P, (int)p, lane);
        { u32x4* z = (u32x4*)(ws + WS_WIN + (size_t)INW * DM * 2); const long n16 = (long)(DM - INW) * DM * 2 / 16;
          for (long i = (long)bx * 512 + tid; i < n16; i += (long)G * 512) z[i] = (u32x4){0u, 0u, 0u, 0u}; }
        { float* ct = (float*)(ws + WS_ROPE); float* st = ct + LSEQ * 32;
          for (long i = (long)bx * 512 + tid; i < LSEQ * 32; i += (long)G * 512) { const int pos = (int)(i / 32), j = (int)(i % 32);
              const float inv = 1.0f / powf(10000.0f, (float)(2 * j) / 64.0f); const float ang = (float)pos * inv; ct[i] = cosf(ang); st[i] = sinf(ang); } }
        { float* wr = (float*)(ws + WS_WR);
          for (long i = (long)bx * 512 + tid; i < DM * NE; i += (long)G * 512) { const int k = (int)(i / NE), e = (int)(i % NE); wr[((k >> 2) * NE + e) * 4 + (k & 3)] = P.w_router[i] * P.g_ffn[k]; } }
        __syncthreads();
    }
    SEAM(PH_P0);
    if (IN(PH_P1)) { PHASE_IDS;
        pg8::ProbP1 pb; pb.A = (const char*)(ws + WS_HN); pb.Bt = (const char*)(ws + WS_WIN); pb.K = DM; pb.lda = DM; pb.ldaB = 2 * DM; pb.ldb = DM; pb.ldbB = 2 * DM; pb.ord.init(MP / 256, 8, G, bx);
        pb.proj = (bf16_t*)(ws + WS_PROJ); pb.kr = (bf16_t*)(ws + WS_KR); pb.rope = (const float*)(ws + WS_ROPE); pb.ssqp = (float*)(ws + WS_RSQ);
        if (cv_first) CV_DEAL(true, CVS_P1, 16, 7, 96, 13, 12);
        pg8::gemm_phase<pg8::ProbP1, true>(lds + RING_OFF, pb, tid);
        if (!cv_first) CV_DEAL(true, CVS_P1, 16, 7, 96, 13, 12);
    }
    if (IN(PH_P1) && IN(PH_P2)) xcd_barrier(bar);
    if (IN(PH_P2)) { PHASE_IDS;
        for (long m = gw; m < MP; m += NGW) p1b_row(P, (int)m, lane);
        if (cv_first) CV_DEAL(true, CVS_P2, 140, 4, 164, 7, 6);
        { pg8::ProbP2q pb; pb.A = (const char*)(ws + WS_PROJ) + 1024 * 2; pb.Bt = (const char*)(ws + WS_WUQ); pb.K = QLORA; pb.lda = DM; pb.ldaB = 2 * DM; pb.ldb = QLORA; pb.ldbB = 2 * QLORA; pb.ord.init(MP / 256, 6, G, bx);
          pb.qb = (bf16_t*)(ws + WS_QB); pb.rsq = (const float*)(ws + WS_RSQ); pb.rope = (const float*)(ws + WS_ROPE);
          pg8::gemm_phase<pg8::ProbP2q, true>(lds + RING_OFF, pb, tid); }
        { pg8::ProbP2kv pb; pb.A = (const char*)(ws + WS_PROJ) + 1536 * 2; pb.Bt = (const char*)(ws + WS_WUKV); pb.K = KVLORA; pb.lda = DM; pb.ldaB = 2 * DM; pb.ldb = KVLORA; pb.ldbB = 2 * KVLORA; pb.ord.init(MP / 256, 8, G, (bx + 116) % G);
          pb.kn = (bf16_t*)(ws + WS_KN); pb.vb = (bf16_t*)(ws + WS_VB); pb.rskv = (const float*)(ws + WS_RSQ);
          pg8::gemm_phase<pg8::ProbP2kv, true>(lds + RING_OFF, pb, tid); }
        if (!cv_first) CV_DEAL(true, CVS_P2, 140, 4, 164, 7, 6);
    }
    SEAM(PH_P2);
    if (IN(PH_P3)) { PHASE_IDS;
        if (cv_first) { CV_SLICE(true, CVS_P3, 15); CV_SLICE(false, CVS_P3B, 1); }
        att::attn_phase(ws, ws, (LAS char*)(lds + RING_OFF), G, bx, tid);
        { pg8::ProbPool pb; pb.A = (const char*)(ws + WS_DP); pb.Bt = (const char*)(ws + WS_WPOOL); pb.K = 256; pb.lda = POOLW; pb.ldaB = 2 * POOLW; pb.ldb = 256; pb.ldbB = 2 * 256; pb.ord.init(MP / 256, 4, G, bx);
          pb.mix = (bf16_t*)(ws + WS_MIX); pb.pscale = P.pool_scale;
          pg8::gemm_phase<pg8::ProbPool, true>(lds + RING_OFF, pb, tid); }
        if (!cv_first) { CV_SLICE(true, CVS_P3, 15); CV_SLICE(false, CVS_P3B, 1); }
    }
    SEAM(PH_P3);
    if (IN(PH_P4)) { PHASE_IDS;
        pg8::ProbP4 pb; pb.A = (const char*)(ws + WS_MIX); pb.Bt = (const char*)(ws + WS_WO); pb.K = DM; pb.lda = DM; pb.ldaB = 2 * DM; pb.ldb = DM; pb.ldbB = 2 * DM; pb.ord.init(MR / 256, 8, G, bx);
        pb.x = P.x; pb.h2 = (bf16_t*)(ws + WS_HN); pb.h2f8 = ws + WS_H2B;
        pg8::gemm_phase<pg8::ProbP4, true>(lds + RING_OFF, pb, tid);
    }
    SEAM(PH_P4);
    if (IN(PH_P5)) { PHASE_IDS; for (int blk = bx; blk < MR / 64; blk += G) p5_block(P, blk, lds_raw, tid); }
    SEAM(PH_P5);
    if (IN(PH_P6)) { PHASE_IDS;
        pg8::moe_table(lds, (const unsigned*)(ws + WS_CTL) + CW_CNT, tid);
        pg8::ProbP6 pb; pb.A = (const char*)(ws + WS_H2B); pb.Bt = (const char*)(ws + WS_W1); pb.K = DM; pb.ldbB = DM; pb.ord.tab = (const LAS int*)(lds + TAB_OFF); pb.ord.G = G; pb.ord.c = bx;
        pb.list = (const int*)(ws + WS_LIST); pb.rsl = (const float*)(ws + WS_RSL); pb.b1 = P.b1; pb.act = ws + WS_ACT;
        const int split = 2 + 4 * ((bx >> 3) & 3);
        pb.ord.i0 = 0; pb.ord.i1 = split;
        pg8::gemm_phase<pg8::ProbP6, true>(lds + RING_OFF, pb, tid);
        CV_SLICE(false, CVS_P4, 13);
        pb.ord.i0 = split; pb.ord.i1 = 0x7fffffff;
        pg8::gemm_phase<pg8::ProbP6, true>(lds + RING_OFF, pb, tid);
        { const int U = ((const LAS int*)(lds + TAB_OFF))[NE] * 16, R = U % G, nidle = G - R, rank0 = (G & 7) ? bx : (bx & 7) * (G >> 3) + (bx >> 3);
          const bool few = nidle < 64; const int nshare = few ? G : nidle, rank = few ? rank0 : rank0 - R;
          if (rank >= 0) { const int cnt_ = (CV_ITEMS - CVS_P6 - rank + nshare - 1) / nshare; CV_CALL(false, CVS_P6 + rank, nshare, cnt_); } }
    }
    SEAM(PH_P6);
    if (IN(PH_P7)) { PHASE_IDS;
        pg8::moe_table(lds, (const unsigned*)(ws + WS_CTL) + CW_CNT, tid);
        pg8::ProbP7 pb; pb.A = (const char*)(ws + WS_ACT); pb.Bt = (const char*)(ws + WS_W2); pb.K = DFF; pb.ldbB = DFF; pb.ord.tab = (const LAS int*)(lds + TAB_OFF); pb.ord.G = G; pb.ord.c = bx; pb.ord.i0 = 0; pb.ord.i1 = 0x7fffffff;
        pb.list = (const int*)(ws + WS_LIST); pb.gate = (const float*)(ws + WS_GATE); pb.b2 = P.b2; pb.yb = ws + WS_YB;
        pg8::gemm_phase<pg8::ProbP7, true>(lds + RING_OFF, pb, tid);
    }
    SEAM(PH_P7);
    if (IN(PH_P8)) { PHASE_IDS; for (long r = gw; r < MR; r += NGW) p8_row(P, (int)r, lane, P.out); }
#undef IN
#undef SEAM
}

extern "C" void kernel_launch(void* const* d_in, const int* in_sizes, int n_in, void* d_out, int out_size, void* d_ws, size_t ws_size, hipStream_t stream) {
    static int ok = 0; static int grid = 256;
    if (ok == 0) {
        if (n_in != 19 || in_sizes[0] != NB * SEQ * DM || out_size != MR * DM || ws_size < WS_END) { fprintf(stderr, "kernel_launch: shape mismatch n_in %d in0 %d out %d ws %zu\n", n_in, n_in > 0 ? in_sizes[0] : -1, out_size, ws_size); ok = -1; return; }
        if (hipFuncSetAttribute((const void*)mk_fwd, hipFuncAttributeMaxDynamicSharedMemorySize, LDS_BYTES) != hipSuccess) { fprintf(stderr, "hipFuncSetAttribute(mk) failed\n"); ok = -1; return; }
        int dev = 0, cus = 0; (void)hipGetDevice(&dev); (void)hipDeviceGetAttribute(&cus, hipDeviceAttributeMultiprocessorCount, dev); if (cus > 0) grid = cus;
        ok = 1;
    }
    if (ok < 0) return;
    Ptrs P{};
    const float** pp = (const float**)&P;
    for (int i = 0; i < 19; ++i) pp[i] = (const float*)d_in[i];
    P.out = (float*)d_out; P.ws = (unsigned char*)d_ws;
    unsigned char* ws = (unsigned char*)d_ws;
    (void)hipMemsetAsync(ws + WS_CTL, 0, CTL_ZERO_BYTES, stream);
    { Args a{}; a.P = P; a.ph_lo = 0; a.ph_hi = PH_END; a.use_bar = 1; a.pad = 0;
      hipLaunchKernelGGL(mk_fwd, dim3(grid), dim3(NWAVES * 64), LDS_BYTES, stream, a); }
}
```

```cpp
#include <hip/hip_runtime.h>
#include <cstdint>
#include <cstdio>

constexpr int NB = 8, SEQ = 2048, NMETA = 16, LSEQ = 2064, LP = 2112, PADR = 48, MP = NB * LP, MR = NB * SEQ;
constexpr int DM = 2048, POOLW = 1024, QLORA = 512, KVLORA = 256, QKROPE = 64, QKNOPE = 128, VDIM = 128, NH = 8, QKD = 192;
constexpr int INW = 1856, NE = 32, TOPK = 4, DFF = 2048;
constexpr float EPS = 1e-5f;
constexpr float C2 = 0.07216878364870322f * 1.4426950408889634f;
constexpr int ACT_ROWS = MR * TOPK + NE * 256;

typedef unsigned short bf16_t;
typedef unsigned u32x4 __attribute__((ext_vector_type(4)));
typedef float f32x4 __attribute__((ext_vector_type(4)));

constexpr size_t MiB = 1u << 20;
constexpr size_t WS_CTL = 0, CTL_ZERO_BYTES = 1 * MiB;
constexpr size_t WS_ROPE = 1 * MiB;
constexpr size_t WS_WR = 2 * MiB;
constexpr size_t WS_WIN = 4 * MiB;
constexpr size_t WS_WUQ = 12 * MiB;
constexpr size_t WS_WUKV = 14 * MiB;
constexpr size_t WS_WPOOL = 15 * MiB;
constexpr size_t WS_WO = 16 * MiB;
constexpr size_t WS_W1 = 24 * MiB;
constexpr size_t WS_W2 = 536 * MiB;
constexpr size_t WS_HN = 792 * MiB;
constexpr size_t WS_PROJ = 860 * MiB;
constexpr size_t WS_QB = 928 * MiB;
constexpr size_t WS_KN = 980 * MiB;
constexpr size_t WS_VB = 1014 * MiB;
constexpr size_t WS_KR = 1048 * MiB;
constexpr size_t WS_RSQ = 1051 * MiB;
constexpr size_t WS_RSKV = 1052 * MiB;
constexpr size_t WS_RS2 = 1053 * MiB;
constexpr size_t WS_DP = 1054 * MiB;
constexpr size_t WS_MIX = 1088 * MiB;
constexpr size_t WS_H2B = 1156 * MiB;
constexpr size_t WS_LIST = 1220 * MiB;
constexpr size_t WS_GATE = 1222 * MiB;
constexpr size_t WS_ACT = 1224 * MiB;
constexpr size_t WS_YB = 1512 * MiB;
constexpr size_t WS_RSL = 1768 * MiB;
constexpr size_t WS_END = 1770 * MiB;
constexpr int CW_CNT = 64;

struct Ptrs {
    const float *x, *meta, *g_attn, *w_in, *g_q, *w_uq, *g_kv, *w_ukv, *pool_w, *pool_scale, *w_o, *g_ffn, *w_router, *b_router, *w1, *b1, *w2, *b2, *g_final;
    float* out; unsigned char* ws;
};

__device__ __forceinline__ float bf2f(bf16_t v) { return __uint_as_float((unsigned)v << 16); }
__device__ __forceinline__ unsigned f2bf(float f) { unsigned u = __float_as_uint(f); return (u + 0x7fffu + ((u >> 16) & 1u)) >> 16; }
__device__ __forceinline__ unsigned pk2(float lo, float hi) { return f2bf(lo) | (f2bf(hi) << 16); }
__device__ __forceinline__ float wave_sum(float v) {
#pragma unroll
    for (int o = 1; o < 64; o <<= 1) v += __shfl_xor(v, o);
    return v;
}
__device__ __forceinline__ float wave_max(float v) {
#pragma unroll
    for (int o = 1; o < 64; o <<= 1) v = fmaxf(v, __shfl_xor(v, o));
    return v;
}

__device__ __forceinline__ void p0_hn_row(const Ptrs& P, int p, int lane) {
    bf16_t* hn = (bf16_t*)(P.ws + WS_HN) + (size_t)p * DM;
    const int b = p / LP, q = p % LP;
    unsigned long long* o8 = (unsigned long long*)hn + lane;
    if (q < PADR) {
#pragma unroll
        for (int j = 0; j < 8; ++j) o8[64 * j] = 0ull;
        return;
    }
    const int pos = q - PADR;
    const float* src = pos < NMETA ? P.meta + (size_t)pos * DM : P.x + ((size_t)b * SEQ + (pos - NMETA)) * DM;
    const f32x4* xr = (const f32x4*)src + lane;
    const f32x4* gr = (const f32x4*)P.g_attn + lane;
    f32x4 v[8]; float s = 0.f;
#pragma unroll
    for (int j = 0; j < 8; ++j) { v[j] = xr[64 * j]; s += (v[j].x * v[j].x + v[j].y * v[j].y) + (v[j].z * v[j].z + v[j].w * v[j].w); }
    const float rs = 1.0f / sqrtf(wave_sum(s) * (1.0f / DM) + EPS);
#pragma unroll
    for (int j = 0; j < 8; ++j) { const f32x4 g = gr[64 * j];
        o8[64 * j] = (unsigned long long)pk2(v[j].x * rs * g.x, v[j].y * rs * g.y) | ((unsigned long long)pk2(v[j].z * rs * g.z, v[j].w * rs * g.w) << 32); }
}
template <int MODE> __device__ __forceinline__ int nmap(int n) {
    if (MODE == 1) { if (n >= 1792) { const int j = n - 1792; return 1792 + (j < 32 ? 2 * j : 2 * (j - 32) + 1); } return n; }
    if (MODE == 2) { const int h = n / 192, d = n % 192; if (d >= 128) { const int j = d - 128; return h * 192 + 128 + (j < 32 ? 2 * j : 2 * (j - 32) + 1); } return n; }
    return n;
}
template <int MODE> __device__ __forceinline__ void p0_transpose_item(const float* W, int K, int N, bf16_t* WT, const float* gk, float* scr, int item, int lane) {
    const int nblk = N / 64, kb = item / nblk, nb = item % nblk, k0 = 64 * kb, n0 = 64 * nb;
    const int kl = lane >> 4, nl = (lane & 15) * 4;
#pragma unroll 4
    for (int i = 0; i < 16; ++i) { const int kk = kl + 4 * i; const f32x4 v = *(const f32x4*)(W + (size_t)(k0 + kk) * N + n0 + nl);
        const float g = gk ? gk[k0 + kk] : 1.0f;
        float* s = scr + kk * 65 + nl; s[0] = v.x * g; s[1] = v.y * g; s[2] = v.z * g; s[3] = v.w * g; }
    __builtin_amdgcn_s_waitcnt(0xc07f); asm volatile("" ::: "memory");
    const int c = lane & 7;
#pragma unroll
    for (int j = 0; j < 8; ++j) { const int n = (lane >> 3) + 8 * j; const float* s = scr + (8 * c) * 65 + n;
        u32x4 o; o.x = pk2(s[0 * 65], s[1 * 65]); o.y = pk2(s[2 * 65], s[3 * 65]); o.z = pk2(s[4 * 65], s[5 * 65]); o.w = pk2(s[6 * 65], s[7 * 65]);
        *(u32x4*)(WT + (size_t)nmap<MODE>(n0 + n) * K + k0 + 8 * c) = o; }
    __builtin_amdgcn_s_waitcnt(0xc07f); asm volatile("" ::: "memory");
}
__device__ __forceinline__ void p0_transpose_item_f8(const float* W, int K, int N, unsigned char* WT, const float* gk, float scale, float* scr, int item, int lane) {
    const int nblk = N / 64, kb = item / nblk, nb = item % nblk, k0 = 64 * kb, n0 = 64 * nb;
    const int kl = lane >> 4, nl = (lane & 15) * 4;
#pragma unroll 4
    for (int i = 0; i < 16; ++i) { const int kk = kl + 4 * i; const f32x4 v = *(const f32x4*)(W + (size_t)(k0 + kk) * N + n0 + nl);
        const float g = (gk ? gk[k0 + kk] : 1.0f) * scale;
        float* s = scr + kk * 65 + nl; s[0] = v.x * g; s[1] = v.y * g; s[2] = v.z * g; s[3] = v.w * g; }
    asm volatile("s_waitcnt lgkmcnt(0)" ::: "memory");
    const int c = lane & 7;
#pragma unroll
    for (int j = 0; j < 8; ++j) { const int n = (lane >> 3) + 8 * j; const float* s = scr + (8 * c) * 65 + n;
        int w0 = 0, w1 = 0;
        w0 = __builtin_amdgcn_cvt_pk_fp8_f32(s[0 * 65], s[1 * 65], w0, false); w0 = __builtin_amdgcn_cvt_pk_fp8_f32(s[2 * 65], s[3 * 65], w0, true);
        w1 = __builtin_amdgcn_cvt_pk_fp8_f32(s[4 * 65], s[5 * 65], w1, false); w1 = __builtin_amdgcn_cvt_pk_fp8_f32(s[6 * 65], s[7 * 65], w1, true);
        *(unsigned long long*)(WT + (size_t)(n0 + n) * K + k0 + 8 * c) = (unsigned long long)(unsigned)w0 | ((unsigned long long)(unsigned)w1 << 32); }
    asm volatile("s_waitcnt lgkmcnt(0)" ::: "memory");
}
constexpr int CV_ITEMS_W1 = NE * (DM / 128) * (4096 / 256), CV_ITEMS_W2 = NE * (DFF / 128) * (DM / 256), CV_ITEMS = CV_ITEMS_W1 + CV_ITEMS_W2;
struct CvItem { const float* src; unsigned char* dst; const float* gk; };
template <bool W1> __device__ __forceinline__ CvItem cv_decode(const Ptrs& P, int it) {
    CvItem c;
    if (W1) { const int e = it >> 8, r = it & 255, kb = r >> 4, nb = r & 15;
        c.src = P.w1 + (size_t)e * DM * 4096 + (size_t)kb * 128 * 4096 + nb * 256; c.dst = P.ws + WS_W1 + ((size_t)e * 4096 + nb * 256) * DM + kb * 128; c.gk = P.g_ffn + kb * 128; }
    else { const int j = it - CV_ITEMS_W1, e = j >> 7, r = j & 127, kb = r >> 3, nb = r & 7;
        c.src = P.w2 + (size_t)e * DFF * DM + (size_t)kb * 128 * DM + nb * 256; c.dst = P.ws + WS_W2 + ((size_t)e * DM + nb * 256) * DFF + kb * 128; c.gk = nullptr; }
    return c;
}
#define CV_LOAD(V, C) do { const __amdgpu_buffer_rsrc_t rs_ = __builtin_amdgcn_make_buffer_rsrc((void*)(C).src, 0, 0x7ffffffe, 0x00020000); \
        _Pragma("unroll") for (int i_ = 0; i_ < 16; ++i_) V[i_] = __builtin_bit_cast(f32x4, __builtin_amdgcn_raw_buffer_load_b128(rs_, lane * 16, (wave + 8 * i_) * NN * 4, 2  )); } while (0)
#define CV_PROCESS(V, C, NEXT_IDX) do { \
        _Pragma("unroll") for (int i_ = 0; i_ < 16; ++i_) { const int k_ = wave + 8 * i_; const float g_ = W1 ? (C).gk[k_] * 32.0f : 32.0f; float* s_ = scr + k_ * 257 + lane * 4; \
            s_[0] = V[i_].x * g_; s_[1] = V[i_].y * g_; s_[2] = V[i_].z * g_; s_[3] = V[i_].w * g_; } \
        unsigned char* dst_ = (C).dst; \
        { const int nx_ = (NEXT_IDX) < count ? (NEXT_IDX) : count - 1; (C) = cv_decode<W1>(P, first + nx_ * step); CV_LOAD(V, C); } \
        asm volatile("s_waitcnt lgkmcnt(0)\n\ts_barrier" ::: "memory"); \
          \
        _Pragma("unroll") for (int p_ = 0; p_ < 4; ++p_) { const int u_ = p_ * 8 + wave, nn_ = (u_ >> 1) * 16 + (lane >> 2), k0_ = (u_ & 1) * 64 + (lane & 3) * 16; \
            const float* t_ = scr + k0_ * 257 + nn_; u32x4 w_; \
            _Pragma("unroll") for (int d_ = 0; d_ < 4; ++d_) { int x_ = 0; x_ = __builtin_amdgcn_cvt_pk_fp8_f32(t_[(4 * d_) * 257], t_[(4 * d_ + 1) * 257], x_, false); \
                x_ = __builtin_amdgcn_cvt_pk_fp8_f32(t_[(4 * d_ + 2) * 257], t_[(4 * d_ + 3) * 257], x_, true); w_[d_] = (unsigned)x_; } \
            *(u32x4*)(dst_ + (size_t)nn_ * DM + k0_) = w_; } \
        asm volatile("s_waitcnt lgkmcnt(0)\n\ts_barrier" ::: "memory"); } while (0)
template <bool W1> __device__ __forceinline__ void cv_slice(const Ptrs& P, unsigned char* ldsg, int tid, int first, int step, int count) {
    if (count <= 0) return;
    constexpr int NN = W1 ? 4096 : DM;
    float* scr = (float*)ldsg;
    const int lane = tid & 63, wave = __builtin_amdgcn_readfirstlane(tid >> 6);
    f32x4 va[16];
    CvItem ca = cv_decode<W1>(P, first);
    CV_LOAD(va, ca);
    for (int n = 0; n < count; ++n) CV_PROCESS(va, ca, n + 1);
    asm volatile("s_waitcnt vmcnt(0)" ::: "memory");
}
#undef CV_LOAD
#undef CV_PROCESS
constexpr int I_WIN = (DM / 64) * (INW / 64), I_WUQ = (QLORA / 64) * (1536 / 64), I_WUKV = (KVLORA / 64) * (2048 / 64), I_POOL1 = 4 * 4, I_WO = 32 * 32,
              I_W1E = (DM / 64) * (4096 / 64), I_W2E = 32 * 32;
constexpr int I_SMALL = I_WIN + I_WUQ + I_WUKV + 4 * I_POOL1 + I_WO;
constexpr long I_TOTAL = (long)I_SMALL;
__device__ __forceinline__ void p0_item(const Ptrs& P, long it, float* scr, int lane) {
    unsigned char* ws = P.ws;
    if (it < I_SMALL) {
        int r = (int)it;
        if (r < I_WIN) { p0_transpose_item<1>(P.w_in, DM, INW, (bf16_t*)(ws + WS_WIN), nullptr, scr, r, lane); return; } r -= I_WIN;
        if (r < I_WUQ) { p0_transpose_item<2>(P.w_uq, QLORA, 1536, (bf16_t*)(ws + WS_WUQ), P.g_q, scr, r, lane); return; } r -= I_WUQ;
        if (r < I_WUKV) { p0_transpose_item<0>(P.w_ukv, KVLORA, 2048, (bf16_t*)(ws + WS_WUKV), P.g_kv, scr, r, lane); return; } r -= I_WUKV;
        if (r < 4 * I_POOL1) { const int g = r / I_POOL1; p0_transpose_item<0>(P.pool_w + (size_t)g * 65536, 256, 256, (bf16_t*)(ws + WS_WPOOL) + (size_t)g * 65536, nullptr, scr, r % I_POOL1, lane); return; } r -= 4 * I_POOL1;
        p0_transpose_item<0>(P.w_o, DM, DM, (bf16_t*)(ws + WS_WO), nullptr, scr, r, lane); return;
    }
    it -= I_SMALL;
    if (it < (long)NE * I_W1E) { const int e = (int)(it / I_W1E), r = (int)(it % I_W1E);
        p0_transpose_item_f8(P.w1 + (size_t)e * DM * 4096, DM, 4096, ws + WS_W1 + (size_t)e * 4096 * DM, P.g_ffn, 32.0f, scr, r, lane); return; }
    it -= (long)NE * I_W1E;
    { const int e = (int)(it / I_W2E), r = (int)(it % I_W2E);
      p0_transpose_item_f8(P.w2 + (size_t)e * DFF * DM, DFF, DM, ws + WS_W2 + (size_t)e * DM * DFF, nullptr, 32.0f, scr, r, lane); }
}
__device__ __forceinline__ void st4bf(bf16_t* p, float a, float b, float c, float d) { *(unsigned long long*)p = (unsigned long long)pk2(a, b) | ((unsigned long long)pk2(c, d) << 32); }
__device__ __forceinline__ void p1b_row(const Ptrs& P, int m, int lane) {
    const bf16_t* proj = (const bf16_t*)(P.ws + WS_PROJ);
    const bf16_t* row = proj + (size_t)m * DM;
    bf16_t* dp = (bf16_t*)(P.ws + WS_DP) + (size_t)m * POOLW;
    const int pos = (m % LP) - PADR;
    if (pos < 0) {
#pragma unroll
        for (int g = 0; g < 4; ++g) *(unsigned long long*)(dp + g * 256 + lane * 4) = 0ull;
        return;
    }
    unsigned long long ld[30];
    { int q = 0;
#pragma unroll
      for (int g = 0; g < 4; ++g)
#pragma unroll
          for (int j = 0; j < (2 << g); ++j) { const int jj = j < pos ? j : pos; ld[q++] = *(const unsigned long long*)(row - (size_t)jj * DM + g * 256 + lane * 4); } }
    { int q = 0;
#pragma unroll
      for (int g = 0; g < 4; ++g) { const int w = 2 << g; const int cntw = pos + 1 < w ? pos + 1 : w;
        float s0 = 0.f, s1 = 0.f, s2 = 0.f, s3 = 0.f, u0 = 0.f, u1 = 0.f, u2 = 0.f, u3 = 0.f;
#pragma unroll
        for (int j = 0; j < w; ++j) { const unsigned long long v = ld[q++]; const unsigned lo = (unsigned)v, hi = (unsigned)(v >> 32);
            const float mk = j < cntw ? 1.0f : 0.0f;
            const float a = __uint_as_float(lo << 16) * mk, b2 = __uint_as_float(lo & 0xffff0000u) * mk, cc = __uint_as_float(hi << 16) * mk, d = __uint_as_float(hi & 0xffff0000u) * mk;
            if (j == 0) { u0 = a; u1 = b2; u2 = cc; u3 = d; } s0 += a; s1 += b2; s2 += cc; s3 += d; }
        const float ic = 1.0f / (float)cntw;
        st4bf(dp + g * 256 + lane * 4, s0 * ic - u0, s1 * ic - u1, s2 * ic - u2, s3 * ic - u3); } }
}
typedef float f32x16_t __attribute__((ext_vector_type(16)));
__device__ __forceinline__ void p5_block(const Ptrs& P, int blk, unsigned char* ldsg, int tid) {
    const int lane = tid & 63, wave = tid >> 6, t = lane & 31, kk = lane >> 5, tg = wave >> 2, kq = wave & 3;
    float* part = (float*)ldsg;
    float* ssqp = part + 8 * 32 * 33;
    const bf16_t* arow = (const bf16_t*)(P.ws + WS_HN) + (size_t)(blk * 64 + tg * 32 + t) * DM + kq * 512 + 16 * kk;
    const f32x4* bptr = (const f32x4*)(P.ws + WS_WR) + ((kq * 128 + 4 * kk) * NE + t);
    f32x16_t acc;
#pragma unroll
    for (int r = 0; r < 16; ++r) acc[r] = 0.f;
    float ss = 0.f;
#pragma unroll 2
    for (int j = 0; j < 16; ++j) {
        f32x4 a[4], b[4]; const u32x4 d0 = *(const u32x4*)(arow + 32 * j), d1 = *(const u32x4*)(arow + 32 * j + 8);
#pragma unroll
        for (int q = 0; q < 4; ++q) b[q] = bptr[(8 * j + q) * NE];
        a[0] = (f32x4){__uint_as_float(d0[0] << 16), __uint_as_float(d0[0] & 0xffff0000u), __uint_as_float(d0[1] << 16), __uint_as_float(d0[1] & 0xffff0000u)};
        a[1] = (f32x4){__uint_as_float(d0[2] << 16), __uint_as_float(d0[2] & 0xffff0000u), __uint_as_float(d0[3] << 16), __uint_as_float(d0[3] & 0xffff0000u)};
        a[2] = (f32x4){__uint_as_float(d1[0] << 16), __uint_as_float(d1[0] & 0xffff0000u), __uint_as_float(d1[1] << 16), __uint_as_float(d1[1] & 0xffff0000u)};
        a[3] = (f32x4){__uint_as_float(d1[2] << 16), __uint_as_float(d1[2] & 0xffff0000u), __uint_as_float(d1[3] << 16), __uint_as_float(d1[3] & 0xffff0000u)};
#pragma unroll
        for (int q = 0; q < 4; ++q) {
            ss += (a[q].x * a[q].x + a[q].y * a[q].y) + (a[q].z * a[q].z + a[q].w * a[q].w);
            acc = __builtin_amdgcn_mfma_f32_32x32x2f32(a[q].x, b[q].x, acc, 0, 0, 0); acc = __builtin_amdgcn_mfma_f32_32x32x2f32(a[q].y, b[q].y, acc, 0, 0, 0);
            acc = __builtin_amdgcn_mfma_f32_32x32x2f32(a[q].z, b[q].z, acc, 0, 0, 0); acc = __builtin_amdgcn_mfma_f32_32x32x2f32(a[q].w, b[q].w, acc, 0, 0, 0);
        }
    }
    ss += __shfl_xor(ss, 32);
#pragma unroll
    for (int r = 0; r < 16; ++r) part[(wave * 32 + ((r & 3) + 8 * (r >> 2) + 4 * kk)) * 33 + t] = acc[r];
    if (kk == 0) ssqp[wave * 32 + t] = ss;
    __syncthreads();
    if (tid < 64) {
        const int tg2 = tid >> 5, ti = tid & 31, r = blk * 64 + tid;
        float lg[NE];
#pragma unroll
        for (int e = 0; e < NE; ++e) lg[e] = (part[((tg2 * 4 + 0) * 32 + ti) * 33 + e] + part[((tg2 * 4 + 1) * 32 + ti) * 33 + e]) + (part[((tg2 * 4 + 2) * 32 + ti) * 33 + e] + part[((tg2 * 4 + 3) * 32 + ti) * 33 + e]);
        const float ssq = (ssqp[(tg2 * 4 + 0) * 32 + ti] + ssqp[(tg2 * 4 + 1) * 32 + ti]) + (ssqp[(tg2 * 4 + 2) * 32 + ti] + ssqp[(tg2 * 4 + 3) * 32 + ti]);
        const float rs = 1.0f / sqrtf(ssq * (1.0f / DM) + EPS);
#pragma unroll
        for (int e = 0; e < NE; ++e) lg[e] = lg[e] * rs + P.b_router[e];
        ((float*)(P.ws + WS_RS2))[r] = rs;
        int idx[TOPK]; float val[TOPK]; unsigned used = 0u;
#pragma unroll
        for (int k = 0; k < TOPK; ++k) { float best = -INFINITY; int bi = 0;
#pragma unroll
            for (int e = 0; e < NE; ++e) { const bool ok = !((used >> e) & 1u) && lg[e] > best; best = ok ? lg[e] : best; bi = ok ? e : bi; }
            used |= 1u << bi; idx[k] = bi; val[k] = best; }
        float den = 0.f, pe[TOPK];
#pragma unroll
        for (int k = 0; k < TOPK; ++k) { pe[k] = __expf(val[k] - val[0]); den += pe[k]; }
        unsigned* cnt = (unsigned*)(P.ws + WS_CTL) + CW_CNT; int* list = (int*)(P.ws + WS_LIST); float* gate = (float*)(P.ws + WS_GATE); float* rsl = (float*)(P.ws + WS_RSL);
        unsigned* lcnt = (unsigned*)(ssqp + 8 * 32); unsigned* lbase = lcnt + NE;
        if (tid < NE) lcnt[tid] = 0u;
        unsigned rk[TOPK];
#pragma unroll
        for (int k = 0; k < TOPK; ++k) rk[k] = __hip_atomic_fetch_add(lcnt + idx[k], 1u, __ATOMIC_RELAXED, __HIP_MEMORY_SCOPE_WORKGROUP);
        if (tid < NE) { const unsigned n = lcnt[tid]; lbase[tid] = n ? atomicAdd(cnt + tid, n) : 0u; }
#pragma unroll
        for (int k = 0; k < TOPK; ++k) { const unsigned slot = lbase[idx[k]] + rk[k]; const size_t o = (size_t)idx[k] * MR + slot; list[o] = r * 4 + k; gate[o] = pe[k] / den; rsl[o] = rs; }
    }
    __syncthreads();
}
__device__ __forceinline__ void p8_row(const Ptrs& P, int r, int lane, float* outbase) {
    const bf16_t* h2 = (const bf16_t*)(P.ws + WS_HN) + (size_t)r * DM; float* orow = outbase + (size_t)r * DM; const unsigned char* yb = P.ws + WS_YB + (size_t)r * 4 * DM;
    f32x4 v[8]; float s = 0.f;
#pragma unroll
    for (int j = 0; j < 8; ++j) { const int c = 4 * lane + 256 * j;
        { const unsigned long long y = *(const unsigned long long*)(h2 + c); const unsigned lo = (unsigned)y, hi = (unsigned)(y >> 32);
          v[j] = (f32x4){__uint_as_float(lo << 16), __uint_as_float(lo & 0xffff0000u), __uint_as_float(hi << 16), __uint_as_float(hi & 0xffff0000u)}; }
#pragma unroll
        for (int k = 0; k < 4; ++k) { const unsigned y = *(const unsigned*)(yb + (size_t)k * DM + c); typedef float f2_t __attribute__((ext_vector_type(2)));
            const f2_t lo = __builtin_amdgcn_cvt_pk_f32_fp8((int)y, false), hi = __builtin_amdgcn_cvt_pk_f32_fp8((int)y, true);
            v[j].x += lo.x * (1.0f / 16.0f); v[j].y += lo.y * (1.0f / 16.0f); v[j].z += hi.x * (1.0f / 16.0f); v[j].w += hi.y * (1.0f / 16.0f); }
        s += (v[j].x * v[j].x + v[j].y * v[j].y) + (v[j].z * v[j].z + v[j].w * v[j].w); }
    const float rs = 1.0f / sqrtf(wave_sum(s) * (1.0f / DM) + EPS);
#pragma unroll
    for (int j = 0; j < 8; ++j) { const int c = 4 * lane + 256 * j; const f32x4 g = *(const f32x4*)(P.g_final + c);
        __builtin_nontemporal_store((f32x4){v[j].x * rs * g.x, v[j].y * rs * g.y, v[j].z * rs * g.z, v[j].w * rs * g.w}, (f32x4*)(orow + c)); }
}
#define LAS __attribute__((address_space(3)))
#define GAS __attribute__((address_space(1)))
typedef short bf16x8 __attribute__((ext_vector_type(8)));
typedef int v4i_t __attribute__((ext_vector_type(4)));
typedef GAS unsigned gu32;
#define RLX_AGENT __ATOMIC_RELAXED, __HIP_MEMORY_SCOPE_AGENT
constexpr int NWAVES = 8;
constexpr int RING_OFF = 0, RING_BYTES = 131072;
constexpr int TAB_OFF = 133 * 1024;
constexpr int MISC_OFF = 143 * 1024;
constexpr int LDS_BYTES = 147456;

namespace pg8 {
constexpr int BM = 256, BK = 64, HALF = 128, HTB = HALF * BK * 2, NXCD = 8, WGM = 8;
__host__ __device__ __forceinline__ int lds_byte(int r, int c) { const int st = (r >> 4) * 2 + (c >> 5), rr = r & 15, cc = c & 31, ob = rr * 64 + cc * 2; return st * 1024 + (ob ^ (((ob >> 9) & 1) << 5)); }
__host__ __device__ __forceinline__ void stage_rc(int b, int& R, int& C) { const int st = b / 1024, sb = b % 1024, swz = sb ^ (((sb >> 9) & 1) << 5); R = (st >> 1) * 16 + swz / 64; C = (st & 1) * 32 + (swz % 64) / 2; }
__host__ __device__ __forceinline__ void stage_rc_f8(int b, int& R, int& Cb) { const int s = b >> 4; R = s >> 3; const int q = s & 7; Cb = 16 * (q ^ ((R >> 1) & 7)); }
__host__ __device__ __forceinline__ int perm32(int rho) { const int n = rho >> 4, i = rho & 15; return 8 * (i >> 2) + 4 * n + (i & 3); }
__host__ __device__ __forceinline__ int perm32x(int i) { return 16 * ((i >> 2) & 1) + 4 * (i >> 3) + (i & 3); }
typedef float f32x16 __attribute__((ext_vector_type(16)));
template <bool F8> struct AccSel { typedef f32x4 T[2][2][4][2]; };
template <> struct AccSel<true> { typedef f32x16 T[2][2][2]; };
struct Unit { int pm, pn, aux; };
__device__ __forceinline__ unsigned cvt_pk_bf16(float lo, float hi) { unsigned r; asm volatile("v_cvt_pk_bf16_f32 %0, %1, %2" : "=v"(r) : "v"(lo), "v"(hi)); return r; }
__device__ __forceinline__ u32x4 pack8(const f32x4& a, const f32x4& b) { u32x4 w; w.x = cvt_pk_bf16(a[0], a[1]); w.y = cvt_pk_bf16(a[2], a[3]); w.z = cvt_pk_bf16(b[0], b[1]); w.w = cvt_pk_bf16(b[2], b[3]); return w; }

struct Order2D {
    int nM, nN, nwg, G, c;
    __device__ __forceinline__ void init(int nM_, int nN_, int G_, int c_) { nM = nM_; nN = nN_; nwg = nM * nN; G = G_; c = c_; }
    __device__ __forceinline__ bool next(int i, Unit& u) const {
        const long L = (long)i * G + c; if (L >= nwg) return false;
        int wgid = (int)L; { const int q = nwg / NXCD, r = nwg % NXCD, xcd = wgid % NXCD, off = wgid / NXCD; wgid = (xcd < r ? xcd * (q + 1) : r * (q + 1) + (xcd - r) * q) + off; }
        const int nig = WGM * nN, gid = wgid / nig, fm = gid * WGM, gsz = (nM - fm) < WGM ? (nM - fm) : WGM;
        u.pm = fm + ((wgid % nig) % gsz); u.pn = (wgid % nig) / gsz; u.aux = 0; return true;
    }
};

template <class Prob, bool ALIGN_EPI>
__device__ __forceinline__ void gemm_phase(LAS unsigned char* lds, const Prob& Pb, const int tid) {
    const int wid = __builtin_amdgcn_readfirstlane(tid >> 6), lane = tid & 63, wr = wid >> 2, wc = wid & 3, fr = lane & 15, fq = lane >> 4;
    constexpr bool F8 = Prob::F8;
    const int nt = F8 ? Pb.K / 128 : Pb.K / BK;
    constexpr bool GATHER = Prob::GATHER;
    int Rr[2], Cc[2]; unsigned voffB, voffA = 0u;
    { int R, C; if (F8) stage_rc_f8(tid * 16, R, C); else { stage_rc(tid * 16, R, C); C *= 2; }
      Rr[0] = R; Rr[1] = R + 64; Cc[0] = C; Cc[1] = C; const int Rb = (R & ~31) + (F8 ? perm32x(R & 31) : perm32(R & 31)); voffB = (unsigned)(Rb * Pb.ldbB + C);
      if constexpr (!GATHER) voffA = (unsigned)(R * Pb.ldaB + C); }
    const unsigned r64B = 64u * (unsigned)Pb.ldbB, r64A = GATHER ? 0u : 64u * (unsigned)Pb.ldaB;
    const unsigned kstep = 128u;
    const unsigned hstepB = (unsigned)HALF * Pb.ldbB;
    const unsigned ldsw = (unsigned)wid * 1024u;
    const int r32 = lane & 31, g32 = lane >> 5;
    const int aoff = F8 ? (wr * 64 + r32) * 128 + (((2 * g32) ^ ((r32 >> 1) & 7)) * 16) : lds_byte(wr * 64 + fr, fq * 8);
    const int boff = F8 ? (wc * 32 + r32) * 128 + (((2 * g32) ^ ((r32 >> 1) & 7)) * 16) : lds_byte(wc * 32 + fr, fq * 8);
    const int aoff8 = aoff, boff8 = boff;
#define PG8_SA(b, h) (((b) * 2 + (h)) * HTB)
#define PG8_SB(b, h) ((4 + (b) * 2 + (h)) * HTB)
    const __amdgpu_buffer_rsrc_t rsA = __builtin_amdgcn_make_buffer_rsrc((void*)Pb.A, 0, 0x7ffffffe, 0x00020000), rsB = __builtin_amdgcn_make_buffer_rsrc((void*)Pb.Bt, 0, 0x7ffffffe, 0x00020000);
#define PG8_STAGE_B(bufoff, so) do { \
        __builtin_amdgcn_raw_ptr_buffer_load_lds(rsB, (LAS unsigned*)(lds + (bufoff) + ldsw), 16, voffB, (int)(so), 0, 0); \
        __builtin_amdgcn_raw_ptr_buffer_load_lds(rsB, (LAS unsigned*)(lds + (bufoff) + ldsw + 8192), 16, voffB, (int)((so) + r64B), 0, 0); } while (0)
#define PG8_STAGE_A(bufoff, so, h) do { if constexpr (GATHER) { \
        __builtin_amdgcn_raw_ptr_buffer_load_lds(rsA, (LAS unsigned*)(lds + (bufoff) + ldsw), 16, (h) ? ca10 : ca00, (int)(so), 0, 0); \
        __builtin_amdgcn_raw_ptr_buffer_load_lds(rsA, (LAS unsigned*)(lds + (bufoff) + ldsw + 8192), 16, (h) ? ca11 : ca01, (int)(so), 0, 0); } else { \
        __builtin_amdgcn_raw_ptr_buffer_load_lds(rsA, (LAS unsigned*)(lds + (bufoff) + ldsw), 16, voffA, (int)((so) + (h) * 2u * r64A), 0, 0); \
        __builtin_amdgcn_raw_ptr_buffer_load_lds(rsA, (LAS unsigned*)(lds + (bufoff) + ldsw + 8192), 16, voffA, (int)((so) + (h) * 2u * r64A + r64A), 0, 0); } } while (0)
#define PG8_LDA(dst, b, h) do { if constexpr (F8) { _Pragma("unroll") for (int m = 0; m < 2; ++m) _Pragma("unroll") for (int k = 0; k < 2; ++k) { dst[m * 2 + k][0] = *(const LAS bf16x8*)(lds + PG8_SA(b, h) + m * 4096 + (aoff8 ^ (k * 64))); dst[m * 2 + k][1] = *(const LAS bf16x8*)(lds + PG8_SA(b, h) + m * 4096 + (aoff8 ^ (k * 64) ^ 16)); } } \
        else { _Pragma("unroll") for (int m = 0; m < 4; ++m) _Pragma("unroll") for (int k = 0; k < 2; ++k) dst[m][k] = *(const LAS bf16x8*)(lds + PG8_SA(b, h) + aoff + m * 2048 + k * 1024); } } while (0)
#define PG8_LDB(dst, b, h) do { if constexpr (F8) { _Pragma("unroll") for (int k = 0; k < 2; ++k) { dst[k][0] = *(const LAS bf16x8*)(lds + PG8_SB(b, h) + (boff8 ^ (k * 64))); dst[k][1] = *(const LAS bf16x8*)(lds + PG8_SB(b, h) + (boff8 ^ (k * 64) ^ 16)); } } \
        else { _Pragma("unroll") for (int n = 0; n < 2; ++n) _Pragma("unroll") for (int k = 0; k < 2; ++k) dst[n][k] = *(const LAS bf16x8*)(lds + PG8_SB(b, h) + boff + n * 2048 + k * 1024); } } while (0)
#define PG8_F8FRAG(x) __builtin_shufflevector(__builtin_bit_cast(v4i_t, x[0]), __builtin_bit_cast(v4i_t, x[1]), 0, 1, 2, 3, 4, 5, 6, 7)
#define PG8_MMA(ai, bj, At, Bt) do { __builtin_amdgcn_s_setprio(1); if constexpr (F8) { _Pragma("unroll") for (int k = 0; k < 2; ++k) _Pragma("unroll") for (int m = 0; m < 2; ++m) \
        acc[ai][bj][m] = __builtin_amdgcn_mfma_scale_f32_32x32x64_f8f6f4(PG8_F8FRAG(Bt[k]), PG8_F8FRAG(At[m * 2 + k]), acc[ai][bj][m], 0, 0, 0, 0, 0, 0); }     \
        else { _Pragma("unroll") for (int m = 0; m < 4; ++m) _Pragma("unroll") for (int n = 0; n < 2; ++n) _Pragma("unroll") for (int k = 0; k < 2; ++k) \
        acc[ai][bj][m][n] = __builtin_amdgcn_mfma_f32_16x16x32_bf16(Bt[n][k], At[m][k], acc[ai][bj][m][n], 0, 0, 0); } __builtin_amdgcn_s_setprio(0); } while (0)
#define PG8_WAIT_V(n) asm volatile("s_waitcnt vmcnt(" #n ")" ::: "memory")
#define PG8_WAIT_L(n) asm volatile("s_waitcnt lgkmcnt(" #n ")" ::: "memory")
#define PG8_BAR __builtin_amdgcn_s_barrier()
#define PG8_SCHED __builtin_amdgcn_sched_barrier(0)
    Unit cur, nxt; int ui = 0;
    if (!Pb.next(0, cur)) return;
    const unsigned ktm = (unsigned)nt - 1u;
    unsigned rc = Pb.rot(cur), rn = 0u;
    typename AccSel<F8>::T acc;
#define PG8_ZERO_ACC do { if constexpr (F8) { _Pragma("unroll") for (int a = 0; a < 2; ++a) _Pragma("unroll") for (int b = 0; b < 2; ++b) _Pragma("unroll") for (int m = 0; m < 2; ++m) _Pragma("unroll") for (int n = 0; n < 16; ++n) acc[a][b][m][n] = 0.f; } \
        else { _Pragma("unroll") for (int a = 0; a < 2; ++a) _Pragma("unroll") for (int b = 0; b < 2; ++b) _Pragma("unroll") for (int m = 0; m < 4; ++m) _Pragma("unroll") for (int n = 0; n < 2; ++n) acc[a][b][m][n] = (f32x4){0.f, 0.f, 0.f, 0.f}; } } while (0)
    PG8_ZERO_ACC;
    bf16x8 At[4][2], B0[2][2], B1[2][2];
    unsigned ca00 = 0, ca01 = 0, ca10 = 0, ca11 = 0;
    unsigned cA, nA;
    if constexpr (GATHER) { Pb.a_fetch(cur, lds, wid); asm volatile("s_waitcnt vmcnt(0)" ::: "memory"); __builtin_amdgcn_s_barrier(); }
    Pb.e_fetch(cur, lds, wid, 0);
    { unsigned o[2][2]; Pb.a_addr(cur, Rr, Cc, o, cA, lds); ca00 = o[0][0]; ca01 = o[0][1]; ca10 = o[1][0]; ca11 = o[1][1]; }
    unsigned cB = Pb.b_base(cur);
    { const unsigned k0 = (rc & ktm) * kstep;
    PG8_STAGE_B(PG8_SB(0, 0), cB + k0); PG8_STAGE_B(PG8_SB(0, 1), cB + k0 + hstepB); PG8_STAGE_A(PG8_SA(0, 0), cA + k0, 0); PG8_STAGE_A(PG8_SA(0, 1), cA + k0, 1);
    if (wr == 1) PG8_BAR;
    PG8_WAIT_V(2); PG8_BAR;
    PG8_STAGE_B(PG8_SB(1, 0), cB + k0 + kstep); PG8_STAGE_A(PG8_SA(1, 0), cA + k0 + kstep, 0); PG8_STAGE_B(PG8_SB(1, 1), cB + k0 + hstepB + kstep); }
    PG8_WAIT_V(6); PG8_BAR;
    for (;;) {
        const bool has_next = Pb.next(ui + 1, nxt);
        unsigned nB;
        if (has_next) { if constexpr (GATHER) Pb.a_fetch(nxt, lds, wid); else { unsigned o[2][2]; Pb.a_addr(nxt, Rr, Cc, o, nA, lds); } nB = Pb.b_base(nxt); rn = Pb.rot(nxt); }
        else { nA = cA; nB = cB; rn = rc; }
        for (int t = 0; t < nt; t += 2) {
            const bool last = (t == nt - 2);
            const unsigned a1 = cA + (((unsigned)(t + 1) + rc) & ktm) * kstep;
            PG8_LDB(B0, 0, 0); PG8_LDB(B1, 0, 1); PG8_SCHED; PG8_LDA(At, 0, 0); PG8_STAGE_A(PG8_SA(1, 1), a1, 1);
            PG8_WAIT_V(8); PG8_WAIT_L(0); PG8_BAR; PG8_MMA(0, 0, At, B0); PG8_MMA(0, 1, At, B1); PG8_BAR; PG8_SCHED;
            const unsigned k2 = last ? (rn & ktm) * kstep : (((unsigned)(t + 2) + rc) & ktm) * kstep;
            const unsigned a2 = (last ? nA : cA) + k2, b2 = (last ? nB : cB) + k2;
            const unsigned a3 = a2 + kstep, b3 = b2 + kstep;
            if constexpr (GATHER) { if (last && has_next) { unsigned o[2][2]; Pb.a_addr(nxt, Rr, Cc, o, nA, lds); ca00 = o[0][0]; ca01 = o[0][1]; ca10 = o[1][0]; ca11 = o[1][1]; } }
            PG8_LDA(At, 0, 1); PG8_STAGE_B(PG8_SB(0, 0), b2); PG8_STAGE_B(PG8_SB(0, 1), b2 + hstepB); PG8_STAGE_A(PG8_SA(0, 0), a2, 0);
            PG8_WAIT_V(8); PG8_WAIT_L(0); PG8_BAR; PG8_MMA(1, 0, At, B0); PG8_MMA(1, 1, At, B1); PG8_BAR; PG8_SCHED;
            PG8_LDB(B0, 1, 0); PG8_LDB(B1, 1, 1); PG8_SCHED; PG8_LDA(At, 1, 0); PG8_STAGE_A(PG8_SA(0, 1), a2, 1);
            PG8_WAIT_V(8); PG8_WAIT_L(0); PG8_BAR; PG8_MMA(0, 0, At, B0); PG8_MMA(0, 1, At, B1); PG8_BAR; PG8_SCHED;
            PG8_LDA(At, 1, 1); PG8_STAGE_B(PG8_SB(1, 0), b3); PG8_STAGE_B(PG8_SB(1, 1), b3 + hstepB); PG8_STAGE_A(PG8_SA(1, 0), a3, 0);
            PG8_WAIT_V(8); PG8_WAIT_L(0); PG8_BAR; PG8_MMA(1, 0, At, B0); PG8_MMA(1, 1, At, B1); PG8_BAR; PG8_SCHED;
        }
        if constexpr (ALIGN_EPI) { if (wr == 0) PG8_BAR; }
        { int tl = tid; asm volatile("" : "+v"(tl));
          const int ln = tl & 63; if constexpr (F8) Pb.epi(acc, cur, wr, wc, ln & 31, ln >> 5, lds + (ui & 1) * 3072); else Pb.epi(acc, cur, wr, wc, ln & 15, ln >> 4, lds + (ui & 1) * 3072); }
        if (!has_next) break;
        PG8_ZERO_ACC;
        if constexpr (F8) { _Pragma("unroll") for (int a = 0; a < 2; ++a) _Pragma("unroll") for (int b = 0; b < 2; ++b) asm volatile("" : "+v"(acc[a][b][0]), "+v"(acc[a][b][1])); }
        else { _Pragma("unroll") for (int a = 0; a < 2; ++a) _Pragma("unroll") for (int b = 0; b < 2; ++b) _Pragma("unroll") for (int m = 0; m < 4; ++m) asm volatile("" : "+v"(acc[a][b][m][0]), "+v"(acc[a][b][m][1])); }
        cur = nxt; cA = nA; cB = nB; rc = rn; ++ui;
        Pb.e_fetch(cur, lds, wid, ui & 1);
        if constexpr (ALIGN_EPI) { if (wr == 1) PG8_BAR; }
    }
    PG8_WAIT_V(0);
    if constexpr (!ALIGN_EPI) { if (wr == 0) PG8_BAR; }
    PG8_BAR;
#undef PG8_SA
#undef PG8_SB
#undef PG8_STAGE_A
#undef PG8_STAGE_B
#undef PG8_LDA
#undef PG8_LDB
#undef PG8_MMA
#undef PG8_F8FRAG
#undef PG8_ZERO_ACC
#undef PG8_WAIT_V
#undef PG8_WAIT_L
#undef PG8_BAR
#undef PG8_SCHED
}
}
namespace pg8 {
#define PG8_EPI_LOOP for (int ai = 0; ai < 2; ++ai) _Pragma("unroll") for (int m = 0; m < 4; ++m) _Pragma("unroll") for (int bj = 0; bj < 2; ++bj)
__device__ __forceinline__ void rope4(const float* rope, int pos, int i0, f32x4& a, f32x4& b) {
    const f32x4 c = *(const f32x4*)(rope + pos * 32 + i0), s = *(const f32x4*)(rope + LSEQ * 32 + pos * 32 + i0);
    const f32x4 r0 = {a[0] * c[0] - a[1] * s[0], a[1] * c[0] + a[0] * s[0], a[2] * c[1] - a[3] * s[1], a[3] * c[1] + a[2] * s[1]};
    const f32x4 r1 = {b[0] * c[2] - b[1] * s[2], b[1] * c[2] + b[0] * s[2], b[2] * c[3] - b[3] * s[3], b[3] * c[3] + b[2] * s[3]};
    a = r0; b = r1;
}
__device__ __forceinline__ float clamp448(float v) { return __builtin_amdgcn_fmed3f(v, -448.0f, 448.0f); }
__device__ __forceinline__ unsigned pack4_f8(float a, float b, float c, float d) { int w = 0; w = __builtin_amdgcn_cvt_pk_fp8_f32(clamp448(a), clamp448(b), w, false); w = __builtin_amdgcn_cvt_pk_fp8_f32(clamp448(c), clamp448(d), w, true); return (unsigned)w; }
__device__ __forceinline__ unsigned long long pack8_f8(const f32x4& a, const f32x4& b) { return (unsigned long long)pack4_f8(a[0], a[1], a[2], a[3]) | ((unsigned long long)pack4_f8(b[0], b[1], b[2], b[3]) << 32); }
struct DenseBase {
    static constexpr bool F8 = false, GATHER = false; static constexpr int scaleA = 0, scaleB = 0;
    const char* A; const char* Bt; int K, lda, ldb, ldaB, ldbB; Order2D ord;
    __device__ __forceinline__ bool next(int i, Unit& u) const { return ord.next(i, u); }
    __device__ __forceinline__ unsigned rot(const Unit&) const { return 0u; }
    __device__ __forceinline__ void e_fetch(const Unit&, LAS unsigned char*, int, int) const {}
    __device__ __forceinline__ void a_addr(const Unit& u, const int (&Rr)[2], const int (&Cc)[2], unsigned (&o)[2][2], unsigned& base, LAS unsigned char*) const {
        base = (unsigned)u.pm * 256u * (unsigned)lda * 2u;
#pragma unroll
        for (int h = 0; h < 2; ++h)
#pragma unroll
            for (int i = 0; i < 2; ++i) o[h][i] = (unsigned)((h * 128 + Rr[i]) * lda * 2 + Cc[i]);
    }
    __device__ __forceinline__ unsigned b_base(const Unit& u) const { return (unsigned)u.pn * 256u * (unsigned)ldb * 2u; }
};
struct ProbP1 : DenseBase {
    bf16_t* proj; bf16_t* kr; const float* rope; float* ssqp;
    __device__ __forceinline__ void epi(const f32x4 (&acc)[2][2][4][2], const Unit& u, int wr, int wc, int fr, int fq, LAS unsigned char*) const {
        float ssq_acc[2][4];
#pragma unroll
        for (int a = 0; a < 2; ++a)
#pragma unroll
            for (int b = 0; b < 4; ++b) ssq_acc[a][b] = 0.f;
#pragma unroll
        PG8_EPI_LOOP {
            const int row = u.pm * 256 + ai * 128 + wr * 64 + m * 16 + fr, col = u.pn * 256 + bj * 128 + wc * 32 + fq * 8;
            f32x4 v0 = acc[ai][bj][m][0], v1 = acc[ai][bj][m][1];
            if (u.pn >= 4 && u.pn < 7) { const float q = (v0[0] * v0[0] + v0[1] * v0[1]) + (v0[2] * v0[2] + v0[3] * v0[3]) + (v1[0] * v1[0] + v1[1] * v1[1]) + (v1[2] * v1[2] + v1[3] * v1[3]);
                ssq_acc[ai][m] += q; }
            if (col < 1792) { *(u32x4*)(proj + (size_t)row * DM + col) = pack8(v0, v1); }
            else if (col < INW) { const int pos = (row % LP) - PADR;
                if (pos >= 0) rope4(rope, pos, (col - 1792) >> 1, v0, v1); else { v0 = (f32x4){0.f, 0.f, 0.f, 0.f}; v1 = v0; }
                *(u32x4*)(kr + (size_t)row * 64 + (col - 1792)) = pack8(v0, v1); }
        }
        if (u.pn >= 4 && u.pn < 7) {
            const int slot = u.pn < 6 ? (u.pn - 4) * 4 + wc : 8 + wc;
#pragma unroll
            for (int ai = 0; ai < 2; ++ai)
#pragma unroll
                for (int m = 0; m < 4; ++m) { float q = ssq_acc[ai][m]; q += __shfl_xor(q, 16); q += __shfl_xor(q, 32);
                    if (fq == 0) ssqp[(size_t)(u.pm * 256 + ai * 128 + wr * 64 + m * 16 + fr) * 12 + slot] = q; }
        }
    }
};
struct ProbP2q : DenseBase {
    bf16_t* qb; const float* rsq; const float* rope;
    __device__ __forceinline__ void epi(const f32x4 (&acc)[2][2][4][2], const Unit& u, int wr, int wc, int fr, int fq, LAS unsigned char*) const {
        float rsv[2][4];
#pragma unroll
        for (int ai = 0; ai < 2; ++ai)
#pragma unroll
            for (int m = 0; m < 4; ++m) { const float* pp = rsq + (size_t)(u.pm * 256 + ai * 128 + wr * 64 + m * 16 + fr) * 12; const f32x4 a = *(const f32x4*)pp, b = *(const f32x4*)(pp + 4);
                rsv[ai][m] = C2 / sqrtf(((a[0] + a[1]) + (a[2] + a[3]) + (b[0] + b[1]) + (b[2] + b[3])) * (1.0f / QLORA) + EPS); }
#pragma unroll
        PG8_EPI_LOOP {
            const int row = u.pm * 256 + ai * 128 + wr * 64 + m * 16 + fr, col = u.pn * 256 + bj * 128 + wc * 32 + fq * 8;
            const float s = rsv[ai][m]; f32x4 v0 = acc[ai][bj][m][0] * s, v1 = acc[ai][bj][m][1] * s;
            const int dd = col % QKD;
            if (dd >= QKNOPE) { const int pos = (row % LP) - PADR; if (pos >= 0) rope4(rope, pos, (dd - QKNOPE) >> 1, v0, v1); else { v0 = (f32x4){0.f, 0.f, 0.f, 0.f}; v1 = v0; } }
            *(u32x4*)(qb + (size_t)row * 1536 + col) = pack8(v0, v1);
        }
    }
};
struct ProbP2kv : DenseBase {
    bf16_t* kn; bf16_t* vb; const float* rskv;
    __device__ __forceinline__ void epi(const f32x4 (&acc)[2][2][4][2], const Unit& u, int wr, int wc, int fr, int fq, LAS unsigned char*) const {
#pragma unroll
        PG8_EPI_LOOP {
            const int row = u.pm * 256 + ai * 128 + wr * 64 + m * 16 + fr, c = wc * 32 + fq * 8;
            const f32x4 pk = *(const f32x4*)(rskv + (size_t)row * 12 + 8); const float s = 1.0f / sqrtf(((pk[0] + pk[1]) + (pk[2] + pk[3])) * (1.0f / KVLORA) + EPS); const f32x4 v0 = acc[ai][bj][m][0] * s, v1 = acc[ai][bj][m][1] * s;
            bf16_t* dst = (bj == 0 ? kn : vb) + (size_t)row * 1024 + u.pn * 128 + c;
            *(u32x4*)dst = pack8(v0, v1);
        }
    }
};
struct ProbPool : DenseBase {
    bf16_t* mix; const float* pscale;
    __device__ __forceinline__ void a_addr(const Unit& u, const int (&Rr)[2], const int (&Cc)[2], unsigned (&o)[2][2], unsigned& base, LAS unsigned char*) const {
        base = ((unsigned)u.pm * 256u * (unsigned)lda + (unsigned)u.pn * 256u) * 2u;
#pragma unroll
        for (int h = 0; h < 2; ++h)
#pragma unroll
            for (int i = 0; i < 2; ++i) o[h][i] = (unsigned)((h * 128 + Rr[i]) * lda * 2 + Cc[i]);
    }
    __device__ __forceinline__ unsigned b_base(const Unit& u) const { return (unsigned)u.pn * 65536u * 2u; }
    __device__ __forceinline__ void epi(const f32x4 (&acc)[2][2][4][2], const Unit& u, int wr, int wc, int fr, int fq, LAS unsigned char*) const {
#pragma unroll
        PG8_EPI_LOOP {
            const int row = u.pm * 256 + ai * 128 + wr * 64 + m * 16 + fr, c = u.pn * 256 + bj * 128 + wc * 32 + fq * 8;
            const f32x4 p0 = *(const f32x4*)(pscale + c), p1 = *(const f32x4*)(pscale + c + 4);
            *(u32x4*)(mix + (size_t)row * DM + c) = pack8(acc[ai][bj][m][0] * p0, acc[ai][bj][m][1] * p1);
        }
    }
};
struct ProbP4 : DenseBase {
    const float* x; bf16_t* h2; unsigned char* h2f8;
    __device__ __forceinline__ void a_addr(const Unit& u, const int (&Rr)[2], const int (&Cc)[2], unsigned (&o)[2][2], unsigned& base, LAS unsigned char*) const {
        base = (unsigned)((u.pm >> 3) * LP + 64 + (u.pm & 7) * 256) * (unsigned)lda * 2u;
#pragma unroll
        for (int h = 0; h < 2; ++h)
#pragma unroll
            for (int i = 0; i < 2; ++i) o[h][i] = (unsigned)((h * 128 + Rr[i]) * lda * 2 + Cc[i]);
    }
    __device__ __forceinline__ void epi(const f32x4 (&acc)[2][2][4][2], const Unit& u, int wr, int wc, int fr, int fq, LAS unsigned char*) const {
#pragma unroll
        PG8_EPI_LOOP {
            const int r = u.pm * 256 + ai * 128 + wr * 64 + m * 16 + fr, c = u.pn * 256 + bj * 128 + wc * 32 + fq * 8;
            const size_t off = (size_t)r * DM + c;
            const f32x4 o0 = *(const f32x4*)(x + off) + acc[ai][bj][m][0], o1 = *(const f32x4*)(x + off + 4) + acc[ai][bj][m][1];
            *(u32x4*)(h2 + off) = pack8(o0, o1); *(unsigned long long*)(h2f8 + off) = pack8_f8(o0, o1);
        }
    }
};
}
namespace pg8 {
constexpr int TB_CNT = 64, TB_TE = 128, TB_TM = 416, TB_LIST = 768, TB_E0 = 1024, TB_E1 = 1280, TB_E2 = 1536;
__device__ __forceinline__ void moe_table(LAS unsigned char* lds, const unsigned* cnt, const int tid) {
    LAS int* tab = (LAS int*)(lds + TAB_OFF);
    __syncthreads();
    if (tid < NE) tab[TB_CNT + tid] = (int)__hip_atomic_load(cnt + tid, RLX_AGENT);
    __syncthreads();
    if (tid == 0) { int s = 0; for (int e = 0; e < NE; ++e) { tab[e] = s; s += (tab[TB_CNT + e] + 255) >> 8; } tab[NE] = s; }
    __syncthreads();
    if (tid < 288) { int e = 0; for (; e < NE - 1; ++e) if (tid < tab[e + 1]) break; tab[TB_TE + tid] = e; tab[TB_TM + tid] = tid - tab[e]; }
    __syncthreads();
}
#ifndef MOE_BT
#define MOE_BT 8
#endif
template <int NTN> struct MoeOrder {
    const LAS int* tab; int G, c, i0, i1;
    __device__ __forceinline__ bool next(int i_, Unit& u) const {
        const int i = i0 + i_; if (i >= i1) return false;
        const int cpx = G >> 3; const int F = (G & 7) ? i * G + c : (i * 8 + (c & 7)) * cpx + (c >> 3);
        const int ntile = __builtin_amdgcn_readfirstlane(tab[NE]); if (F >= ntile * NTN) return false;
        constexpr int BT = MOE_BT, PG = 32 / BT;
        const int blk = F / (BT * NTN), r = F - blk * (BT * NTN), nb = (ntile - blk * BT) < BT ? (ntile - blk * BT) : BT;
        int png, rr; if (nb == BT) { png = r / 32; rr = r & 31; } else { const int gs = nb * PG; png = r / gs; rr = r - png * gs; }
        const int T = blk * BT + rr / PG;
        u.aux = __builtin_amdgcn_readfirstlane(tab[TB_TE + T]); u.pm = __builtin_amdgcn_readfirstlane(tab[TB_TM + T]); u.pn = png * PG + (rr % PG); return true;
    }
};
constexpr int W_SCALE_LOG2 = 5, ACT_SCALE_LOG2 = 2, YB_SCALE_LOG2 = 4;
struct ProbP6 {
    static constexpr bool F8 = true, GATHER = true; static constexpr int ldaB = DM; static constexpr int scaleB = 0x01010101 * (127 - W_SCALE_LOG2), scaleA = 0x7f7f7f7f;
    const char* A; const char* Bt; int K, ldbB; MoeOrder<16> ord;
    const int* list; const float* rsl; const float* b1; unsigned char* act;
    __device__ __forceinline__ bool next(int i, Unit& u) const { return ord.next(i, u); }
    __device__ __forceinline__ unsigned rot(const Unit& u) const { return 0u; }
    __device__ __forceinline__ void a_fetch(const Unit& u, LAS unsigned char* lds, int wid) const {
        if (wid == 0) { const __amdgpu_buffer_rsrc_t rl = __builtin_amdgcn_make_buffer_rsrc((void*)list, 0, 0x7ffffffe, 0x00020000);
            __builtin_amdgcn_raw_ptr_buffer_load_lds(rl, (LAS unsigned*)(lds + TAB_OFF + TB_LIST * 4), 16, (threadIdx.x & 63) * 16, (int)(((unsigned)u.aux * (unsigned)MR + (unsigned)u.pm * 256u) * 4u), 0, 0); }
    }
    __device__ __forceinline__ void a_addr(const Unit& u, const int (&Rr)[2], const int (&Cc)[2], unsigned (&o)[2][2], unsigned& base, LAS unsigned char* lds) const {
        base = 0u; const int cnt_e = __builtin_amdgcn_readfirstlane(ord.tab[TB_CNT + u.aux]); const LAS int* lb = (const LAS int*)(lds + TAB_OFF) + TB_LIST; const int lastv = cnt_e - 1 - u.pm * 256;
#pragma unroll
        for (int h = 0; h < 2; ++h)
#pragma unroll
            for (int i = 0; i < 2; ++i) { int sl = h * 128 + Rr[i]; sl = sl < lastv ? sl : lastv; const int tok = lb[sl] >> 2; o[h][i] = (unsigned)tok * (unsigned)DM + (unsigned)Cc[i]; }
    }
    __device__ __forceinline__ void e_fetch(const Unit& u, LAS unsigned char* lds, int wid, int par) const {
        lds += par * 3072;
        if (wid == 1) { const __amdgpu_buffer_rsrc_t r = __builtin_amdgcn_make_buffer_rsrc((void*)rsl, 0, 0x7ffffffe, 0x00020000);
            __builtin_amdgcn_raw_ptr_buffer_load_lds(r, (LAS unsigned*)(lds + TAB_OFF + TB_E0 * 4), 16, (threadIdx.x & 63) * 16, (int)(((unsigned)u.aux * (unsigned)MR + (unsigned)u.pm * 256u) * 4u), 0, 0); }
        if (wid == 2) { const __amdgpu_buffer_rsrc_t r = __builtin_amdgcn_make_buffer_rsrc((void*)b1, 0, 0x7ffffffe, 0x00020000);
            __builtin_amdgcn_raw_ptr_buffer_load_lds(r, (LAS unsigned*)(lds + TAB_OFF + TB_E1 * 4), 16, (threadIdx.x & 63) * 16, (int)(((unsigned)u.aux * 4096u + (unsigned)u.pn * 256u) * 4u), 0, 0); }
    }
    __device__ __forceinline__ unsigned b_base(const Unit& u) const { return ((unsigned)u.aux * 4096u + (unsigned)u.pn * 256u) * (unsigned)DM; }
    __device__ __forceinline__ void epi(const f32x16 (&acc)[2][2][2], const Unit& u, int wr, int wc, int r32, int hi, LAS unsigned char* lds) const {
        const LAS float* rsb = (const LAS float*)(lds + TAB_OFF) + TB_E0; const LAS float* bb1 = (const LAS float*)(lds + TAB_OFF) + TB_E1;
        const int cnt_e = __builtin_amdgcn_readfirstlane(ord.tab[TB_CNT + u.aux]), rbase = __builtin_amdgcn_readfirstlane(ord.tab[u.aux]) * 256;
        constexpr float AS = (float)(1 << ACT_SCALE_LOG2), NC = -1.702f * 1.4426950408889634f;
#pragma unroll
        for (int bj = 0; bj < 2; ++bj) {
            f32x4 bg[2], bl[2];
#pragma unroll
            for (int h = 0; h < 2; ++h) { const LAS float* bp = bb1 + bj * 128 + wc * 32 + hi * 16 + h * 8; const f32x4 x0 = *(const LAS f32x4*)bp, x1 = *(const LAS f32x4*)(bp + 4);
                bg[h] = (f32x4){x0[0], x0[2], x1[0], x1[2]}; bl[h] = (f32x4){x0[1], x0[3], x1[1], x1[3]}; }
#pragma unroll
            for (int ai = 0; ai < 2; ++ai)
#pragma unroll
                for (int m = 0; m < 2; ++m) {
                    const int slot = u.pm * 256 + ai * 128 + wr * 64 + m * 32 + r32; const bool valid = slot < cnt_e;
                    const float rs = valid ? rsb[ai * 128 + wr * 64 + m * 32 + r32] * (1.0f / (float)(1 << W_SCALE_LOG2)) : 0.f;
                    const f32x16 a = acc[ai][bj][m];
                    unsigned w2[2];
#pragma unroll
                    for (int h = 0; h < 2; ++h) {
                        f32x4 g = (f32x4){a[8 * h + 0], a[8 * h + 2], a[8 * h + 4], a[8 * h + 6]} * rs + bg[h], l = (f32x4){a[8 * h + 1], a[8 * h + 3], a[8 * h + 5], a[8 * h + 7]} * rs + bl[h];
#pragma unroll
                        for (int q = 0; q < 4; ++q) { g[q] = fminf(g[q], 7.0f); l[q] = __builtin_amdgcn_fmed3f(l[q], -7.0f, 7.0f); }
                        f32x4 e = g * NC, lp = l * AS + AS;
#pragma unroll
                        for (int q = 0; q < 4; ++q) e[q] = __builtin_amdgcn_rcpf(1.0f + __builtin_amdgcn_exp2f(e[q]));
                        const f32x4 o = (g * e) * lp;
                        int w = 0; w = __builtin_amdgcn_cvt_pk_fp8_f32(o[0], o[1], w, false); w = __builtin_amdgcn_cvt_pk_fp8_f32(o[2], o[3], w, true); w2[h] = (unsigned)w;
                    }
                    if (valid) *(unsigned long long*)(act + (size_t)(rbase + slot) * DFF + u.pn * 128 + bj * 64 + wc * 16 + hi * 8) = (unsigned long long)w2[0] | ((unsigned long long)w2[1] << 32);
                }
        }
    }
};
struct ProbP7 {
    static constexpr bool F8 = true, GATHER = false; static constexpr int ldaB = DFF; static constexpr int scaleB = 0x01010101 * (127 - W_SCALE_LOG2), scaleA = 0x01010101 * (127 - ACT_SCALE_LOG2);
    const char* A; const char* Bt; int K, ldbB; MoeOrder<8> ord;
    const int* list; const float* gate; const float* b2; unsigned char* yb;
    __device__ __forceinline__ bool next(int i, Unit& u) const { return ord.next(i, u); }
    __device__ __forceinline__ unsigned rot(const Unit& u) const { return 0u; }
    __device__ __forceinline__ void a_addr(const Unit& u, const int (&Rr)[2], const int (&Cc)[2], unsigned (&o)[2][2], unsigned& base, LAS unsigned char*) const {
        base = (unsigned)(__builtin_amdgcn_readfirstlane(ord.tab[u.aux]) + u.pm) * 256u * (unsigned)DFF;
#pragma unroll
        for (int h = 0; h < 2; ++h)
#pragma unroll
            for (int i = 0; i < 2; ++i) o[h][i] = (unsigned)((h * 128 + Rr[i]) * DFF + Cc[i]);
    }
    __device__ __forceinline__ void e_fetch(const Unit& u, LAS unsigned char* lds, int wid, int par) const {
        lds += par * 3072;
        const int so = (int)(((unsigned)u.aux * (unsigned)MR + (unsigned)u.pm * 256u) * 4u);
        if (wid == 1) { const __amdgpu_buffer_rsrc_t r = __builtin_amdgcn_make_buffer_rsrc((void*)gate, 0, 0x7ffffffe, 0x00020000);
            __builtin_amdgcn_raw_ptr_buffer_load_lds(r, (LAS unsigned*)(lds + TAB_OFF + TB_E0 * 4), 16, (threadIdx.x & 63) * 16, so, 0, 0); }
        if (wid == 2) { const __amdgpu_buffer_rsrc_t r = __builtin_amdgcn_make_buffer_rsrc((void*)b2, 0, 0x7ffffffe, 0x00020000);
            __builtin_amdgcn_raw_ptr_buffer_load_lds(r, (LAS unsigned*)(lds + TAB_OFF + TB_E1 * 4), 16, (threadIdx.x & 63) * 16, (int)(((unsigned)u.aux * (unsigned)DM + (unsigned)u.pn * 256u) * 4u), 0, 0); }
        if (wid == 3) { const __amdgpu_buffer_rsrc_t r = __builtin_amdgcn_make_buffer_rsrc((void*)list, 0, 0x7ffffffe, 0x00020000);
            __builtin_amdgcn_raw_ptr_buffer_load_lds(r, (LAS unsigned*)(lds + TAB_OFF + TB_E2 * 4), 16, (threadIdx.x & 63) * 16, so, 0, 0); }
    }
    __device__ __forceinline__ unsigned b_base(const Unit& u) const { return ((unsigned)u.aux * (unsigned)DM + (unsigned)u.pn * 256u) * (unsigned)DFF; }
    __device__ __forceinline__ void epi(const f32x16 (&acc)[2][2][2], const Unit& u, int wr, int wc, int r32, int hi, LAS unsigned char* lds) const {
        const int cnt_e = __builtin_amdgcn_readfirstlane(ord.tab[TB_CNT + u.aux]);
        const LAS float* gtb = (const LAS float*)(lds + TAB_OFF) + TB_E0; const LAS float* bb2 = (const LAS float*)(lds + TAB_OFF) + TB_E1; const LAS int* idb = (const LAS int*)(lds + TAB_OFF) + TB_E2;
        const int col = u.pn * 256 + wc * 32 + hi * 16;
        typedef unsigned long long u64x2 __attribute__((ext_vector_type(2)));
#pragma unroll
        for (int bj = 0; bj < 2; ++bj) {
            f32x4 bb[4];
#pragma unroll
            for (int q = 0; q < 4; ++q) bb[q] = *(const LAS f32x4*)(bb2 + bj * 128 + wc * 32 + hi * 16 + q * 4);
#pragma unroll
            for (int ai = 0; ai < 2; ++ai)
#pragma unroll
                for (int m = 0; m < 2; ++m) {
                    const int rl = ai * 128 + wr * 64 + m * 32 + r32, slot = u.pm * 256 + rl; const bool valid = slot < cnt_e;
                    const int id = valid ? idb[rl] : 0; const float g = valid ? gtb[rl] : 0.f, gs = g * (1.0f / (float)(1 << (W_SCALE_LOG2 + ACT_SCALE_LOG2)));
                    const f32x16 a = acc[ai][bj][m];
                    f32x4 y[4];
#pragma unroll
                    for (int q = 0; q < 4; ++q) y[q] = ((f32x4){a[4 * q], a[4 * q + 1], a[4 * q + 2], a[4 * q + 3]} * gs + bb[q] * g) * (float)(1 << YB_SCALE_LOG2);
                    if (valid) { u64x2 w; w.x = pack8_f8(y[0], y[1]); w.y = pack8_f8(y[2], y[3]); *(u64x2*)(yb + (size_t)id * DM + col + bj * 128) = w; }
                }
        }
    }
};
}
namespace att {
using f32x16 = __attribute__((ext_vector_type(16))) float;
using s16x4 = __attribute__((ext_vector_type(4))) short;
constexpr int SHM_V = 16384, SHM_KN = 16384, SHM_KR = 8192, SHM_BUF = SHM_V + SHM_KN + SHM_KR, NBUF = 3, WS_OFF = NBUF * SHM_BUF;
#define ATT_SBAR() __builtin_amdgcn_sched_barrier(0)
__device__ __forceinline__ int crow(int r, int hi) { return (r & 3) + 8 * (r >> 2) + 4 * hi; }
__device__ __forceinline__ unsigned cvtpk(float lo, float hi) { unsigned r; asm volatile("v_cvt_pk_bf16_f32 %0, %1, %2" : "=v"(r) : "v"(lo), "v"(hi)); return r; }
__device__ __forceinline__ int v_st(int k, int c) { const int kk = (k & ~0xC) | ((k & 4) << 1) | ((k & 8) >> 1); return ((kk >> 3) * 4 + (c >> 5)) * 512 + ((kk & 7) * 32 + (c & 31)) * 2; }
__device__ __forceinline__ int v_rd_base(int lane) { return ((lane & 3) << 3) | (((lane >> 2) & 3) << 6) | (((lane >> 4) & 1) << 5) | (((lane >> 5) & 1) << 8); }
constexpr int v_rd_off(int d0, int ks, int half) { return d0 * 512 + ks * 4096 + half * 2048; }
template <int OFF> __device__ __forceinline__ s16x4 tr_read(int vb) { s16x4 r; asm volatile("ds_read_b64_tr_b16 %0, %1 offset:%2" : "=&v"(r) : "v"(vb), "i"(OFF) : "memory"); return r; }
template <int D0> __device__ __forceinline__ void pv_one(f32x16& od, int vb, bf16x8 pa0, bf16x8 pa1, bf16x8 pa2, bf16x8 pa3) {
    const s16x4 l0 = tr_read<v_rd_off(D0, 0, 0)>(vb), h0 = tr_read<v_rd_off(D0, 0, 1)>(vb), l1 = tr_read<v_rd_off(D0, 1, 0)>(vb), h1 = tr_read<v_rd_off(D0, 1, 1)>(vb);
    const s16x4 l2 = tr_read<v_rd_off(D0, 2, 0)>(vb), h2 = tr_read<v_rd_off(D0, 2, 1)>(vb), l3 = tr_read<v_rd_off(D0, 3, 0)>(vb), h3 = tr_read<v_rd_off(D0, 3, 1)>(vb);
    asm volatile("s_waitcnt lgkmcnt(0)" ::: "memory"); ATT_SBAR();
#define ATT_PK(L, H) (bf16x8){L[0], L[1], L[2], L[3], H[0], H[1], H[2], H[3]}
    od = __builtin_amdgcn_mfma_f32_32x32x16_bf16(pa0, ATT_PK(l0, h0), od, 0, 0, 0);
    od = __builtin_amdgcn_mfma_f32_32x32x16_bf16(pa1, ATT_PK(l1, h1), od, 0, 0, 0);
    od = __builtin_amdgcn_mfma_f32_32x32x16_bf16(pa2, ATT_PK(l2, h2), od, 0, 0, 0);
    od = __builtin_amdgcn_mfma_f32_32x32x16_bf16(pa3, ATT_PK(l3, h3), od, 0, 0, 0);
#undef ATT_PK
}
template <int D0, int HK> __device__ __forceinline__ void pv_half(f32x16& od, int vb, bf16x8 pa0, bf16x8 pa1) {
    const s16x4 l0 = tr_read<v_rd_off(D0, 2 * HK, 0)>(vb), h0 = tr_read<v_rd_off(D0, 2 * HK, 1)>(vb), l1 = tr_read<v_rd_off(D0, 2 * HK + 1, 0)>(vb), h1 = tr_read<v_rd_off(D0, 2 * HK + 1, 1)>(vb);
    asm volatile("s_waitcnt lgkmcnt(0)" ::: "memory"); ATT_SBAR();
#define ATT_PK(L, H) (bf16x8){L[0], L[1], L[2], L[3], H[0], H[1], H[2], H[3]}
    od = __builtin_amdgcn_mfma_f32_32x32x16_bf16(pa0, ATT_PK(l0, h0), od, 0, 0, 0);
    od = __builtin_amdgcn_mfma_f32_32x32x16_bf16(pa1, ATT_PK(l1, h1), od, 0, 0, 0);
#undef ATT_PK
}
__device__ __forceinline__ void attn_unit(int b, int h, int u, const bf16_t* __restrict__ QB, const bf16_t* __restrict__ KN, const bf16_t* __restrict__ KR, const bf16_t* __restrict__ VB,
                                          bf16_t* __restrict__ MIX, LAS char* lds, const int tid) {
    const int wid = tid >> 6, lane = tid & 63, r32 = lane & 31, hi = lane >> 5;
    const int qc = (0x22331100u >> (4 * wid)) & 3, half = wid & 1;
    const int c0 = 4 * u - 3, ntw = c0 + qc + 1, ntmax = 4 * u + 1;
    const size_t rowb = (size_t)b * LP;
    const int qrow0 = 64 * (c0 + qc) + 32 * half;
    LAS float* wsf = (LAS float*)(lds + WS_OFF) + wid * 64; LAS float* li_l = wsf; LAS float* al_l = wsf + 32;
    bf16x8 qr[12];
    { const bf16_t* Qw = QB + (rowb + qrow0 + r32) * 1536 + h * QKD + hi * 8;
#pragma unroll
      for (int d0 = 0; d0 < 12; ++d0) qr[d0] = *(const bf16x8*)(Qw + d0 * 16); }
    unsigned gk0, gv0, gr;
    { const int w = wid;
      { const int row = 32 * (w & 1) + (lane >> 1), hh = (lane & 1) ^ ((row >> 3) & 1);
        gk0 = (unsigned)(row * 1024 + h * 128 + (w >> 1) * 16 + hh * 8); gr = (unsigned)(row * 64 + (w >> 1) * 16 + hh * 8); }
      { const int st = 4 * w + (lane >> 5), kk = (st >> 2) * 8 + ((lane >> 2) & 7), k = (kk & ~0xC) | ((kk & 4) << 1) | ((kk & 8) >> 1), c = (st & 3) * 32 + (lane & 3) * 8; gv0 = (unsigned)(k * 1024 + h * 128 + c); } }
    const bf16_t* KNb = KN + rowb * 1024; const bf16_t* VBb = VB + rowb * 1024; const bf16_t* KRb = KR + rowb * 64;
    const unsigned wq = (unsigned)wid * 2048u, wk = (unsigned)wid * 1024u;
    const int kb0 = (int)(uintptr_t)lds + SHM_V + r32 * 32 + ((hi ^ ((r32 >> 3) & 1)) << 4);
    const int vb0 = (int)(uintptr_t)lds + v_rd_base(lane);
#define ATT_DMA(gp, lp) __builtin_amdgcn_global_load_lds((const unsigned*)(gp), (LAS unsigned*)(lp), 16, 0, 0)
#define ATT_STAGE(j_, bf_) do { LAS char* bb_ = lds + (bf_) * SHM_BUF; const size_t ko_ = (size_t)(j_) * 64; \
    ATT_DMA(KNb + ko_ * 1024 + gk0, bb_ + SHM_V + wk); ATT_DMA(KNb + ko_ * 1024 + gk0 + 64, bb_ + SHM_V + 8192 + wk); \
    ATT_DMA(VBb + ko_ * 1024 + gv0, bb_ + wq); ATT_DMA(VBb + ko_ * 1024 + gv0 + 64, bb_ + wq + 1024); ATT_DMA(KRb + ko_ * 64 + gr, bb_ + SHM_V + 16384 + wk); } while (0)
#define ATT_WAIT_BAR(N) asm volatile("s_waitcnt vmcnt(" #N ") lgkmcnt(0)\n\ts_barrier" ::: "memory")
    float m_reg = -1e30f, l_reg = 0.f; f32x16 o[4];
#pragma unroll
    for (int d = 0; d < 4; ++d)
#pragma unroll
        for (int r = 0; r < 16; ++r) o[d][r] = 0.f;
    ATT_STAGE(0, 0); if (ntmax > 1) { ATT_STAGE(1, 1); ATT_WAIT_BAR(5); } else { ATT_WAIT_BAR(0); }
    int bf = 0;
    for (int j = 0; j < ntmax; ++j) {
        const int bf2 = bf == 0 ? 2 : bf - 1;
        const bool st2 = j + 2 < ntmax;
        if (st2) ATT_STAGE(j + 2, bf2);
        if (j < ntw) {
            const int vb = vb0 + bf * SHM_BUF, kb = kb0 + bf * SHM_BUF;
#pragma unroll
            for (int hk = 0; hk < 2; ++hk) {
                if (j == 0 && hk == 0) continue;
                f32x16 p0;
#pragma unroll
                for (int r = 0; r < 16; ++r) p0[r] = 0.f;
#pragma unroll
                for (int d0 = 0; d0 < 12; ++d0) {
                    const bf16x8 b0 = *(const LAS bf16x8*)(uintptr_t)(unsigned)(kb + d0 * 2048 + hk * 1024);
                    p0 = __builtin_amdgcn_mfma_f32_32x32x16_bf16(b0, qr[d0], p0, 0, 0, 0); }
                if (j == 0) {
#pragma unroll
                    for (int r = 0; r < 8; ++r) p0[r] = -1e30f;
                }
                float pmax = p0[0];
#pragma unroll
                for (int r = 1; r < 16; ++r) pmax = fmaxf(pmax, p0[r]);
                { auto sw = __builtin_amdgcn_permlane32_swap(__float_as_uint(pmax), __float_as_uint(pmax), false, false); pmax = fmaxf(__uint_as_float(sw[0]), __uint_as_float(sw[1])); }
                float mn, alpha;
                if (__all(pmax - m_reg <= 8.0f)) { mn = m_reg; alpha = 1.f; }
                else { mn = fmaxf(m_reg, pmax); alpha = __builtin_amdgcn_exp2f(m_reg - mn); m_reg = mn; }
                float ps = 0.f;
#pragma unroll
                for (int r = 0; r < 16; ++r) { p0[r] = __builtin_amdgcn_exp2f(p0[r] - mn); ps += p0[r]; }
                { auto sw = __builtin_amdgcn_permlane32_swap(__float_as_uint(ps), __float_as_uint(ps), false, false); ps = __uint_as_float(sw[0]) + __uint_as_float(sw[1]); }
                l_reg = l_reg * alpha + ps;
                bf16x8 pa0, pa1;
#define ATT_PK4(Pv, BASE, OUT) do { unsigned a0 = cvtpk(Pv[BASE + 0], Pv[BASE + 1]), a1 = cvtpk(Pv[BASE + 2], Pv[BASE + 3]); \
    unsigned b0_ = cvtpk(Pv[BASE + 4], Pv[BASE + 5]), b1_ = cvtpk(Pv[BASE + 6], Pv[BASE + 7]); \
    auto r0 = __builtin_amdgcn_permlane32_swap(a0, b0_, false, false); auto r1 = __builtin_amdgcn_permlane32_swap(a1, b1_, false, false); \
    u32x4 w = {r0[0], r1[0], r0[1], r1[1]}; OUT = *reinterpret_cast<bf16x8*>(&w); } while (0)
                ATT_PK4(p0, 0, pa0); ATT_PK4(p0, 8, pa1);
#undef ATT_PK4
                if (__any(alpha < 1.f)) { if (hi == 0) al_l[r32] = alpha; asm volatile("s_waitcnt lgkmcnt(0)" ::: "memory");
#pragma unroll
                    for (int d = 0; d < 4; ++d)
#pragma unroll
                        for (int r = 0; r < 16; ++r) o[d][r] *= al_l[crow(r, hi)]; }
                if (hk == 0) { pv_half<0, 0>(o[0], vb, pa0, pa1); pv_half<1, 0>(o[1], vb, pa0, pa1); pv_half<2, 0>(o[2], vb, pa0, pa1); pv_half<3, 0>(o[3], vb, pa0, pa1); }
                else         { pv_half<0, 1>(o[0], vb, pa0, pa1); pv_half<1, 1>(o[1], vb, pa0, pa1); pv_half<2, 1>(o[2], vb, pa0, pa1); pv_half<3, 1>(o[3], vb, pa0, pa1); }
            }
        }
        if (st2) ATT_WAIT_BAR(5); else ATT_WAIT_BAR(0);
        bf = bf == 2 ? 0 : bf + 1;
    }
    if (hi == 0) li_l[r32] = l_reg;
    asm volatile("s_waitcnt lgkmcnt(0)" ::: "memory");
    bf16_t* Ow = MIX + (rowb + qrow0) * DM + POOLW + h * 128 + r32;
#pragma unroll
    for (int r = 0; r < 16; ++r) { const int orow = crow(r, hi); const float rli = __builtin_amdgcn_rcpf(li_l[orow]);
#pragma unroll
        for (int d0 = 0; d0 < 4; ++d0) Ow[(size_t)orow * DM + d0 * 32] = (bf16_t)f2bf(o[d0][r] * rli); }
#undef ATT_DMA
#undef ATT_STAGE
#undef ATT_WAIT_BAR
}
__device__ __forceinline__ void attn_phase(const unsigned char* ws, unsigned char* wsw, LAS char* lds, int G, int bx, const int tid) {
    const bf16_t* QB = (const bf16_t*)(ws + WS_QB); const bf16_t* KN = (const bf16_t*)(ws + WS_KN); const bf16_t* KR = (const bf16_t*)(ws + WS_KR); const bf16_t* VB = (const bf16_t*)(ws + WS_VB);
    bf16_t* MIX = (bf16_t*)(wsw + WS_MIX);
    for (int c = bx; c < 256; c += G) {
        const int x = c & 7, y = c >> 3, bh = 8 * (y >> 2) + x, p = y & 3, b = bh >> 3, h = bh & 7;
#pragma unroll 1
        for (int k = 0; k < 2; ++k) attn_unit(b, h, k == 0 ? 8 - p : 1 + p, QB, KN, KR, VB, MIX, lds, tid);
    }
}
}
#define XB_TMO      128
#define XB_XCNT(j)  (256  + 64 * (j))
#define XB_XSUB(j)  (1280 + 64 * (j))
#define XB_XGEN(j)  (2304 + 64 * (j))
#define XB_TOP      3328
#define XB_TOPGEN   3392
#define XCD_BAR_WORDS 3456
#define XB_SPIN_CAP (1u << 18)
__device__ __forceinline__ unsigned xb_ld(unsigned* p)              { return __hip_atomic_load(p, __ATOMIC_RELAXED, __HIP_MEMORY_SCOPE_AGENT); }
__device__ __forceinline__ unsigned xb_add(unsigned* p, unsigned v) { return __hip_atomic_fetch_add(p, v, __ATOMIC_RELAXED, __HIP_MEMORY_SCOPE_AGENT); }
__device__ __forceinline__ unsigned xb_xcc_id() { return (unsigned)__builtin_amdgcn_s_getreg((3 << 11) | 20) & 0xFu; }
#define XB_SPIN(cond, bar) do { unsigned _sp = 0; while (cond) { __builtin_amdgcn_s_sleep(1); \
    if ((++_sp & 255u) == 0u) { if (xb_ld(&(bar)[XB_TMO])) break; if (_sp > XB_SPIN_CAP) { atomicAdd(&(bar)[XB_TMO], 1u); break; } } } } while (0)
struct XcdBarrier { unsigned* bar; unsigned x; volatile LAS unsigned* st; };
__device__ __forceinline__ XcdBarrier xcd_barrier_post(unsigned* bar, volatile LAS unsigned* st) {
    XcdBarrier b; b.bar = bar; b.x = xb_xcc_id(); b.st = st;
    if (threadIdx.x == 0) (void)xb_add(&bar[XB_XCNT(b.x)], 1u);
    return b;
}
__device__ __forceinline__ void xcd_barrier_complete(unsigned* bar, unsigned x, unsigned& nloc, unsigned& nx) {
    const unsigned G = gridDim.x * gridDim.y * gridDim.z;
    unsigned sum, cnt, mine, sp = 0u;
    for (;;) {
        sum = 0u; cnt = 0u; mine = 0u;
#pragma unroll
        for (unsigned j = 0; j < 16; ++j) { const unsigned c = xb_ld(&bar[XB_XCNT(j)]); sum += c; cnt += (c > 0u) ? 1u : 0u; mine = (j == x) ? c : mine; }
        if (sum == G) break;
        __builtin_amdgcn_s_sleep(1);
        if ((++sp & 255u) == 0u) { if (xb_ld(&bar[XB_TMO])) break; if (sp > XB_SPIN_CAP) { atomicAdd(&bar[XB_TMO], 1u); break; } }
    }
    nloc = mine > 0u ? mine : 1u; nx = cnt > 0u ? cnt : 1u;
}
__device__ __forceinline__ void xcd_barrier(const XcdBarrier& b) {
    asm volatile("s_waitcnt vmcnt(0)" ::: "memory");
    __syncthreads();
    if (threadIdx.x == 0) {
        unsigned* bar = b.bar;
        __builtin_amdgcn_s_waitcnt(0);
        unsigned nloc = b.st[0], nx = b.st[1];
        if (nloc == 0u) { xcd_barrier_complete(bar, b.x, nloc, nx); b.st[0] = nloc; b.st[1] = nx; }
        const unsigned old = xb_add(&bar[XB_XSUB(b.x)], 1u);
        const unsigned gen = old / nloc;
        if (old + 1u == (gen + 1u) * nloc) {
            __builtin_amdgcn_fence(__ATOMIC_RELEASE, "agent");
            asm volatile("s_waitcnt vmcnt(0)" ::: "memory");
            const unsigned og = xb_add(&bar[XB_TOP], 1u);
            const unsigned tg = og / nx;
            if (og + 1u == (tg + 1u) * nx) xb_add(&bar[XB_TOPGEN], 1u);
            else XB_SPIN(xb_ld(&bar[XB_TOPGEN]) == tg, bar);
            __builtin_amdgcn_fence(__ATOMIC_ACQUIRE, "agent");
            xb_add(&bar[XB_XGEN(b.x)], 1u);
            asm volatile("s_waitcnt vmcnt(0)" ::: "memory");
        } else {
            XB_SPIN(xb_ld(&bar[XB_XGEN(b.x)]) == gen, bar);
            __builtin_amdgcn_fence(__ATOMIC_ACQUIRE, "agent");
            asm volatile("s_waitcnt vmcnt(0)" ::: "memory");
        }
    }
    __syncthreads();
}
constexpr int CW_BAR = 4096;

constexpr int CVS_P1 = 0, CVS_P2 = 3072, CVS_P3 = 4352, CVS_P3B = 8192, CVS_P4 = 8448, CVS_P6 = 11776;
static_assert(CVS_P1 + 16 * 7 + 80 * 13 + 160 * 12 == CVS_P2 && CVS_P2 + 140 * 4 + 24 * 7 + 92 * 6 == CVS_P3 && CVS_P3 + 256 * 15 == CV_ITEMS_W1 && CVS_P3B == CV_ITEMS_W1 && CVS_P3B + 256 == CVS_P4 && CVS_P4 + 256 * 13 == CVS_P6 && CVS_P6 + 512 == CV_ITEMS, "conversion plan");
constexpr int PH_P0 = 0, PH_P1 = 1, PH_P1B = 2, PH_P2 = 3, PH_P3 = 4, PH_P4 = 5, PH_P5 = 6, PH_P6 = 7, PH_P7 = 8, PH_P8 = 9, PH_END = 10;
struct Args { Ptrs P; int ph_lo, ph_hi, use_bar, pad; };
#define CAS __attribute__((address_space(4)))
__device__ __forceinline__ void load_ptrs(const CAS Args* a, Ptrs& P) { P.x = a->P.x; P.meta = a->P.meta; P.g_attn = a->P.g_attn; P.w_in = a->P.w_in; P.g_q = a->P.g_q; P.w_uq = a->P.w_uq; P.g_kv = a->P.g_kv; P.w_ukv = a->P.w_ukv; P.pool_w = a->P.pool_w; P.pool_scale = a->P.pool_scale; P.w_o = a->P.w_o; P.g_ffn = a->P.g_ffn; P.w_router = a->P.w_router; P.b_router = a->P.b_router; P.w1 = a->P.w1; P.b1 = a->P.b1; P.w2 = a->P.w2; P.b2 = a->P.b2; P.g_final = a->P.g_final; P.out = a->P.out; P.ws = a->P.ws; }
__global__ void __launch_bounds__(NWAVES * 64, 2) mk_fwd(Args args) {
    extern __shared__ __attribute__((aligned(16))) unsigned char lds_raw[];
    LAS unsigned char* lds = (LAS unsigned char*)lds_raw;
    const int G = gridDim.x, bx = blockIdx.x;
#define PHASE_IDS int tid; asm volatile("v_mov_b32 %0, %1" : "=v"(tid) : "v"(threadIdx.x)); const int lane = tid & 63, wave = __builtin_amdgcn_readfirstlane(tid >> 6); \
    const long gw = (long)bx * NWAVES + wave, NGW = (long)G * NWAVES; (void)lane; (void)gw; (void)NGW; \
    const CAS Args* ap_ = (const CAS Args*)__builtin_amdgcn_kernarg_segment_ptr(); asm volatile("" : "+s"(ap_)); Ptrs P; load_ptrs(ap_, P); unsigned char* const ws = P.ws
    volatile LAS unsigned* MISC = (volatile LAS unsigned*)(lds + MISC_OFF);
    if (threadIdx.x < 64) MISC[threadIdx.x] = 0u;
    __syncthreads();
    XcdBarrier bar; bar.bar = (unsigned*)(args.P.ws + WS_CTL) + CW_BAR; bar.x = 0; bar.st = nullptr;
    if (args.use_bar) bar = xcd_barrier_post((unsigned*)(args.P.ws + WS_CTL) + CW_BAR, MISC + 8);
    const int lo = args.ph_lo, hi = args.ph_hi;
#define IN(k) (lo <= (k) && (k) < hi)
    const bool cv_first = ((bx >> 3) & 1) != 0;
#define CV_CALL(W1, F, S, N) do { const CAS Args* ap2_ = (const CAS Args*)__builtin_amdgcn_kernarg_segment_ptr(); asm volatile("" : "+s"(ap2_)); Ptrs Pc_; load_ptrs(ap2_, Pc_); cv_slice<W1>(Pc_, lds_raw, tid, (F), (S), (N)); } while (0)
#define CV_DEAL(W1, S, ca, ka, cb, kb, kc) do { if (G == 256) { int f_, s_, n_; if (bx < (ca)) { f_ = (S) + bx; s_ = (ca); n_ = (ka); } else if (bx < (cb)) { f_ = (S) + (ca) * (ka) + (bx - (ca)); s_ = (cb) - (ca); n_ = (kb); } \
        else { f_ = (S) + (ca) * (ka) + ((cb) - (ca)) * (kb) + (bx - (cb)); s_ = 256 - (cb); n_ = (kc); } CV_CALL(W1, f_, s_, n_); } \
    else { const int tot_ = (ca) * (ka) + ((cb) - (ca)) * (kb) + (256 - (cb)) * (kc); for (int it_ = (S) + bx; it_ < (S) + tot_; it_ += G) CV_CALL(W1, it_, 0, 1); } } while (0)
#define CV_SLICE(W1, S, N) CV_DEAL(W1, S, 0, 0, 0, 0, N)
#define SEAM(k) do { if (IN(k) && IN((k) + 1)) xcd_barrier(bar); } while (0)

    if (IN(PH_P0)) { PHASE_IDS;
        float* scr = (float*)lds_raw + wave * (64 * 65);
        for (long it = gw; it < I_TOTAL; it += NGW) p0_item(P, it, scr, lane);
        for (long p = gw; p < MP; p += NGW) p0_hn_row(P, (int)p, lane);
        { u32x4* z = (u32x4*)(ws + WS_WIN + (size_t)INW * DM * 2); const long n16 = (long)(DM - INW) * DM * 2 / 16;
          for (long i = (long)bx * 512 + tid; i < n16; i += (long)G * 512) z[i] = (u32x4){0u, 0u, 0u, 0u}; }
        { float* ct = (float*)(ws + WS_ROPE); float* st = ct + LSEQ * 32;
          for (long i = (long)bx * 512 + tid; i < LSEQ * 32; i += (long)G * 512) { const int pos = (int)(i / 32), j = (int)(i % 32);
              const float inv = 1.0f / powf(10000.0f, (float)(2 * j) / 64.0f); const float ang = (float)pos * inv; ct[i] = cosf(ang); st[i] = sinf(ang); } }
        { float* wr = (float*)(ws + WS_WR);
          for (long i = (long)bx * 512 + tid; i < DM * NE; i += (long)G * 512) { const int k = (int)(i / NE), e = (int)(i % NE); wr[((k >> 2) * NE + e) * 4 + (k & 3)] = P.w_router[i] * P.g_ffn[k]; } }
        __syncthreads();
    }
    SEAM(PH_P0);
    if (IN(PH_P1)) { PHASE_IDS;
        pg8::ProbP1 pb; pb.A = (const char*)(ws + WS_HN); pb.Bt = (const char*)(ws + WS_WIN); pb.K = DM; pb.lda = DM; pb.ldaB = 2 * DM; pb.ldb = DM; pb.ldbB = 2 * DM; pb.ord.init(MP / 256, 8, G, bx);
        pb.proj = (bf16_t*)(ws + WS_PROJ); pb.kr = (bf16_t*)(ws + WS_KR); pb.rope = (const float*)(ws + WS_ROPE); pb.ssqp = (float*)(ws + WS_RSQ);
        if (cv_first) CV_DEAL(true, CVS_P1, 16, 7, 96, 13, 12);
        pg8::gemm_phase<pg8::ProbP1, true>(lds + RING_OFF, pb, tid);
        if (!cv_first) CV_DEAL(true, CVS_P1, 16, 7, 96, 13, 12);
    }
    if (IN(PH_P1) && IN(PH_P2)) xcd_barrier(bar);
    if (IN(PH_P2)) { PHASE_IDS;
        for (long m = gw; m < MP; m += NGW) p1b_row(P, (int)m, lane);
        if (cv_first) CV_DEAL(true, CVS_P2, 140, 4, 164, 7, 6);
        { pg8::ProbP2q pb; pb.A = (const char*)(ws + WS_PROJ) + 1024 * 2; pb.Bt = (const char*)(ws + WS_WUQ); pb.K = QLORA; pb.lda = DM; pb.ldaB = 2 * DM; pb.ldb = QLORA; pb.ldbB = 2 * QLORA; pb.ord.init(MP / 256, 6, G, bx);
          pb.qb = (bf16_t*)(ws + WS_QB); pb.rsq = (const float*)(ws + WS_RSQ); pb.rope = (const float*)(ws + WS_ROPE);
          pg8::gemm_phase<pg8::ProbP2q, true>(lds + RING_OFF, pb, tid); }
        { pg8::ProbP2kv pb; pb.A = (const char*)(ws + WS_PROJ) + 1536 * 2; pb.Bt = (const char*)(ws + WS_WUKV); pb.K = KVLORA; pb.lda = DM; pb.ldaB = 2 * DM; pb.ldb = KVLORA; pb.ldbB = 2 * KVLORA; pb.ord.init(MP / 256, 8, G, (bx + 116) % G);
          pb.kn = (bf16_t*)(ws + WS_KN); pb.vb = (bf16_t*)(ws + WS_VB); pb.rskv = (const float*)(ws + WS_RSQ);
          pg8::gemm_phase<pg8::ProbP2kv, true>(lds + RING_OFF, pb, tid); }
        if (!cv_first) CV_DEAL(true, CVS_P2, 140, 4, 164, 7, 6);
    }
    SEAM(PH_P2);
    if (IN(PH_P3)) { PHASE_IDS;
        if (cv_first) { CV_SLICE(true, CVS_P3, 15); CV_SLICE(false, CVS_P3B, 1); }
        att::attn_phase(ws, ws, (LAS char*)(lds + RING_OFF), G, bx, tid);
        { pg8::ProbPool pb; pb.A = (const char*)(ws + WS_DP); pb.Bt = (const char*)(ws + WS_WPOOL); pb.K = 256; pb.lda = POOLW; pb.ldaB = 2 * POOLW; pb.ldb = 256; pb.ldbB = 2 * 256; pb.ord.init(MP / 256, 4, G, bx);
          pb.mix = (bf16_t*)(ws + WS_MIX); pb.pscale = P.pool_scale;
          pg8::gemm_phase<pg8::ProbPool, true>(lds + RING_OFF, pb, tid); }
        if (!cv_first) { CV_SLICE(true, CVS_P3, 15); CV_SLICE(false, CVS_P3B, 1); }
    }
    SEAM(PH_P3);
    if (IN(PH_P4)) { PHASE_IDS;
        pg8::ProbP4 pb; pb.A = (const char*)(ws + WS_MIX); pb.Bt = (const char*)(ws + WS_WO); pb.K = DM; pb.lda = DM; pb.ldaB = 2 * DM; pb.ldb = DM; pb.ldbB = 2 * DM; pb.ord.init(MR / 256, 8, G, bx);
        pb.x = P.x; pb.h2 = (bf16_t*)(ws + WS_HN); pb.h2f8 = ws + WS_H2B;
        pg8::gemm_phase<pg8::ProbP4, true>(lds + RING_OFF, pb, tid);
    }
    SEAM(PH_P4);
    if (IN(PH_P5)) { PHASE_IDS; for (int blk = bx; blk < MR / 64; blk += G) p5_block(P, blk, lds_raw, tid); }
    SEAM(PH_P5);
    if (IN(PH_P6)) { PHASE_IDS;
        pg8::moe_table(lds, (const unsigned*)(ws + WS_CTL) + CW_CNT, tid);
        pg8::ProbP6 pb; pb.A = (const char*)(ws + WS_H2B); pb.Bt = (const char*)(ws + WS_W1); pb.K = DM; pb.ldbB = DM; pb.ord.tab = (const LAS int*)(lds + TAB_OFF); pb.ord.G = G; pb.ord.c = bx;
        pb.list = (const int*)(ws + WS_LIST); pb.rsl = (const float*)(ws + WS_RSL); pb.b1 = P.b1; pb.act = ws + WS_ACT;
        const int split = 2 + 4 * ((bx >> 3) & 3);
        pb.ord.i0 = 0; pb.ord.i1 = split;
        pg8::gemm_phase<pg8::ProbP6, true>(lds + RING_OFF, pb, tid);
        CV_SLICE(false, CVS_P4, 13);
        pb.ord.i0 = split; pb.ord.i1 = 0x7fffffff;
        pg8::gemm_phase<pg8::ProbP6, true>(lds + RING_OFF, pb, tid);
        { const int U = ((const LAS int*)(lds + TAB_OFF))[NE] * 16, R = U % G, nidle = G - R, rank0 = (G & 7) ? bx : (bx & 7) * (G >> 3) + (bx >> 3);
          const bool few = nidle < 64; const int nshare = few ? G : nidle, rank = few ? rank0 : rank0 - R;
          if (rank >= 0) { const int cnt_ = (CV_ITEMS - CVS_P6 - rank + nshare - 1) / nshare; CV_CALL(false, CVS_P6 + rank, nshare, cnt_); } }
    }
    SEAM(PH_P6);
    if (IN(PH_P7)) { PHASE_IDS;
        pg8::moe_table(lds, (const unsigned*)(ws + WS_CTL) + CW_CNT, tid);
        pg8::ProbP7 pb; pb.A = (const char*)(ws + WS_ACT); pb.Bt = (const char*)(ws + WS_W2); pb.K = DFF; pb.ldbB = DFF; pb.ord.tab = (const LAS int*)(lds + TAB_OFF); pb.ord.G = G; pb.ord.c = bx; pb.ord.i0 = 0; pb.ord.i1 = 0x7fffffff;
        pb.list = (const int*)(ws + WS_LIST); pb.gate = (const float*)(ws + WS_GATE); pb.b2 = P.b2; pb.yb = ws + WS_YB;
        pg8::gemm_phase<pg8::ProbP7, true>(lds + RING_OFF, pb, tid);
    }
    SEAM(PH_P7);
    if (IN(PH_P8)) { PHASE_IDS; for (long r = gw; r < MR; r += NGW) p8_row(P, (int)r, lane, P.out); }
#undef IN
#undef SEAM
}

extern "C" void kernel_launch(void* const* d_in, const int* in_sizes, int n_in, void* d_out, int out_size, void* d_ws, size_t ws_size, hipStream_t stream) {
    static int ok = 0; static int grid = 256;
    if (ok == 0) {
        if (n_in != 19 || in_sizes[0] != NB * SEQ * DM || out_size != MR * DM || ws_size < WS_END) { fprintf(stderr, "kernel_launch: shape mismatch n_in %d in0 %d out %d ws %zu\n", n_in, n_in > 0 ? in_sizes[0] : -1, out_size, ws_size); ok = -1; return; }
        if (hipFuncSetAttribute((const void*)mk_fwd, hipFuncAttributeMaxDynamicSharedMemorySize, LDS_BYTES) != hipSuccess) { fprintf(stderr, "hipFuncSetAttribute(mk) failed\n"); ok = -1; return; }
        int dev = 0, cus = 0; (void)hipGetDevice(&dev); (void)hipDeviceGetAttribute(&cus, hipDeviceAttributeMultiprocessorCount, dev); if (cus > 0) grid = cus;
        ok = 1;
    }
    if (ok < 0) return;
    Ptrs P{};
    const float** pp = (const float**)&P;
    for (int i = 0; i < 19; ++i) pp[i] = (const float*)d_in[i];
    P.out = (float*)d_out; P.ws = (unsigned char*)d_ws;
    unsigned char* ws = (unsigned char*)d_ws;
    (void)hipMemsetAsync(ws + WS_CTL, 0, CTL_ZERO_BYTES, stream);
    { Args a{}; a.P = P; a.ph_lo = 0; a.ph_hi = PH_END; a.use_bar = 1; a.pad = 0;
      hipLaunchKernelGGL(mk_fwd, dim3(grid), dim3(NWAVES * 64), LDS_BYTES, stream, a); }
}
```

```cpp
#include <hip/hip_runtime.h>
#include <cstdint>
#include <cstdio>

constexpr int NB = 8, SEQ = 2048, NMETA = 16, LSEQ = 2064, LP = 2112, PADR = 48, MP = NB * LP, MR = NB * SEQ;
constexpr int DM = 2048, POOLW = 1024, QLORA = 512, KVLORA = 256, QKROPE = 64, QKNOPE = 128, VDIM = 128, NH = 8, QKD = 192;
constexpr int INW = 1856, NE = 32, TOPK = 4, DFF = 2048;
constexpr float EPS = 1e-5f;
constexpr float C2 = 0.07216878364870322f * 1.4426950408889634f;
constexpr int ACT_ROWS = MR * TOPK + NE * 256;

typedef unsigned short bf16_t;
typedef unsigned u32x4 __attribute__((ext_vector_type(4)));
typedef float f32x4 __attribute__((ext_vector_type(4)));

constexpr size_t MiB = 1u << 20;
constexpr size_t WS_CTL = 0, CTL_ZERO_BYTES = 1 * MiB;
constexpr size_t WS_ROPE = 1 * MiB;
constexpr size_t WS_WR = 2 * MiB;
constexpr size_t WS_WIN = 4 * MiB;
constexpr size_t WS_WUQ = 12 * MiB;
constexpr size_t WS_WUKV = 14 * MiB;
constexpr size_t WS_WPOOL = 15 * MiB;
constexpr size_t WS_WO = 16 * MiB;
constexpr size_t WS_W1 = 24 * MiB;
constexpr size_t WS_W2 = 536 * MiB;
constexpr size_t WS_HN = 792 * MiB;
constexpr size_t WS_PROJ = 860 * MiB;
constexpr size_t WS_QB = 928 * MiB;
constexpr size_t WS_KN = 980 * MiB;
constexpr size_t WS_VB = 1014 * MiB;
constexpr size_t WS_KR = 1048 * MiB;
constexpr size_t WS_RSQ = 1051 * MiB;
constexpr size_t WS_RSKV = 1052 * MiB;
constexpr size_t WS_RS2 = 1053 * MiB;
constexpr size_t WS_DP = 1054 * MiB;
constexpr size_t WS_MIX = 1088 * MiB;
constexpr size_t WS_H2B = 1156 * MiB;
constexpr size_t WS_LIST = 1220 * MiB;
constexpr size_t WS_GATE = 1222 * MiB;
constexpr size_t WS_ACT = 1224 * MiB;
constexpr size_t WS_YB = 1512 * MiB;
constexpr size_t WS_RSL = 1768 * MiB;
constexpr size_t WS_END = 1770 * MiB;
constexpr int CW_CNT = 64;

struct Ptrs {
    const float *x, *meta, *g_attn, *w_in, *g_q, *w_uq, *g_kv, *w_ukv, *pool_w, *pool_scale, *w_o, *g_ffn, *w_router, *b_router, *w1, *b1, *w2, *b2, *g_final;
    float* out; unsigned char* ws;
};

__device__ __forceinline__ float bf2f(bf16_t v) { return __uint_as_float((unsigned)v << 16); }
__device__ __forceinline__ unsigned f2bf(float f) { unsigned u = __float_as_uint(f); return (u + 0x7fffu + ((u >> 16) & 1u)) >> 16; }
__device__ __forceinline__ unsigned pk2(float lo, float hi) { return f2bf(lo) | (f2bf(hi) << 16); }
__device__ __forceinline__ float wave_sum(float v) {
#pragma unroll
    for (int o = 1; o < 64; o <<= 1) v += __shfl_xor(v, o);
    return v;
}
__device__ __forceinline__ float wave_max(float v) {
#pragma unroll
    for (int o = 1; o < 64; o <<= 1) v = fmaxf(v, __shfl_xor(v, o));
    return v;
}

__device__ __forceinline__ void p0_hn_row(const Ptrs& P, int p, int lane) {
    bf16_t* hn = (bf16_t*)(P.ws + WS_HN) + (size_t)p * DM;
    const int b = p / LP, q = p % LP;
    unsigned long long* o8 = (unsigned long long*)hn + lane;
    if (q < PADR) {
#pragma unroll
        for (int j = 0; j < 8; ++j) o8[64 * j] = 0ull;
        return;
    }
    const int pos = q - PADR;
    const float* src = pos < NMETA ? P.meta + (size_t)pos * DM : P.x + ((size_t)b * SEQ + (pos - NMETA)) * DM;
    const f32x4* xr = (const f32x4*)src + lane;
    const f32x4* gr = (const f32x4*)P.g_attn + lane;
    f32x4 v[8]; float s = 0.f;
#pragma unroll
    for (int j = 0; j < 8; ++j) { v[j] = xr[64 * j]; s += (v[j].x * v[j].x + v[j].y * v[j].y) + (v[j].z * v[j].z + v[j].w * v[j].w); }
    const float rs = 1.0f / sqrtf(wave_sum(s) * (1.0f / DM) + EPS);
#pragma unroll
    for (int j = 0; j < 8; ++j) { const f32x4 g = gr[64 * j];
        o8[64 * j] = (unsigned long long)pk2(v[j].x * rs * g.x, v[j].y * rs * g.y) | ((unsigned long long)pk2(v[j].z * rs * g.z, v[j].w * rs * g.w) << 32); }
}
template <int MODE> __device__ __forceinline__ int nmap(int n) {
    if (MODE == 1) { if (n >= 1792) { const int j = n - 1792; return 1792 + (j < 32 ? 2 * j : 2 * (j - 32) + 1); } return n; }
    if (MODE == 2) { const int h = n / 192, d = n % 192; if (d >= 128) { const int j = d - 128; return h * 192 + 128 + (j < 32 ? 2 * j : 2 * (j - 32) + 1); } return n; }
    return n;
}
template <int MODE> __device__ __forceinline__ void p0_transpose_item(const float* W, int K, int N, bf16_t* WT, const float* gk, float* scr, int item, int lane) {
    const int nblk = N / 64, kb = item / nblk, nb = item % nblk, k0 = 64 * kb, n0 = 64 * nb;
    const int kl = lane >> 4, nl = (lane & 15) * 4;
#pragma unroll 4
    for (int i = 0; i < 16; ++i) { const int kk = kl + 4 * i; const f32x4 v = *(const f32x4*)(W + (size_t)(k0 + kk) * N + n0 + nl);
        const float g = gk ? gk[k0 + kk] : 1.0f;
        float* s = scr + kk * 65 + nl; s[0] = v.x * g; s[1] = v.y * g; s[2] = v.z * g; s[3] = v.w * g; }
    __builtin_amdgcn_s_waitcnt(0xc07f); asm volatile("" ::: "memory");
    const int c = lane & 7;
#pragma unroll
    for (int j = 0; j < 8; ++j) { const int n = (lane >> 3) + 8 * j; const float* s = scr + (8 * c) * 65 + n;
        u32x4 o; o.x = pk2(s[0 * 65], s[1 * 65]); o.y = pk2(s[2 * 65], s[3 * 65]); o.z = pk2(s[4 * 65], s[5 * 65]); o.w = pk2(s[6 * 65], s[7 * 65]);
        *(u32x4*)(WT + (size_t)nmap<MODE>(n0 + n) * K + k0 + 8 * c) = o; }
    __builtin_amdgcn_s_waitcnt(0xc07f); asm volatile("" ::: "memory");
}
__device__ __forceinline__ void p0_transpose_item_f8(const float* W, int K, int N, unsigned char* WT, const float* gk, float scale, float* scr, int item, int lane) {
    const int nblk = N / 64, kb = item / nblk, nb = item % nblk, k0 = 64 * kb, n0 = 64 * nb;
    const int kl = lane >> 4, nl = (lane & 15) * 4;
#pragma unroll 4
    for (int i = 0; i < 16; ++i) { const int kk = kl + 4 * i; const f32x4 v = *(const f32x4*)(W + (size_t)(k0 + kk) * N + n0 + nl);
        const float g = (gk ? gk[k0 + kk] : 1.0f) * scale;
        float* s = scr + kk * 65 + nl; s[0] = v.x * g; s[1] = v.y * g; s[2] = v.z * g; s[3] = v.w * g; }
    asm volatile("s_waitcnt lgkmcnt(0)" ::: "memory");
    const int c = lane & 7;
#pragma unroll
    for (int j = 0; j < 8; ++j) { const int n = (lane >> 3) + 8 * j; const float* s = scr + (8 * c) * 65 + n;
        int w0 = 0, w1 = 0;
        w0 = __builtin_amdgcn_cvt_pk_fp8_f32(s[0 * 65], s[1 * 65], w0, false); w0 = __builtin_amdgcn_cvt_pk_fp8_f32(s[2 * 65], s[3 * 65], w0, true);
        w1 = __builtin_amdgcn_cvt_pk_fp8_f32(s[4 * 65], s[5 * 65], w1, false); w1 = __builtin_amdgcn_cvt_pk_fp8_f32(s[6 * 65], s[7 * 65], w1, true);
        *(unsigned long long*)(WT + (size_t)(n0 + n) * K + k0 + 8 * c) = (unsigned long long)(unsigned)w0 | ((unsigned long long)(unsigned)w1 << 32); }
    asm volatile("s_waitcnt lgkmcnt(0)" ::: "memory");
}
constexpr int CV_ITEMS_W1 = NE * (DM / 128) * (4096 / 256), CV_ITEMS_W2 = NE * (DFF / 128) * (DM / 256), CV_ITEMS = CV_ITEMS_W1 + CV_ITEMS_W2;
struct CvItem { const float* src; unsigned char* dst; const float* gk; };
__device__ __forceinline__ const __attribute__((address_space(4))) float* cv_uniform_cptr(const float* p) {
    const unsigned long long v = (unsigned long long)p; const unsigned lo = __builtin_amdgcn_readfirstlane((unsigned)v), hi = __builtin_amdgcn_readfirstlane((unsigned)(v >> 32));
    return (const __attribute__((address_space(4))) float*)(((unsigned long long)hi << 32) | lo); }
template <bool W1> __device__ __forceinline__ CvItem cv_decode(const Ptrs& P, int it) {
    CvItem c;
    if (W1) { const int e = it >> 8, r = it & 255, kb = r >> 4, nb = r & 15;
        c.src = P.w1 + (size_t)e * DM * 4096 + (size_t)kb * 128 * 4096 + nb * 256; c.dst = P.ws + WS_W1 + ((size_t)e * 4096 + nb * 256) * DM + kb * 128; c.gk = P.g_ffn + kb * 128; }
    else { const int j = it - CV_ITEMS_W1, e = j >> 7, r = j & 127, kb = r >> 3, nb = r & 7;
        c.src = P.w2 + (size_t)e * DFF * DM + (size_t)kb * 128 * DM + nb * 256; c.dst = P.ws + WS_W2 + ((size_t)e * DM + nb * 256) * DFF + kb * 128; c.gk = nullptr; }
    return c;
}
#define CV_LOAD(V, C, VALID) do { const __amdgpu_buffer_rsrc_t rs_ = __builtin_amdgcn_make_buffer_rsrc((void*)(C).src, 0, (VALID) ? 0x7ffffffe : 0, 0x00020000);     \
        _Pragma("unroll") for (int i_ = 0; i_ < 16; ++i_) V[i_] = __builtin_bit_cast(f32x4, __builtin_amdgcn_raw_buffer_load_b128(rs_, lane * 16, (wave + 8 * i_) * NN * 4, 2  )); } while (0)
#define CV_PROCESS(V, C, NEXT_IDX) do { \
        const __attribute__((address_space(4))) float* gk_ = cv_uniform_cptr((C).gk);     \
          \
        _Pragma("unroll") for (int i_ = 0; i_ < 16; ++i_) { const int k_ = wave + 8 * i_; const float g_ = W1 ? gk_[k_] * 32.0f : 32.0f; \
            *(f32x4*)(scr + k_ * 256 + ((lane * 4) ^ (((i_ >> 1) & 3) << 3))) = V[i_] * g_; } \
        unsigned char* dst_ = (C).dst; \
        asm volatile("" ::: "memory"); __builtin_amdgcn_sched_barrier(0);     \
        { const int nx_ = (NEXT_IDX) < count ? (NEXT_IDX) : count - 1; (C) = cv_decode<W1>(P, first + nx_ * step); CV_LOAD(V, C, (NEXT_IDX) < count); } \
        asm volatile("s_waitcnt lgkmcnt(0)\n\ts_barrier" ::: "memory"); \
          \
        _Pragma("unroll") for (int p_ = 0; p_ < 4; ++p_) { const int u_ = p_ * 8 + wave, nn_ = (u_ >> 1) * 16 + (lane >> 2), k0_ = (u_ & 1) * 64 + (lane & 3) * 16; \
            const float* t_ = scr + k0_ * 256 + (nn_ ^ ((lane & 3) << 3)); u32x4 w_;     \
            _Pragma("unroll") for (int d_ = 0; d_ < 4; ++d_) { int x_ = 0; x_ = __builtin_amdgcn_cvt_pk_fp8_f32(t_[(4 * d_) * 256], t_[(4 * d_ + 1) * 256], x_, false); \
                x_ = __builtin_amdgcn_cvt_pk_fp8_f32(t_[(4 * d_ + 2) * 256], t_[(4 * d_ + 3) * 256], x_, true); w_[d_] = (unsigned)x_; } \
            *(u32x4*)(dst_ + (size_t)nn_ * DM + k0_) = w_; __builtin_amdgcn_sched_barrier(0); } \
        asm volatile("s_waitcnt lgkmcnt(0)\n\ts_barrier" ::: "memory"); } while (0)
template <bool W1> __device__ __forceinline__ void cv_slice(const Ptrs& P, unsigned char* ldsg, int tid, int first, int step, int count) {
    if (count <= 0) return;
    constexpr int NN = W1 ? 4096 : DM;
    float* scr = (float*)ldsg;
    const int lane = tid & 63, wave = __builtin_amdgcn_readfirstlane(tid >> 6);
    f32x4 va[16], vb[16];
    CvItem ca = cv_decode<W1>(P, first), cb = cv_decode<W1>(P, first + (count > 1 ? step : 0));
    CV_LOAD(va, ca, true); CV_LOAD(vb, cb, count > 1);
    int n = 0;
    for (; n + 1 < count; n += 2) { CV_PROCESS(va, ca, n + 2); CV_PROCESS(vb, cb, n + 3); }
    if (n < count) CV_PROCESS(va, ca, n + 2);
    asm volatile("s_waitcnt vmcnt(0)" ::: "memory");
}
#undef CV_LOAD
#undef CV_PROCESS
constexpr int I_WIN = (DM / 64) * (INW / 64), I_WUQ = (QLORA / 64) * (1536 / 64), I_WUKV = (KVLORA / 64) * (2048 / 64), I_POOL1 = 4 * 4, I_WO = 32 * 32,
              I_W1E = (DM / 64) * (4096 / 64), I_W2E = 32 * 32;
constexpr int I_SMALL = I_WIN + I_WUQ + I_WUKV + 4 * I_POOL1 + I_WO;
constexpr long I_TOTAL = (long)I_SMALL;
__device__ __forceinline__ void p0_item(const Ptrs& P, long it, float* scr, int lane) {
    unsigned char* ws = P.ws;
    if (it < I_SMALL) {
        int r = (int)it;
        if (r < I_WIN) { p0_transpose_item<1>(P.w_in, DM, INW, (bf16_t*)(ws + WS_WIN), nullptr, scr, r, lane); return; } r -= I_WIN;
        if (r < I_WUQ) { p0_transpose_item<2>(P.w_uq, QLORA, 1536, (bf16_t*)(ws + WS_WUQ), P.g_q, scr, r, lane); return; } r -= I_WUQ;
        if (r < I_WUKV) { p0_transpose_item<0>(P.w_ukv, KVLORA, 2048, (bf16_t*)(ws + WS_WUKV), P.g_kv, scr, r, lane); return; } r -= I_WUKV;
        if (r < 4 * I_POOL1) { const int g = r / I_POOL1; p0_transpose_item<0>(P.pool_w + (size_t)g * 65536, 256, 256, (bf16_t*)(ws + WS_WPOOL) + (size_t)g * 65536, nullptr, scr, r % I_POOL1, lane); return; } r -= 4 * I_POOL1;
        p0_transpose_item<0>(P.w_o, DM, DM, (bf16_t*)(ws + WS_WO), nullptr, scr, r, lane); return;
    }
    it -= I_SMALL;
    if (it < (long)NE * I_W1E) { const int e = (int)(it / I_W1E), r = (int)(it % I_W1E);
        p0_transpose_item_f8(P.w1 + (size_t)e * DM * 4096, DM, 4096, ws + WS_W1 + (size_t)e * 4096 * DM, P.g_ffn, 32.0f, scr, r, lane); return; }
    it -= (long)NE * I_W1E;
    { const int e = (int)(it / I_W2E), r = (int)(it % I_W2E);
      p0_transpose_item_f8(P.w2 + (size_t)e * DFF * DM, DFF, DM, ws + WS_W2 + (size_t)e * DM * DFF, nullptr, 32.0f, scr, r, lane); }
}
__device__ __forceinline__ void st4bf(bf16_t* p, float a, float b, float c, float d) { *(unsigned long long*)p = (unsigned long long)pk2(a, b) | ((unsigned long long)pk2(c, d) << 32); }
__device__ __forceinline__ void p1b_row(const Ptrs& P, int m, int lane) {
    const bf16_t* proj = (const bf16_t*)(P.ws + WS_PROJ);
    const bf16_t* row = proj + (size_t)m * DM;
    bf16_t* dp = (bf16_t*)(P.ws + WS_DP) + (size_t)m * POOLW;
    const int pos = (m % LP) - PADR;
    if (pos < 0) {
#pragma unroll
        for (int g = 0; g < 4; ++g) *(unsigned long long*)(dp + g * 256 + lane * 4) = 0ull;
        return;
    }
    unsigned long long ld[30];
    { int q = 0;
#pragma unroll
      for (int g = 0; g < 4; ++g)
#pragma unroll
          for (int j = 0; j < (2 << g); ++j) { const int jj = j < pos ? j : pos; ld[q++] = *(const unsigned long long*)(row - (size_t)jj * DM + g * 256 + lane * 4); } }
    { int q = 0;
#pragma unroll
      for (int g = 0; g < 4; ++g) { const int w = 2 << g; const int cntw = pos + 1 < w ? pos + 1 : w;
        float s0 = 0.f, s1 = 0.f, s2 = 0.f, s3 = 0.f, u0 = 0.f, u1 = 0.f, u2 = 0.f, u3 = 0.f;
#pragma unroll
        for (int j = 0; j < w; ++j) { const unsigned long long v = ld[q++]; const unsigned lo = (unsigned)v, hi = (unsigned)(v >> 32);
            const float mk = j < cntw ? 1.0f : 0.0f;
            const float a = __uint_as_float(lo << 16) * mk, b2 = __uint_as_float(lo & 0xffff0000u) * mk, cc = __uint_as_float(hi << 16) * mk, d = __uint_as_float(hi & 0xffff0000u) * mk;
            if (j == 0) { u0 = a; u1 = b2; u2 = cc; u3 = d; } s0 += a; s1 += b2; s2 += cc; s3 += d; }
        const float ic = 1.0f / (float)cntw;
        st4bf(dp + g * 256 + lane * 4, s0 * ic - u0, s1 * ic - u1, s2 * ic - u2, s3 * ic - u3); } }
}
typedef float f32x16_t __attribute__((ext_vector_type(16)));
__device__ __forceinline__ void p5_block(const Ptrs& P, int blk, unsigned char* ldsg, int tid) {
    const int lane = tid & 63, wave = tid >> 6, t = lane & 31, kk = lane >> 5, tg = wave >> 2, kq = wave & 3;
    float* part = (float*)ldsg;
    float* ssqp = part + 8 * 32 * 33;
    const bf16_t* arow = (const bf16_t*)(P.ws + WS_HN) + (size_t)(blk * 64 + tg * 32 + t) * DM + kq * 512 + 16 * kk;
    const f32x4* bptr = (const f32x4*)(P.ws + WS_WR) + ((kq * 128 + 4 * kk) * NE + t);
    f32x16_t acc;
#pragma unroll
    for (int r = 0; r < 16; ++r) acc[r] = 0.f;
    float ss = 0.f;
#pragma unroll 2
    for (int j = 0; j < 16; ++j) {
        f32x4 a[4], b[4]; const u32x4 d0 = *(const u32x4*)(arow + 32 * j), d1 = *(const u32x4*)(arow + 32 * j + 8);
#pragma unroll
        for (int q = 0; q < 4; ++q) b[q] = bptr[(8 * j + q) * NE];
        a[0] = (f32x4){__uint_as_float(d0[0] << 16), __uint_as_float(d0[0] & 0xffff0000u), __uint_as_float(d0[1] << 16), __uint_as_float(d0[1] & 0xffff0000u)};
        a[1] = (f32x4){__uint_as_float(d0[2] << 16), __uint_as_float(d0[2] & 0xffff0000u), __uint_as_float(d0[3] << 16), __uint_as_float(d0[3] & 0xffff0000u)};
        a[2] = (f32x4){__uint_as_float(d1[0] << 16), __uint_as_float(d1[0] & 0xffff0000u), __uint_as_float(d1[1] << 16), __uint_as_float(d1[1] & 0xffff0000u)};
        a[3] = (f32x4){__uint_as_float(d1[2] << 16), __uint_as_float(d1[2] & 0xffff0000u), __uint_as_float(d1[3] << 16), __uint_as_float(d1[3] & 0xffff0000u)};
#pragma unroll
        for (int q = 0; q < 4; ++q) {
            ss += (a[q].x * a[q].x + a[q].y * a[q].y) + (a[q].z * a[q].z + a[q].w * a[q].w);
            acc = __builtin_amdgcn_mfma_f32_32x32x2f32(a[q].x, b[q].x, acc, 0, 0, 0); acc = __builtin_amdgcn_mfma_f32_32x32x2f32(a[q].y, b[q].y, acc, 0, 0, 0);
            acc = __builtin_amdgcn_mfma_f32_32x32x2f32(a[q].z, b[q].z, acc, 0, 0, 0); acc = __builtin_amdgcn_mfma_f32_32x32x2f32(a[q].w, b[q].w, acc, 0, 0, 0);
        }
    }
    ss += __shfl_xor(ss, 32);
#pragma unroll
    for (int r = 0; r < 16; ++r) part[(wave * 32 + ((r & 3) + 8 * (r >> 2) + 4 * kk)) * 33 + t] = acc[r];
    if (kk == 0) ssqp[wave * 32 + t] = ss;
    __syncthreads();
    if (tid < 64) {
        const int tg2 = tid >> 5, ti = tid & 31, r = blk * 64 + tid;
        float lg[NE];
#pragma unroll
        for (int e = 0; e < NE; ++e) lg[e] = (part[((tg2 * 4 + 0) * 32 + ti) * 33 + e] + part[((tg2 * 4 + 1) * 32 + ti) * 33 + e]) + (part[((tg2 * 4 + 2) * 32 + ti) * 33 + e] + part[((tg2 * 4 + 3) * 32 + ti) * 33 + e]);
        const float ssq = (ssqp[(tg2 * 4 + 0) * 32 + ti] + ssqp[(tg2 * 4 + 1) * 32 + ti]) + (ssqp[(tg2 * 4 + 2) * 32 + ti] + ssqp[(tg2 * 4 + 3) * 32 + ti]);
        const float rs = 1.0f / sqrtf(ssq * (1.0f / DM) + EPS);
#pragma unroll
        for (int e = 0; e < NE; ++e) lg[e] = lg[e] * rs + P.b_router[e];
        ((float*)(P.ws + WS_RS2))[r] = rs;
        int idx[TOPK]; float val[TOPK]; unsigned used = 0u;
#pragma unroll
        for (int k = 0; k < TOPK; ++k) { float best = -INFINITY; int bi = 0;
#pragma unroll
            for (int e = 0; e < NE; ++e) { const bool ok = !((used >> e) & 1u) && lg[e] > best; best = ok ? lg[e] : best; bi = ok ? e : bi; }
            used |= 1u << bi; idx[k] = bi; val[k] = best; }
        float den = 0.f, pe[TOPK];
#pragma unroll
        for (int k = 0; k < TOPK; ++k) { pe[k] = __expf(val[k] - val[0]); den += pe[k]; }
        unsigned* cnt = (unsigned*)(P.ws + WS_CTL) + CW_CNT; int* list = (int*)(P.ws + WS_LIST); float* gate = (float*)(P.ws + WS_GATE); float* rsl = (float*)(P.ws + WS_RSL);
        unsigned* lcnt = (unsigned*)(ssqp + 8 * 32); unsigned* lbase = lcnt + NE;
        if (tid < NE) lcnt[tid] = 0u;
        unsigned rk[TOPK];
#pragma unroll
        for (int k = 0; k < TOPK; ++k) rk[k] = __hip_atomic_fetch_add(lcnt + idx[k], 1u, __ATOMIC_RELAXED, __HIP_MEMORY_SCOPE_WORKGROUP);
        if (tid < NE) { const unsigned n = lcnt[tid]; lbase[tid] = n ? atomicAdd(cnt + tid, n) : 0u; }
#pragma unroll
        for (int k = 0; k < TOPK; ++k) { const unsigned slot = lbase[idx[k]] + rk[k]; const size_t o = (size_t)idx[k] * MR + slot; list[o] = r * 4 + k; gate[o] = pe[k] / den; rsl[o] = rs; }
    }
    __syncthreads();
}
__device__ __forceinline__ void p8_row(const Ptrs& P, int r, int lane, float* outbase) {
    const bf16_t* h2 = (const bf16_t*)(P.ws + WS_HN) + (size_t)r * DM; float* orow = outbase + (size_t)r * DM; const unsigned char* yb = P.ws + WS_YB + (size_t)r * 4 * DM;
    f32x4 v[8]; float s = 0.f;
#pragma unroll
    for (int j = 0; j < 8; ++j) { const int c = 4 * lane + 256 * j;
        { const unsigned long long y = *(const unsigned long long*)(h2 + c); const unsigned lo = (unsigned)y, hi = (unsigned)(y >> 32);
          v[j] = (f32x4){__uint_as_float(lo << 16), __uint_as_float(lo & 0xffff0000u), __uint_as_float(hi << 16), __uint_as_float(hi & 0xffff0000u)}; }
#pragma unroll
        for (int k = 0; k < 4; ++k) { const unsigned y = *(const unsigned*)(yb + (size_t)k * DM + c); typedef float f2_t __attribute__((ext_vector_type(2)));
            const f2_t lo = __builtin_amdgcn_cvt_pk_f32_fp8((int)y, false), hi = __builtin_amdgcn_cvt_pk_f32_fp8((int)y, true);
            v[j].x += lo.x * (1.0f / 16.0f); v[j].y += lo.y * (1.0f / 16.0f); v[j].z += hi.x * (1.0f / 16.0f); v[j].w += hi.y * (1.0f / 16.0f); }
        s += (v[j].x * v[j].x + v[j].y * v[j].y) + (v[j].z * v[j].z + v[j].w * v[j].w); }
    const float rs = 1.0f / sqrtf(wave_sum(s) * (1.0f / DM) + EPS);
#pragma unroll
    for (int j = 0; j < 8; ++j) { const int c = 4 * lane + 256 * j; const f32x4 g = *(const f32x4*)(P.g_final + c);
        __builtin_nontemporal_store((f32x4){v[j].x * rs * g.x, v[j].y * rs * g.y, v[j].z * rs * g.z, v[j].w * rs * g.w}, (f32x4*)(orow + c)); }
}
#define LAS __attribute__((address_space(3)))
#define GAS __attribute__((address_space(1)))
typedef short bf16x8 __attribute__((ext_vector_type(8)));
typedef int v4i_t __attribute__((ext_vector_type(4)));
typedef GAS unsigned gu32;
#define RLX_AGENT __ATOMIC_RELAXED, __HIP_MEMORY_SCOPE_AGENT
constexpr int NWAVES = 8;
constexpr int RING_OFF = 0, RING_BYTES = 131072;
constexpr int TAB_OFF = 133 * 1024;
constexpr int MISC_OFF = 143 * 1024;
constexpr int LDS_BYTES = 147456;

namespace pg8 {
constexpr int BM = 256, BK = 64, HALF = 128, HTB = HALF * BK * 2, NXCD = 8, WGM = 8;
__host__ __device__ __forceinline__ int lds_byte(int r, int c) { const int st = (r >> 4) * 2 + (c >> 5), rr = r & 15, cc = c & 31, ob = rr * 64 + cc * 2; return st * 1024 + (ob ^ (((ob >> 9) & 1) << 5)); }
__host__ __device__ __forceinline__ void stage_rc(int b, int& R, int& C) { const int st = b / 1024, sb = b % 1024, swz = sb ^ (((sb >> 9) & 1) << 5); R = (st >> 1) * 16 + swz / 64; C = (st & 1) * 32 + (swz % 64) / 2; }
__host__ __device__ __forceinline__ void stage_rc_f8(int b, int& R, int& Cb) { const int s = b >> 4; R = s >> 3; const int q = s & 7; Cb = 16 * (q ^ ((R >> 1) & 7)); }
__host__ __device__ __forceinline__ int perm32(int rho) { const int n = rho >> 4, i = rho & 15; return 8 * (i >> 2) + 4 * n + (i & 3); }
__host__ __device__ __forceinline__ int perm32x(int i) { return 16 * ((i >> 2) & 1) + 4 * (i >> 3) + (i & 3); }
typedef float f32x16 __attribute__((ext_vector_type(16)));
template <bool F8> struct AccSel { typedef f32x4 T[2][2][4][2]; };
template <> struct AccSel<true> { typedef f32x16 T[2][2][2]; };
struct Unit { int pm, pn, aux; };
__device__ __forceinline__ unsigned cvt_pk_bf16(float lo, float hi) { unsigned r; asm volatile("v_cvt_pk_bf16_f32 %0, %1, %2" : "=v"(r) : "v"(lo), "v"(hi)); return r; }
__device__ __forceinline__ u32x4 pack8(const f32x4& a, const f32x4& b) { u32x4 w; w.x = cvt_pk_bf16(a[0], a[1]); w.y = cvt_pk_bf16(a[2], a[3]); w.z = cvt_pk_bf16(b[0], b[1]); w.w = cvt_pk_bf16(b[2], b[3]); return w; }

struct Order2D {
    int nM, nN, nwg, G, c;
    __device__ __forceinline__ void init(int nM_, int nN_, int G_, int c_) { nM = nM_; nN = nN_; nwg = nM * nN; G = G_; c = c_; }
    __device__ __forceinline__ bool next(int i, Unit& u) const {
        const long L = (long)i * G + c; if (L >= nwg) return false;
        int wgid = (int)L; { const int q = nwg / NXCD, r = nwg % NXCD, xcd = wgid % NXCD, off = wgid / NXCD; wgid = (xcd < r ? xcd * (q + 1) : r * (q + 1) + (xcd - r) * q) + off; }
        const int nig = WGM * nN, gid = wgid / nig, fm = gid * WGM, gsz = (nM - fm) < WGM ? (nM - fm) : WGM;
        u.pm = fm + ((wgid % nig) % gsz); u.pn = (wgid % nig) / gsz; u.aux = 0; return true;
    }
};

template <class Prob, bool ALIGN_EPI>
__device__ __forceinline__ void gemm_phase(LAS unsigned char* lds, const Prob& Pb, const int tid) {
    const int wid = __builtin_amdgcn_readfirstlane(tid >> 6), lane = tid & 63, wr = wid >> 2, wc = wid & 3, fr = lane & 15, fq = lane >> 4;
    constexpr bool F8 = Prob::F8;
    const int nt = F8 ? Pb.K / 128 : Pb.K / BK;
    constexpr bool GATHER = Prob::GATHER;
    int Rr[2], Cc[2]; unsigned voffB, voffA = 0u;
    { int R, C; if (F8) stage_rc_f8(tid * 16, R, C); else { stage_rc(tid * 16, R, C); C *= 2; }
      Rr[0] = R; Rr[1] = R + 64; Cc[0] = C; Cc[1] = C; const int Rb = (R & ~31) + (F8 ? perm32x(R & 31) : perm32(R & 31)); voffB = (unsigned)(Rb * Pb.ldbB + C);
      if constexpr (!GATHER) voffA = (unsigned)(R * Pb.ldaB + C); }
    const unsigned r64B = 64u * (unsigned)Pb.ldbB, r64A = GATHER ? 0u : 64u * (unsigned)Pb.ldaB;
    const unsigned kstep = 128u;
    const unsigned hstepB = (unsigned)HALF * Pb.ldbB;
    const unsigned ldsw = (unsigned)wid * 1024u;
    const int r32 = lane & 31, g32 = lane >> 5;
    const int aoff = F8 ? (wr * 64 + r32) * 128 + (((2 * g32) ^ ((r32 >> 1) & 7)) * 16) : lds_byte(wr * 64 + fr, fq * 8);
    const int boff = F8 ? (wc * 32 + r32) * 128 + (((2 * g32) ^ ((r32 >> 1) & 7)) * 16) : lds_byte(wc * 32 + fr, fq * 8);
    const int aoff8 = aoff, boff8 = boff;
#define PG8_SA(b, h) (((b) * 2 + (h)) * HTB)
#define PG8_SB(b, h) ((4 + (b) * 2 + (h)) * HTB)
    const __amdgpu_buffer_rsrc_t rsA = __builtin_amdgcn_make_buffer_rsrc((void*)Pb.A, 0, 0x7ffffffe, 0x00020000), rsB = __builtin_amdgcn_make_buffer_rsrc((void*)Pb.Bt, 0, 0x7ffffffe, 0x00020000);
#define PG8_STAGE_B(bufoff, so) do { \
        __builtin_amdgcn_raw_ptr_buffer_load_lds(rsB, (LAS unsigned*)(lds + (bufoff) + ldsw), 16, voffB, (int)(so), 0, 0); \
        __builtin_amdgcn_raw_ptr_buffer_load_lds(rsB, (LAS unsigned*)(lds + (bufoff) + ldsw + 8192), 16, voffB, (int)((so) + r64B), 0, 0); } while (0)
#define PG8_STAGE_A(bufoff, so, h) do { if constexpr (GATHER) { \
        __builtin_amdgcn_raw_ptr_buffer_load_lds(rsA, (LAS unsigned*)(lds + (bufoff) + ldsw), 16, (h) ? ca10 : ca00, (int)(so), 0, 0); \
        __builtin_amdgcn_raw_ptr_buffer_load_lds(rsA, (LAS unsigned*)(lds + (bufoff) + ldsw + 8192), 16, (h) ? ca11 : ca01, (int)(so), 0, 0); } else { \
        __builtin_amdgcn_raw_ptr_buffer_load_lds(rsA, (LAS unsigned*)(lds + (bufoff) + ldsw), 16, voffA, (int)((so) + (h) * 2u * r64A), 0, 0); \
        __builtin_amdgcn_raw_ptr_buffer_load_lds(rsA, (LAS unsigned*)(lds + (bufoff) + ldsw + 8192), 16, voffA, (int)((so) + (h) * 2u * r64A + r64A), 0, 0); } } while (0)
#define PG8_LDA(dst, b, h) do { if constexpr (F8) { _Pragma("unroll") for (int m = 0; m < 2; ++m) _Pragma("unroll") for (int k = 0; k < 2; ++k) { dst[m * 2 + k][0] = *(const LAS bf16x8*)(lds + PG8_SA(b, h) + m * 4096 + (aoff8 ^ (k * 64))); dst[m * 2 + k][1] = *(const LAS bf16x8*)(lds + PG8_SA(b, h) + m * 4096 + (aoff8 ^ (k * 64) ^ 16)); } } \
        else { _Pragma("unroll") for (int m = 0; m < 4; ++m) _Pragma("unroll") for (int k = 0; k < 2; ++k) dst[m][k] = *(const LAS bf16x8*)(lds + PG8_SA(b, h) + aoff + m * 2048 + k * 1024); } } while (0)
#define PG8_LDB(dst, b, h) do { if constexpr (F8) { _Pragma("unroll") for (int k = 0; k < 2; ++k) { dst[k][0] = *(const LAS bf16x8*)(lds + PG8_SB(b, h) + (boff8 ^ (k * 64))); dst[k][1] = *(const LAS bf16x8*)(lds + PG8_SB(b, h) + (boff8 ^ (k * 64) ^ 16)); } } \
        else { _Pragma("unroll") for (int n = 0; n < 2; ++n) _Pragma("unroll") for (int k = 0; k < 2; ++k) dst[n][k] = *(const LAS bf16x8*)(lds + PG8_SB(b, h) + boff + n * 2048 + k * 1024); } } while (0)
#define PG8_F8FRAG(x) __builtin_shufflevector(__builtin_bit_cast(v4i_t, x[0]), __builtin_bit_cast(v4i_t, x[1]), 0, 1, 2, 3, 4, 5, 6, 7)
#define PG8_MMA(ai, bj, At, Bt) do { __builtin_amdgcn_s_setprio(1); if constexpr (F8) { _Pragma("unroll") for (int k = 0; k < 2; ++k) _Pragma("unroll") for (int m = 0; m < 2; ++m) \
        acc[ai][bj][m] = __builtin_amdgcn_mfma_scale_f32_32x32x64_f8f6f4(PG8_F8FRAG(Bt[k]), PG8_F8FRAG(At[m * 2 + k]), acc[ai][bj][m], 0, 0, 0, 0, 0, 0); }     \
        else { _Pragma("unroll") for (int m = 0; m < 4; ++m) _Pragma("unroll") for (int n = 0; n < 2; ++n) _Pragma("unroll") for (int k = 0; k < 2; ++k) \
        acc[ai][bj][m][n] = __builtin_amdgcn_mfma_f32_16x16x32_bf16(Bt[n][k], At[m][k], acc[ai][bj][m][n], 0, 0, 0); } __builtin_amdgcn_s_setprio(0); } while (0)
#define PG8_WAIT_V(n) asm volatile("s_waitcnt vmcnt(" #n ")" ::: "memory")
#define PG8_WAIT_L(n) asm volatile("s_waitcnt lgkmcnt(" #n ")" ::: "memory")
#define PG8_BAR __builtin_amdgcn_s_barrier()
#define PG8_SCHED __builtin_amdgcn_sched_barrier(0)
    Unit cur, nxt; int ui = 0;
    if (!Pb.next(0, cur)) return;
    const unsigned ktm = (unsigned)nt - 1u;
    unsigned rc = Pb.rot(cur), rn = 0u;
    typename AccSel<F8>::T acc;
#define PG8_ZERO_ACC do { if constexpr (F8) { _Pragma("unroll") for (int a = 0; a < 2; ++a) _Pragma("unroll") for (int b = 0; b < 2; ++b) _Pragma("unroll") for (int m = 0; m < 2; ++m) _Pragma("unroll") for (int n = 0; n < 16; ++n) acc[a][b][m][n] = 0.f; } \
        else { _Pragma("unroll") for (int a = 0; a < 2; ++a) _Pragma("unroll") for (int b = 0; b < 2; ++b) _Pragma("unroll") for (int m = 0; m < 4; ++m) _Pragma("unroll") for (int n = 0; n < 2; ++n) acc[a][b][m][n] = (f32x4){0.f, 0.f, 0.f, 0.f}; } } while (0)
    PG8_ZERO_ACC;
    bf16x8 At[4][2], B0[2][2], B1[2][2];
    unsigned ca00 = 0, ca01 = 0, ca10 = 0, ca11 = 0;
    unsigned cA, nA;
    if constexpr (GATHER) { Pb.a_fetch(cur, lds, wid); asm volatile("s_waitcnt vmcnt(0)" ::: "memory"); __builtin_amdgcn_s_barrier(); }
    Pb.e_fetch(cur, lds, wid, 0);
    { unsigned o[2][2]; Pb.a_addr(cur, Rr, Cc, o, cA, lds); ca00 = o[0][0]; ca01 = o[0][1]; ca10 = o[1][0]; ca11 = o[1][1]; }
    unsigned cB = Pb.b_base(cur);
    { const unsigned k0 = (rc & ktm) * kstep;
    PG8_STAGE_B(PG8_SB(0, 0), cB + k0); PG8_STAGE_B(PG8_SB(0, 1), cB + k0 + hstepB); PG8_STAGE_A(PG8_SA(0, 0), cA + k0, 0); PG8_STAGE_A(PG8_SA(0, 1), cA + k0, 1);
    if (wr == 1) PG8_BAR;
    PG8_WAIT_V(2); PG8_BAR;
    PG8_STAGE_B(PG8_SB(1, 0), cB + k0 + kstep); PG8_STAGE_A(PG8_SA(1, 0), cA + k0 + kstep, 0); PG8_STAGE_B(PG8_SB(1, 1), cB + k0 + hstepB + kstep); }
    PG8_WAIT_V(6); PG8_BAR;
    for (;;) {
        const bool has_next = Pb.next(ui + 1, nxt);
        unsigned nB;
        if (has_next) { if constexpr (GATHER) Pb.a_fetch(nxt, lds, wid); else { unsigned o[2][2]; Pb.a_addr(nxt, Rr, Cc, o, nA, lds); } nB = Pb.b_base(nxt); rn = Pb.rot(nxt); }
        else { nA = cA; nB = cB; rn = rc; }
        for (int t = 0; t < nt; t += 2) {
            const bool last = (t == nt - 2);
            const unsigned a1 = cA + (((unsigned)(t + 1) + rc) & ktm) * kstep;
            PG8_LDB(B0, 0, 0); PG8_LDB(B1, 0, 1); PG8_SCHED; PG8_LDA(At, 0, 0); PG8_STAGE_A(PG8_SA(1, 1), a1, 1);
            PG8_WAIT_V(8); PG8_WAIT_L(0); PG8_BAR; PG8_MMA(0, 0, At, B0); PG8_MMA(0, 1, At, B1); PG8_BAR; PG8_SCHED;
            const unsigned k2 = last ? (rn & ktm) * kstep : (((unsigned)(t + 2) + rc) & ktm) * kstep;
            const unsigned a2 = (last ? nA : cA) + k2, b2 = (last ? nB : cB) + k2;
            const unsigned a3 = a2 + kstep, b3 = b2 + kstep;
            if constexpr (GATHER) { if (last && has_next) { unsigned o[2][2]; Pb.a_addr(nxt, Rr, Cc, o, nA, lds); ca00 = o[0][0]; ca01 = o[0][1]; ca10 = o[1][0]; ca11 = o[1][1]; } }
            PG8_LDA(At, 0, 1); PG8_STAGE_B(PG8_SB(0, 0), b2); PG8_STAGE_B(PG8_SB(0, 1), b2 + hstepB); PG8_STAGE_A(PG8_SA(0, 0), a2, 0);
            PG8_WAIT_V(8); PG8_WAIT_L(0); PG8_BAR; PG8_MMA(1, 0, At, B0); PG8_MMA(1, 1, At, B1); PG8_BAR; PG8_SCHED;
            PG8_LDB(B0, 1, 0); PG8_LDB(B1, 1, 1); PG8_SCHED; PG8_LDA(At, 1, 0); PG8_STAGE_A(PG8_SA(0, 1), a2, 1);
            PG8_WAIT_V(8); PG8_WAIT_L(0); PG8_BAR; PG8_MMA(0, 0, At, B0); PG8_MMA(0, 1, At, B1); PG8_BAR; PG8_SCHED;
            PG8_LDA(At, 1, 1); PG8_STAGE_B(PG8_SB(1, 0), b3); PG8_STAGE_B(PG8_SB(1, 1), b3 + hstepB); PG8_STAGE_A(PG8_SA(1, 0), a3, 0);
            PG8_WAIT_V(8); PG8_WAIT_L(0); PG8_BAR; PG8_MMA(1, 0, At, B0); PG8_MMA(1, 1, At, B1); PG8_BAR; PG8_SCHED;
        }
        if constexpr (ALIGN_EPI) { if (wr == 0) PG8_BAR; }
        { int tl = tid; asm volatile("" : "+v"(tl));
          const int ln = tl & 63; if constexpr (F8) Pb.epi(acc, cur, wr, wc, ln & 31, ln >> 5, lds + (ui & 1) * 3072); else Pb.epi(acc, cur, wr, wc, ln & 15, ln >> 4, lds + (ui & 1) * 3072); }
        if (!has_next) break;
        PG8_ZERO_ACC;
        if constexpr (F8) { _Pragma("unroll") for (int a = 0; a < 2; ++a) _Pragma("unroll") for (int b = 0; b < 2; ++b) asm volatile("" : "+v"(acc[a][b][0]), "+v"(acc[a][b][1])); }
        else { _Pragma("unroll") for (int a = 0; a < 2; ++a) _Pragma("unroll") for (int b = 0; b < 2; ++b) _Pragma("unroll") for (int m = 0; m < 4; ++m) asm volatile("" : "+v"(acc[a][b][m][0]), "+v"(acc[a][b][m][1])); }
        cur = nxt; cA = nA; cB = nB; rc = rn; ++ui;
        Pb.e_fetch(cur, lds, wid, ui & 1);
        if constexpr (ALIGN_EPI) { if (wr == 1) PG8_BAR; }
    }
    PG8_WAIT_V(0);
    if constexpr (!ALIGN_EPI) { if (wr == 0) PG8_BAR; }
    PG8_BAR;
#undef PG8_SA
#undef PG8_SB
#undef PG8_STAGE_A
#undef PG8_STAGE_B
#undef PG8_LDA
#undef PG8_LDB
#undef PG8_MMA
#undef PG8_F8FRAG
#undef PG8_ZERO_ACC
#undef PG8_WAIT_V
#undef PG8_WAIT_L
#undef PG8_BAR
#undef PG8_SCHED
}
}
namespace pg8 {
#define PG8_EPI_LOOP for (int ai = 0; ai < 2; ++ai) _Pragma("unroll") for (int m = 0; m < 4; ++m) _Pragma("unroll") for (int bj = 0; bj < 2; ++bj)
__device__ __forceinline__ void rope4(const float* rope, int pos, int i0, f32x4& a, f32x4& b) {
    const f32x4 c = *(const f32x4*)(rope + pos * 32 + i0), s = *(const f32x4*)(rope + LSEQ * 32 + pos * 32 + i0);
    const f32x4 r0 = {a[0] * c[0] - a[1] * s[0], a[1] * c[0] + a[0] * s[0], a[2] * c[1] - a[3] * s[1], a[3] * c[1] + a[2] * s[1]};
    const f32x4 r1 = {b[0] * c[2] - b[1] * s[2], b[1] * c[2] + b[0] * s[2], b[2] * c[3] - b[3] * s[3], b[3] * c[3] + b[2] * s[3]};
    a = r0; b = r1;
}
__device__ __forceinline__ float clamp448(float v) { return __builtin_amdgcn_fmed3f(v, -448.0f, 448.0f); }
__device__ __forceinline__ unsigned pack4_f8(float a, float b, float c, float d) { int w = 0; w = __builtin_amdgcn_cvt_pk_fp8_f32(clamp448(a), clamp448(b), w, false); w = __builtin_amdgcn_cvt_pk_fp8_f32(clamp448(c), clamp448(d), w, true); return (unsigned)w; }
__device__ __forceinline__ unsigned long long pack8_f8(const f32x4& a, const f32x4& b) { return (unsigned long long)pack4_f8(a[0], a[1], a[2], a[3]) | ((unsigned long long)pack4_f8(b[0], b[1], b[2], b[3]) << 32); }
struct DenseBase {
    static constexpr bool F8 = false, GATHER = false; static constexpr int scaleA = 0, scaleB = 0;
    const char* A; const char* Bt; int K, lda, ldb, ldaB, ldbB; Order2D ord;
    __device__ __forceinline__ bool next(int i, Unit& u) const { return ord.next(i, u); }
    __device__ __forceinline__ unsigned rot(const Unit&) const { return 0u; }
    __device__ __forceinline__ void e_fetch(const Unit&, LAS unsigned char*, int, int) const {}
    __device__ __forceinline__ void a_addr(const Unit& u, const int (&Rr)[2], const int (&Cc)[2], unsigned (&o)[2][2], unsigned& base, LAS unsigned char*) const {
        base = (unsigned)u.pm * 256u * (unsigned)lda * 2u;
#pragma unroll
        for (int h = 0; h < 2; ++h)
#pragma unroll
            for (int i = 0; i < 2; ++i) o[h][i] = (unsigned)((h * 128 + Rr[i]) * lda * 2 + Cc[i]);
    }
    __device__ __forceinline__ unsigned b_base(const Unit& u) const { return (unsigned)u.pn * 256u * (unsigned)ldb * 2u; }
};
struct ProbP1 : DenseBase {
    bf16_t* proj; bf16_t* kr; const float* rope; float* ssqp;
    __device__ __forceinline__ void epi(const f32x4 (&acc)[2][2][4][2], const Unit& u, int wr, int wc, int fr, int fq, LAS unsigned char*) const {
        float ssq_acc[2][4];
#pragma unroll
        for (int a = 0; a < 2; ++a)
#pragma unroll
            for (int b = 0; b < 4; ++b) ssq_acc[a][b] = 0.f;
#pragma unroll
        PG8_EPI_LOOP {
            const int row = u.pm * 256 + ai * 128 + wr * 64 + m * 16 + fr, col = u.pn * 256 + bj * 128 + wc * 32 + fq * 8;
            f32x4 v0 = acc[ai][bj][m][0], v1 = acc[ai][bj][m][1];
            if (u.pn >= 4 && u.pn < 7) { const float q = (v0[0] * v0[0] + v0[1] * v0[1]) + (v0[2] * v0[2] + v0[3] * v0[3]) + (v1[0] * v1[0] + v1[1] * v1[1]) + (v1[2] * v1[2] + v1[3] * v1[3]);
                ssq_acc[ai][m] += q; }
            if (col < 1792) { *(u32x4*)(proj + (size_t)row * DM + col) = pack8(v0, v1); }
            else if (col < INW) { const int pos = (row % LP) - PADR;
                if (pos >= 0) rope4(rope, pos, (col - 1792) >> 1, v0, v1); else { v0 = (f32x4){0.f, 0.f, 0.f, 0.f}; v1 = v0; }
                *(u32x4*)(kr + (size_t)row * 64 + (col - 1792)) = pack8(v0, v1); }
        }
        if (u.pn >= 4 && u.pn < 7) {
            const int slot = u.pn < 6 ? (u.pn - 4) * 4 + wc : 8 + wc;
#pragma unroll
            for (int ai = 0; ai < 2; ++ai)
#pragma unroll
                for (int m = 0; m < 4; ++m) { float q = ssq_acc[ai][m]; q += __shfl_xor(q, 16); q += __shfl_xor(q, 32);
                    if (fq == 0) ssqp[(size_t)(u.pm * 256 + ai * 128 + wr * 64 + m * 16 + fr) * 12 + slot] = q; }
        }
    }
};
struct ProbP2q : DenseBase {
    bf16_t* qb; const float* rsq; const float* rope;
    __device__ __forceinline__ void epi(const f32x4 (&acc)[2][2][4][2], const Unit& u, int wr, int wc, int fr, int fq, LAS unsigned char*) const {
        float rsv[2][4];
#pragma unroll
        for (int ai = 0; ai < 2; ++ai)
#pragma unroll
            for (int m = 0; m < 4; ++m) { const float* pp = rsq + (size_t)(u.pm * 256 + ai * 128 + wr * 64 + m * 16 + fr) * 12; const f32x4 a = *(const f32x4*)pp, b = *(const f32x4*)(pp + 4);
                rsv[ai][m] = C2 / sqrtf(((a[0] + a[1]) + (a[2] + a[3]) + (b[0] + b[1]) + (b[2] + b[3])) * (1.0f / QLORA) + EPS); }
#pragma unroll
        PG8_EPI_LOOP {
            const int row = u.pm * 256 + ai * 128 + wr * 64 + m * 16 + fr, col = u.pn * 256 + bj * 128 + wc * 32 + fq * 8;
            const float s = rsv[ai][m]; f32x4 v0 = acc[ai][bj][m][0] * s, v1 = acc[ai][bj][m][1] * s;
            const int dd = col % QKD;
            if (dd >= QKNOPE) { const int pos = (row % LP) - PADR; if (pos >= 0) rope4(rope, pos, (dd - QKNOPE) >> 1, v0, v1); else { v0 = (f32x4){0.f, 0.f, 0.f, 0.f}; v1 = v0; } }
            *(u32x4*)(qb + (size_t)row * 1536 + col) = pack8(v0, v1);
        }
    }
};
struct ProbP2kv : DenseBase {
    bf16_t* kn; bf16_t* vb; const float* rskv;
    __device__ __forceinline__ void epi(const f32x4 (&acc)[2][2][4][2], const Unit& u, int wr, int wc, int fr, int fq, LAS unsigned char*) const {
#pragma unroll
        PG8_EPI_LOOP {
            const int row = u.pm * 256 + ai * 128 + wr * 64 + m * 16 + fr, c = wc * 32 + fq * 8;
            const f32x4 pk = *(const f32x4*)(rskv + (size_t)row * 12 + 8); const float s = 1.0f / sqrtf(((pk[0] + pk[1]) + (pk[2] + pk[3])) * (1.0f / KVLORA) + EPS); const f32x4 v0 = acc[ai][bj][m][0] * s, v1 = acc[ai][bj][m][1] * s;
            bf16_t* dst = (bj == 0 ? kn : vb) + (size_t)row * 1024 + u.pn * 128 + c;
            *(u32x4*)dst = pack8(v0, v1);
        }
    }
};
struct ProbPool : DenseBase {
    bf16_t* mix; const float* pscale;
    __device__ __forceinline__ void a_addr(const Unit& u, const int (&Rr)[2], const int (&Cc)[2], unsigned (&o)[2][2], unsigned& base, LAS unsigned char*) const {
        base = ((unsigned)u.pm * 256u * (unsigned)lda + (unsigned)u.pn * 256u) * 2u;
#pragma unroll
        for (int h = 0; h < 2; ++h)
#pragma unroll
            for (int i = 0; i < 2; ++i) o[h][i] = (unsigned)((h * 128 + Rr[i]) * lda * 2 + Cc[i]);
    }
    __device__ __forceinline__ unsigned b_base(const Unit& u) const { return (unsigned)u.pn * 65536u * 2u; }
    __device__ __forceinline__ void epi(const f32x4 (&acc)[2][2][4][2], const Unit& u, int wr, int wc, int fr, int fq, LAS unsigned char*) const {
#pragma unroll
        PG8_EPI_LOOP {
            const int row = u.pm * 256 + ai * 128 + wr * 64 + m * 16 + fr, c = u.pn * 256 + bj * 128 + wc * 32 + fq * 8;
            const f32x4 p0 = *(const f32x4*)(pscale + c), p1 = *(const f32x4*)(pscale + c + 4);
            *(u32x4*)(mix + (size_t)row * DM + c) = pack8(acc[ai][bj][m][0] * p0, acc[ai][bj][m][1] * p1);
        }
    }
};
struct ProbP4 : DenseBase {
    const float* x; bf16_t* h2; unsigned char* h2f8;
    __device__ __forceinline__ void a_addr(const Unit& u, const int (&Rr)[2], const int (&Cc)[2], unsigned (&o)[2][2], unsigned& base, LAS unsigned char*) const {
        base = (unsigned)((u.pm >> 3) * LP + 64 + (u.pm & 7) * 256) * (unsigned)lda * 2u;
#pragma unroll
        for (int h = 0; h < 2; ++h)
#pragma unroll
            for (int i = 0; i < 2; ++i) o[h][i] = (unsigned)((h * 128 + Rr[i]) * lda * 2 + Cc[i]);
    }
    __device__ __forceinline__ void epi(const f32x4 (&acc)[2][2][4][2], const Unit& u, int wr, int wc, int fr, int fq, LAS unsigned char*) const {
#pragma unroll
        PG8_EPI_LOOP {
            const int r = u.pm * 256 + ai * 128 + wr * 64 + m * 16 + fr, c = u.pn * 256 + bj * 128 + wc * 32 + fq * 8;
            const size_t off = (size_t)r * DM + c;
            const f32x4 o0 = *(const f32x4*)(x + off) + acc[ai][bj][m][0], o1 = *(const f32x4*)(x + off + 4) + acc[ai][bj][m][1];
            *(u32x4*)(h2 + off) = pack8(o0, o1); *(unsigned long long*)(h2f8 + off) = pack8_f8(o0, o1);
        }
    }
};
}
namespace pg8 {
constexpr int TB_CNT = 64, TB_TE = 128, TB_TM = 416, TB_LIST = 768, TB_E0 = 1024, TB_E1 = 1280, TB_E2 = 1536;
__device__ __forceinline__ void moe_table(LAS unsigned char* lds, const unsigned* cnt, const int tid) {
    LAS int* tab = (LAS int*)(lds + TAB_OFF);
    __syncthreads();
    if (tid < NE) tab[TB_CNT + tid] = (int)__hip_atomic_load(cnt + tid, RLX_AGENT);
    __syncthreads();
    if (tid == 0) { int s = 0; for (int e = 0; e < NE; ++e) { tab[e] = s; s += (tab[TB_CNT + e] + 255) >> 8; } tab[NE] = s; }
    __syncthreads();
    if (tid < 288) { int e = 0; for (; e < NE - 1; ++e) if (tid < tab[e + 1]) break; tab[TB_TE + tid] = e; tab[TB_TM + tid] = tid - tab[e]; }
    __syncthreads();
}
#ifndef MOE_BT
#define MOE_BT 8
#endif
template <int NTN> struct MoeOrder {
    const LAS int* tab; int G, c, i0, i1;
    __device__ __forceinline__ bool next(int i_, Unit& u) const {
        const int i = i0 + i_; if (i >= i1) return false;
        const int cpx = G >> 3; const int F = (G & 7) ? i * G + c : (i * 8 + (c & 7)) * cpx + (c >> 3);
        const int ntile = __builtin_amdgcn_readfirstlane(tab[NE]); if (F >= ntile * NTN) return false;
        constexpr int BT = MOE_BT, PG = 32 / BT;
        const int blk = F / (BT * NTN), r = F - blk * (BT * NTN), nb = (ntile - blk * BT) < BT ? (ntile - blk * BT) : BT;
        int png, rr; if (nb == BT) { png = r / 32; rr = r & 31; } else { const int gs = nb * PG; png = r / gs; rr = r - png * gs; }
        const int T = blk * BT + rr / PG;
        u.aux = __builtin_amdgcn_readfirstlane(tab[TB_TE + T]); u.pm = __builtin_amdgcn_readfirstlane(tab[TB_TM + T]); u.pn = png * PG + (rr % PG); return true;
    }
};
constexpr int W_SCALE_LOG2 = 5, ACT_SCALE_LOG2 = 2, YB_SCALE_LOG2 = 4;
struct ProbP6 {
    static constexpr bool F8 = true, GATHER = true; static constexpr int ldaB = DM; static constexpr int scaleB = 0x01010101 * (127 - W_SCALE_LOG2), scaleA = 0x7f7f7f7f;
    const char* A; const char* Bt; int K, ldbB; MoeOrder<16> ord;
    const int* list; const float* rsl; const float* b1; unsigned char* act;
    __device__ __forceinline__ bool next(int i, Unit& u) const { return ord.next(i, u); }
    __device__ __forceinline__ unsigned rot(const Unit& u) const { return 0u; }
    __device__ __forceinline__ void a_fetch(const Unit& u, LAS unsigned char* lds, int wid) const {
        if (wid == 0) { const __amdgpu_buffer_rsrc_t rl = __builtin_amdgcn_make_buffer_rsrc((void*)list, 0, 0x7ffffffe, 0x00020000);
            __builtin_amdgcn_raw_ptr_buffer_load_lds(rl, (LAS unsigned*)(lds + TAB_OFF + TB_LIST * 4), 16, (threadIdx.x & 63) * 16, (int)(((unsigned)u.aux * (unsigned)MR + (unsigned)u.pm * 256u) * 4u), 0, 0); }
    }
    __device__ __forceinline__ void a_addr(const Unit& u, const int (&Rr)[2], const int (&Cc)[2], unsigned (&o)[2][2], unsigned& base, LAS unsigned char* lds) const {
        base = 0u; const int cnt_e = __builtin_amdgcn_readfirstlane(ord.tab[TB_CNT + u.aux]); const LAS int* lb = (const LAS int*)(lds + TAB_OFF) + TB_LIST; const int lastv = cnt_e - 1 - u.pm * 256;
#pragma unroll
        for (int h = 0; h < 2; ++h)
#pragma unroll
            for (int i = 0; i < 2; ++i) { int sl = h * 128 + Rr[i]; sl = sl < lastv ? sl : lastv; const int tok = lb[sl] >> 2; o[h][i] = (unsigned)tok * (unsigned)DM + (unsigned)Cc[i]; }
    }
    __device__ __forceinline__ void e_fetch(const Unit& u, LAS unsigned char* lds, int wid, int par) const {
        lds += par * 3072;
        if (wid == 1) { const __amdgpu_buffer_rsrc_t r = __builtin_amdgcn_make_buffer_rsrc((void*)rsl, 0, 0x7ffffffe, 0x00020000);
            __builtin_amdgcn_raw_ptr_buffer_load_lds(r, (LAS unsigned*)(lds + TAB_OFF + TB_E0 * 4), 16, (threadIdx.x & 63) * 16, (int)(((unsigned)u.aux * (unsigned)MR + (unsigned)u.pm * 256u) * 4u), 0, 0); }
        if (wid == 2) { const __amdgpu_buffer_rsrc_t r = __builtin_amdgcn_make_buffer_rsrc((void*)b1, 0, 0x7ffffffe, 0x00020000);
            __builtin_amdgcn_raw_ptr_buffer_load_lds(r, (LAS unsigned*)(lds + TAB_OFF + TB_E1 * 4), 16, (threadIdx.x & 63) * 16, (int)(((unsigned)u.aux * 4096u + (unsigned)u.pn * 256u) * 4u), 0, 0); }
    }
    __device__ __forceinline__ unsigned b_base(const Unit& u) const { return ((unsigned)u.aux * 4096u + (unsigned)u.pn * 256u) * (unsigned)DM; }
    __device__ __forceinline__ void epi(const f32x16 (&acc)[2][2][2], const Unit& u, int wr, int wc, int r32, int hi, LAS unsigned char* lds) const {
        const LAS float* rsb = (const LAS float*)(lds + TAB_OFF) + TB_E0; const LAS float* bb1 = (const LAS float*)(lds + TAB_OFF) + TB_E1;
        const int cnt_e = __builtin_amdgcn_readfirstlane(ord.tab[TB_CNT + u.aux]), rbase = __builtin_amdgcn_readfirstlane(ord.tab[u.aux]) * 256;
        constexpr float AS = (float)(1 << ACT_SCALE_LOG2), NC = -1.702f * 1.4426950408889634f;
#pragma unroll
        for (int bj = 0; bj < 2; ++bj) {
            f32x4 bg[2], bl[2];
#pragma unroll
            for (int h = 0; h < 2; ++h) { const LAS float* bp = bb1 + bj * 128 + wc * 32 + hi * 16 + h * 8; const f32x4 x0 = *(const LAS f32x4*)bp, x1 = *(const LAS f32x4*)(bp + 4);
                bg[h] = (f32x4){x0[0], x0[2], x1[0], x1[2]}; bl[h] = (f32x4){x0[1], x0[3], x1[1], x1[3]}; }
#pragma unroll
            for (int ai = 0; ai < 2; ++ai)
#pragma unroll
                for (int m = 0; m < 2; ++m) {
                    const int slot = u.pm * 256 + ai * 128 + wr * 64 + m * 32 + r32; const bool valid = slot < cnt_e;
                    const float rs = valid ? rsb[ai * 128 + wr * 64 + m * 32 + r32] * (1.0f / (float)(1 << W_SCALE_LOG2)) : 0.f;
                    const f32x16 a = acc[ai][bj][m];
                    unsigned w2[2];
#pragma unroll
                    for (int h = 0; h < 2; ++h) {
                        f32x4 g = (f32x4){a[8 * h + 0], a[8 * h + 2], a[8 * h + 4], a[8 * h + 6]} * rs + bg[h], l = (f32x4){a[8 * h + 1], a[8 * h + 3], a[8 * h + 5], a[8 * h + 7]} * rs + bl[h];
#pragma unroll
                        for (int q = 0; q < 4; ++q) { g[q] = fminf(g[q], 7.0f); l[q] = __builtin_amdgcn_fmed3f(l[q], -7.0f, 7.0f); }
                        f32x4 e = g * NC, lp = l * AS + AS;
#pragma unroll
                        for (int q = 0; q < 4; ++q) e[q] = __builtin_amdgcn_rcpf(1.0f + __builtin_amdgcn_exp2f(e[q]));
                        const f32x4 o = (g * e) * lp;
                        int w = 0; w = __builtin_amdgcn_cvt_pk_fp8_f32(o[0], o[1], w, false); w = __builtin_amdgcn_cvt_pk_fp8_f32(o[2], o[3], w, true); w2[h] = (unsigned)w;
                    }
                    if (valid) *(unsigned long long*)(act + (size_t)(rbase + slot) * DFF + u.pn * 128 + bj * 64 + wc * 16 + hi * 8) = (unsigned long long)w2[0] | ((unsigned long long)w2[1] << 32);
                }
        }
    }
};
struct ProbP7 {
    static constexpr bool F8 = true, GATHER = false; static constexpr int ldaB = DFF; static constexpr int scaleB = 0x01010101 * (127 - W_SCALE_LOG2), scaleA = 0x01010101 * (127 - ACT_SCALE_LOG2);
    const char* A; const char* Bt; int K, ldbB; MoeOrder<8> ord;
    const int* list; const float* gate; const float* b2; unsigned char* yb;
    __device__ __forceinline__ bool next(int i, Unit& u) const { return ord.next(i, u); }
    __device__ __forceinline__ unsigned rot(const Unit& u) const { return 0u; }
    __device__ __forceinline__ void a_addr(const Unit& u, const int (&Rr)[2], const int (&Cc)[2], unsigned (&o)[2][2], unsigned& base, LAS unsigned char*) const {
        base = (unsigned)(__builtin_amdgcn_readfirstlane(ord.tab[u.aux]) + u.pm) * 256u * (unsigned)DFF;
#pragma unroll
        for (int h = 0; h < 2; ++h)
#pragma unroll
            for (int i = 0; i < 2; ++i) o[h][i] = (unsigned)((h * 128 + Rr[i]) * DFF + Cc[i]);
    }
    __device__ __forceinline__ void e_fetch(const Unit& u, LAS unsigned char* lds, int wid, int par) const {
        lds += par * 3072;
        const int so = (int)(((unsigned)u.aux * (unsigned)MR + (unsigned)u.pm * 256u) * 4u);
        if (wid == 1) { const __amdgpu_buffer_rsrc_t r = __builtin_amdgcn_make_buffer_rsrc((void*)gate, 0, 0x7ffffffe, 0x00020000);
            __builtin_amdgcn_raw_ptr_buffer_load_lds(r, (LAS unsigned*)(lds + TAB_OFF + TB_E0 * 4), 16, (threadIdx.x & 63) * 16, so, 0, 0); }
        if (wid == 2) { const __amdgpu_buffer_rsrc_t r = __builtin_amdgcn_make_buffer_rsrc((void*)b2, 0, 0x7ffffffe, 0x00020000);
            __builtin_amdgcn_raw_ptr_buffer_load_lds(r, (LAS unsigned*)(lds + TAB_OFF + TB_E1 * 4), 16, (threadIdx.x & 63) * 16, (int)(((unsigned)u.aux * (unsigned)DM + (unsigned)u.pn * 256u) * 4u), 0, 0); }
        if (wid == 3) { const __amdgpu_buffer_rsrc_t r = __builtin_amdgcn_make_buffer_rsrc((void*)list, 0, 0x7ffffffe, 0x00020000);
            __builtin_amdgcn_raw_ptr_buffer_load_lds(r, (LAS unsigned*)(lds + TAB_OFF + TB_E2 * 4), 16, (threadIdx.x & 63) * 16, so, 0, 0); }
    }
    __device__ __forceinline__ unsigned b_base(const Unit& u) const { return ((unsigned)u.aux * (unsigned)DM + (unsigned)u.pn * 256u) * (unsigned)DFF; }
    __device__ __forceinline__ void epi(const f32x16 (&acc)[2][2][2], const Unit& u, int wr, int wc, int r32, int hi, LAS unsigned char* lds) const {
        const int cnt_e = __builtin_amdgcn_readfirstlane(ord.tab[TB_CNT + u.aux]);
        const LAS float* gtb = (const LAS float*)(lds + TAB_OFF) + TB_E0; const LAS float* bb2 = (const LAS float*)(lds + TAB_OFF) + TB_E1; const LAS int* idb = (const LAS int*)(lds + TAB_OFF) + TB_E2;
        const int col = u.pn * 256 + wc * 32 + hi * 16;
        typedef unsigned long long u64x2 __attribute__((ext_vector_type(2)));
#pragma unroll
        for (int bj = 0; bj < 2; ++bj) {
            f32x4 bb[4];
#pragma unroll
            for (int q = 0; q < 4; ++q) bb[q] = *(const LAS f32x4*)(bb2 + bj * 128 + wc * 32 + hi * 16 + q * 4);
#pragma unroll
            for (int ai = 0; ai < 2; ++ai)
#pragma unroll
                for (int m = 0; m < 2; ++m) {
                    const int rl = ai * 128 + wr * 64 + m * 32 + r32, slot = u.pm * 256 + rl; const bool valid = slot < cnt_e;
                    const int id = valid ? idb[rl] : 0; const float g = valid ? gtb[rl] : 0.f, gs = g * (1.0f / (float)(1 << (W_SCALE_LOG2 + ACT_SCALE_LOG2)));
                    const f32x16 a = acc[ai][bj][m];
                    f32x4 y[4];
#pragma unroll
                    for (int q = 0; q < 4; ++q) y[q] = ((f32x4){a[4 * q], a[4 * q + 1], a[4 * q + 2], a[4 * q + 3]} * gs + bb[q] * g) * (float)(1 << YB_SCALE_LOG2);
                    if (valid) { u64x2 w; w.x = pack8_f8(y[0], y[1]); w.y = pack8_f8(y[2], y[3]); *(u64x2*)(yb + (size_t)id * DM + col + bj * 128) = w; }
                }
        }
    }
};
}
namespace att {
using f32x16 = __attribute__((ext_vector_type(16))) float;
using s16x4 = __attribute__((ext_vector_type(4))) short;
constexpr int SHM_V = 16384, SHM_KN = 16384, SHM_KR = 8192, SHM_BUF = SHM_V + SHM_KN + SHM_KR, NBUF = 3, WS_OFF = NBUF * SHM_BUF;
#define ATT_SBAR() __builtin_amdgcn_sched_barrier(0)
__device__ __forceinline__ int crow(int r, int hi) { return (r & 3) + 8 * (r >> 2) + 4 * hi; }
__device__ __forceinline__ unsigned cvtpk(float lo, float hi) { unsigned r; asm volatile("v_cvt_pk_bf16_f32 %0, %1, %2" : "=v"(r) : "v"(lo), "v"(hi)); return r; }
__device__ __forceinline__ int v_st(int k, int c) { const int kk = (k & ~0xC) | ((k & 4) << 1) | ((k & 8) >> 1); return ((kk >> 3) * 4 + (c >> 5)) * 512 + ((kk & 7) * 32 + (c & 31)) * 2; }
__device__ __forceinline__ int v_rd_base(int lane) { return ((lane & 3) << 3) | (((lane >> 2) & 3) << 6) | (((lane >> 4) & 1) << 5) | (((lane >> 5) & 1) << 8); }
constexpr int v_rd_off(int d0, int ks, int half) { return d0 * 512 + ks * 4096 + half * 2048; }
template <int OFF> __device__ __forceinline__ s16x4 tr_read(int vb) { s16x4 r; asm volatile("ds_read_b64_tr_b16 %0, %1 offset:%2" : "=&v"(r) : "v"(vb), "i"(OFF) : "memory"); return r; }
template <int D0> __device__ __forceinline__ void pv_one(f32x16& od, int vb, bf16x8 pa0, bf16x8 pa1, bf16x8 pa2, bf16x8 pa3) {
    const s16x4 l0 = tr_read<v_rd_off(D0, 0, 0)>(vb), h0 = tr_read<v_rd_off(D0, 0, 1)>(vb), l1 = tr_read<v_rd_off(D0, 1, 0)>(vb), h1 = tr_read<v_rd_off(D0, 1, 1)>(vb);
    const s16x4 l2 = tr_read<v_rd_off(D0, 2, 0)>(vb), h2 = tr_read<v_rd_off(D0, 2, 1)>(vb), l3 = tr_read<v_rd_off(D0, 3, 0)>(vb), h3 = tr_read<v_rd_off(D0, 3, 1)>(vb);
    asm volatile("s_waitcnt lgkmcnt(0)" ::: "memory"); ATT_SBAR();
#define ATT_PK(L, H) (bf16x8){L[0], L[1], L[2], L[3], H[0], H[1], H[2], H[3]}
    od = __builtin_amdgcn_mfma_f32_32x32x16_bf16(pa0, ATT_PK(l0, h0), od, 0, 0, 0);
    od = __builtin_amdgcn_mfma_f32_32x32x16_bf16(pa1, ATT_PK(l1, h1), od, 0, 0, 0);
    od = __builtin_amdgcn_mfma_f32_32x32x16_bf16(pa2, ATT_PK(l2, h2), od, 0, 0, 0);
    od = __builtin_amdgcn_mfma_f32_32x32x16_bf16(pa3, ATT_PK(l3, h3), od, 0, 0, 0);
#undef ATT_PK
}
template <int D0, int HK> __device__ __forceinline__ void pv_half(f32x16& od, int vb, bf16x8 pa0, bf16x8 pa1) {
    const s16x4 l0 = tr_read<v_rd_off(D0, 2 * HK, 0)>(vb), h0 = tr_read<v_rd_off(D0, 2 * HK, 1)>(vb), l1 = tr_read<v_rd_off(D0, 2 * HK + 1, 0)>(vb), h1 = tr_read<v_rd_off(D0, 2 * HK + 1, 1)>(vb);
    asm volatile("s_waitcnt lgkmcnt(0)" ::: "memory"); ATT_SBAR();
#define ATT_PK(L, H) (bf16x8){L[0], L[1], L[2], L[3], H[0], H[1], H[2], H[3]}
    od = __builtin_amdgcn_mfma_f32_32x32x16_bf16(pa0, ATT_PK(l0, h0), od, 0, 0, 0);
    od = __builtin_amdgcn_mfma_f32_32x32x16_bf16(pa1, ATT_PK(l1, h1), od, 0, 0, 0);
#undef ATT_PK
}
__device__ __forceinline__ void attn_unit(int b, int h, int u, const bf16_t* __restrict__ QB, const bf16_t* __restrict__ KN, const bf16_t* __restrict__ KR, const bf16_t* __restrict__ VB,
                                          bf16_t* __restrict__ MIX, LAS char* lds, const int tid) {
    const int wid = tid >> 6, lane = tid & 63, r32 = lane & 31, hi = lane >> 5;
    const int qc = (0x22331100u >> (4 * wid)) & 3, half = wid & 1;
    const int c0 = 4 * u - 3, ntw = c0 + qc + 1, ntmax = 4 * u + 1;
    const size_t rowb = (size_t)b * LP;
    const int qrow0 = 64 * (c0 + qc) + 32 * half;
    LAS float* wsf = (LAS float*)(lds + WS_OFF) + wid * 64; LAS float* li_l = wsf; LAS float* al_l = wsf + 32;
    bf16x8 qr[12];
    { const bf16_t* Qw = QB + (rowb + qrow0 + r32) * 1536 + h * QKD + hi * 8;
#pragma unroll
      for (int d0 = 0; d0 < 12; ++d0) qr[d0] = *(const bf16x8*)(Qw + d0 * 16); }
    unsigned gk0, gv0, gr;
    { const int w = wid;
      { const int row = 32 * (w & 1) + (lane >> 1), hh = (lane & 1) ^ ((row >> 3) & 1);
        gk0 = (unsigned)(row * 1024 + h * 128 + (w >> 1) * 16 + hh * 8); gr = (unsigned)(row * 64 + (w >> 1) * 16 + hh * 8); }
      { const int st = 4 * w + (lane >> 5), kk = (st >> 2) * 8 + ((lane >> 2) & 7), k = (kk & ~0xC) | ((kk & 4) << 1) | ((kk & 8) >> 1), c = (st & 3) * 32 + (lane & 3) * 8; gv0 = (unsigned)(k * 1024 + h * 128 + c); } }
    const bf16_t* KNb = KN + rowb * 1024; const bf16_t* VBb = VB + rowb * 1024; const bf16_t* KRb = KR + rowb * 64;
    const unsigned wq = (unsigned)wid * 2048u, wk = (unsigned)wid * 1024u;
    const int kb0 = (int)(uintptr_t)lds + SHM_V + r32 * 32 + ((hi ^ ((r32 >> 3) & 1)) << 4);
    const int vb0 = (int)(uintptr_t)lds + v_rd_base(lane);
#define ATT_DMA(gp, lp) __builtin_amdgcn_global_load_lds((const unsigned*)(gp), (LAS unsigned*)(lp), 16, 0, 0)
#define ATT_STAGE(j_, bf_) do { LAS char* bb_ = lds + (bf_) * SHM_BUF; const size_t ko_ = (size_t)(j_) * 64; \
    ATT_DMA(KNb + ko_ * 1024 + gk0, bb_ + SHM_V + wk); ATT_DMA(KNb + ko_ * 1024 + gk0 + 64, bb_ + SHM_V + 8192 + wk); \
    ATT_DMA(VBb + ko_ * 1024 + gv0, bb_ + wq); ATT_DMA(VBb + ko_ * 1024 + gv0 + 64, bb_ + wq + 1024); ATT_DMA(KRb + ko_ * 64 + gr, bb_ + SHM_V + 16384 + wk); } while (0)
#define ATT_WAIT_BAR(N) asm volatile("s_waitcnt vmcnt(" #N ") lgkmcnt(0)\n\ts_barrier" ::: "memory")
    float m_reg = -1e30f, l_reg = 0.f; f32x16 o[4];
#pragma unroll
    for (int d = 0; d < 4; ++d)
#pragma unroll
        for (int r = 0; r < 16; ++r) o[d][r] = 0.f;
    ATT_STAGE(0, 0); if (ntmax > 1) { ATT_STAGE(1, 1); ATT_WAIT_BAR(5); } else { ATT_WAIT_BAR(0); }
    int bf = 0;
    for (int j = 0; j < ntmax; ++j) {
        const int bf2 = bf == 0 ? 2 : bf - 1;
        const bool st2 = j + 2 < ntmax;
        if (st2) ATT_STAGE(j + 2, bf2);
        if (j < ntw) {
            const int vb = vb0 + bf * SHM_BUF, kb = kb0 + bf * SHM_BUF;
#pragma unroll
            for (int hk = 0; hk < 2; ++hk) {
                if (j == 0 && hk == 0) continue;
                f32x16 p0;
#pragma unroll
                for (int r = 0; r < 16; ++r) p0[r] = 0.f;
#pragma unroll
                for (int d0 = 0; d0 < 12; ++d0) {
                    const bf16x8 b0 = *(const LAS bf16x8*)(uintptr_t)(unsigned)(kb + d0 * 2048 + hk * 1024);
                    p0 = __builtin_amdgcn_mfma_f32_32x32x16_bf16(b0, qr[d0], p0, 0, 0, 0); }
                if (j == 0) {
#pragma unroll
                    for (int r = 0; r < 8; ++r) p0[r] = -1e30f;
                }
                float pmax = p0[0];
#pragma unroll
                for (int r = 1; r < 16; ++r) pmax = fmaxf(pmax, p0[r]);
                { auto sw = __builtin_amdgcn_permlane32_swap(__float_as_uint(pmax), __float_as_uint(pmax), false, false); pmax = fmaxf(__uint_as_float(sw[0]), __uint_as_float(sw[1])); }
                float mn, alpha;
                if (__all(pmax - m_reg <= 8.0f)) { mn = m_reg; alpha = 1.f; }
                else { mn = fmaxf(m_reg, pmax); alpha = __builtin_amdgcn_exp2f(m_reg - mn); m_reg = mn; }
                float ps = 0.f;
#pragma unroll
                for (int r = 0; r < 16; ++r) { p0[r] = __builtin_amdgcn_exp2f(p0[r] - mn); ps += p0[r]; }
                { auto sw = __builtin_amdgcn_permlane32_swap(__float_as_uint(ps), __float_as_uint(ps), false, false); ps = __uint_as_float(sw[0]) + __uint_as_float(sw[1]); }
                l_reg = l_reg * alpha + ps;
                bf16x8 pa0, pa1;
#define ATT_PK4(Pv, BASE, OUT) do { unsigned a0 = cvtpk(Pv[BASE + 0], Pv[BASE + 1]), a1 = cvtpk(Pv[BASE + 2], Pv[BASE + 3]); \
    unsigned b0_ = cvtpk(Pv[BASE + 4], Pv[BASE + 5]), b1_ = cvtpk(Pv[BASE + 6], Pv[BASE + 7]); \
    auto r0 = __builtin_amdgcn_permlane32_swap(a0, b0_, false, false); auto r1 = __builtin_amdgcn_permlane32_swap(a1, b1_, false, false); \
    u32x4 w = {r0[0], r1[0], r0[1], r1[1]}; OUT = *reinterpret_cast<bf16x8*>(&w); } while (0)
                ATT_PK4(p0, 0, pa0); ATT_PK4(p0, 8, pa1);
#undef ATT_PK4
                if (__any(alpha < 1.f)) { if (hi == 0) al_l[r32] = alpha; asm volatile("s_waitcnt lgkmcnt(0)" ::: "memory");
#pragma unroll
                    for (int d = 0; d < 4; ++d)
#pragma unroll
                        for (int r = 0; r < 16; ++r) o[d][r] *= al_l[crow(r, hi)]; }
                if (hk == 0) { pv_half<0, 0>(o[0], vb, pa0, pa1); pv_half<1, 0>(o[1], vb, pa0, pa1); pv_half<2, 0>(o[2], vb, pa0, pa1); pv_half<3, 0>(o[3], vb, pa0, pa1); }
                else         { pv_half<0, 1>(o[0], vb, pa0, pa1); pv_half<1, 1>(o[1], vb, pa0, pa1); pv_half<2, 1>(o[2], vb, pa0, pa1); pv_half<3, 1>(o[3], vb, pa0, pa1); }
            }
        }
        if (st2) ATT_WAIT_BAR(5); else ATT_WAIT_BAR(0);
        bf = bf == 2 ? 0 : bf + 1;
    }
    if (hi == 0) li_l[r32] = l_reg;
    asm volatile("s_waitcnt lgkmcnt(0)" ::: "memory");
    bf16_t* Ow = MIX + (rowb + qrow0) * DM + POOLW + h * 128 + r32;
#pragma unroll
    for (int r = 0; r < 16; ++r) { const int orow = crow(r, hi); const float rli = __builtin_amdgcn_rcpf(li_l[orow]);
#pragma unroll
        for (int d0 = 0; d0 < 4; ++d0) Ow[(size_t)orow * DM + d0 * 32] = (bf16_t)f2bf(o[d0][r] * rli); }
#undef ATT_DMA
#undef ATT_STAGE
#undef ATT_WAIT_BAR
}
__device__ __forceinline__ void attn_phase(const unsigned char* ws, unsigned char* wsw, LAS char* lds, int G, int bx, const int tid) {
    const bf16_t* QB = (const bf16_t*)(ws + WS_QB); const bf16_t* KN = (const bf16_t*)(ws + WS_KN); const bf16_t* KR = (const bf16_t*)(ws + WS_KR); const bf16_t* VB = (const bf16_t*)(ws + WS_VB);
    bf16_t* MIX = (bf16_t*)(wsw + WS_MIX);
    for (int c = bx; c < 256; c += G) {
        const int x = c & 7, y = c >> 3, bh = 8 * (y >> 2) + x, p = y & 3, b = bh >> 3, h = bh & 7;
#pragma unroll 1
        for (int k = 0; k < 2; ++k) attn_unit(b, h, k == 0 ? 8 - p : 1 + p, QB, KN, KR, VB, MIX, lds, tid);
    }
}
}
#define XB_TMO      128
#define XB_XCNT(j)  (256  + 64 * (j))
#define XB_XSUB(j)  (1280 + 64 * (j))
#define XB_XGEN(j)  (2304 + 64 * (j))
#define XB_TOP      3328
#define XB_TOPGEN   3392
#define XCD_BAR_WORDS 3456
#define XB_SPIN_CAP (1u << 18)
__device__ __forceinline__ unsigned xb_ld(unsigned* p)              { return __hip_atomic_load(p, __ATOMIC_RELAXED, __HIP_MEMORY_SCOPE_AGENT); }
__device__ __forceinline__ unsigned xb_add(unsigned* p, unsigned v) { return __hip_atomic_fetch_add(p, v, __ATOMIC_RELAXED, __HIP_MEMORY_SCOPE_AGENT); }
__device__ __forceinline__ unsigned xb_xcc_id() { return (unsigned)__builtin_amdgcn_s_getreg((3 << 11) | 20) & 0xFu; }
#define XB_SPIN(cond, bar) do { unsigned _sp = 0; while (cond) { __builtin_amdgcn_s_sleep(1); \
    if ((++_sp & 255u) == 0u) { if (xb_ld(&(bar)[XB_TMO])) break; if (_sp > XB_SPIN_CAP) { atomicAdd(&(bar)[XB_TMO], 1u); break; } } } } while (0)
struct XcdBarrier { unsigned* bar; unsigned x; volatile LAS unsigned* st; };
__device__ __forceinline__ XcdBarrier xcd_barrier_post(unsigned* bar, volatile LAS unsigned* st) {
    XcdBarrier b; b.bar = bar; b.x = xb_xcc_id(); b.st = st;
    if (threadIdx.x == 0) (void)xb_add(&bar[XB_XCNT(b.x)], 1u);
    return b;
}
__device__ __forceinline__ void xcd_barrier_complete(unsigned* bar, unsigned x, unsigned& nloc, unsigned& nx) {
    const unsigned G = gridDim.x * gridDim.y * gridDim.z;
    unsigned sum, cnt, mine, sp = 0u;
    for (;;) {
        sum = 0u; cnt = 0u; mine = 0u;
#pragma unroll
        for (unsigned j = 0; j < 16; ++j) { const unsigned c = xb_ld(&bar[XB_XCNT(j)]); sum += c; cnt += (c > 0u) ? 1u : 0u; mine = (j == x) ? c : mine; }
        if (sum == G) break;
        __builtin_amdgcn_s_sleep(1);
        if ((++sp & 255u) == 0u) { if (xb_ld(&bar[XB_TMO])) break; if (sp > XB_SPIN_CAP) { atomicAdd(&bar[XB_TMO], 1u); break; } }
    }
    nloc = mine > 0u ? mine : 1u; nx = cnt > 0u ? cnt : 1u;
}
__device__ __forceinline__ void xcd_barrier(const XcdBarrier& b) {
    asm volatile("s_waitcnt vmcnt(0)" ::: "memory");
    __syncthreads();
    if (threadIdx.x == 0) {
        unsigned* bar = b.bar;
        __builtin_amdgcn_s_waitcnt(0);
        unsigned nloc = b.st[0], nx = b.st[1];
        if (nloc == 0u) { xcd_barrier_complete(bar, b.x, nloc, nx); b.st[0] = nloc; b.st[1] = nx; }
        const unsigned old = xb_add(&bar[XB_XSUB(b.x)], 1u);
        const unsigned gen = old / nloc;
        if (old + 1u == (gen + 1u) * nloc) {
            __builtin_amdgcn_fence(__ATOMIC_RELEASE, "agent");
            asm volatile("s_waitcnt vmcnt(0)" ::: "memory");
            const unsigned og = xb_add(&bar[XB_TOP], 1u);
            const unsigned tg = og / nx;
            if (og + 1u == (tg + 1u) * nx) xb_add(&bar[XB_TOPGEN], 1u);
            else XB_SPIN(xb_ld(&bar[XB_TOPGEN]) == tg, bar);
            __builtin_amdgcn_fence(__ATOMIC_ACQUIRE, "agent");
            xb_add(&bar[XB_XGEN(b.x)], 1u);
            asm volatile("s_waitcnt vmcnt(0)" ::: "memory");
        } else {
            XB_SPIN(xb_ld(&bar[XB_XGEN(b.x)]) == gen, bar);
            __builtin_amdgcn_fence(__ATOMIC_ACQUIRE, "agent");
            asm volatile("s_waitcnt vmcnt(0)" ::: "memory");
        }
    }
    __syncthreads();
}
constexpr int CW_BAR = 4096;

constexpr int CVS_P1 = 0, CVS_P2 = 3072, CVS_P3 = 4352, CVS_P3B = 8192, CVS_P4 = 8448, CVS_P6 = 11776;
static_assert(CVS_P1 + 16 * 7 + 80 * 13 + 160 * 12 == CVS_P2 && CVS_P2 + 140 * 4 + 24 * 7 + 92 * 6 == CVS_P3 && CVS_P3 + 256 * 15 == CV_ITEMS_W1 && CVS_P3B == CV_ITEMS_W1 && CVS_P3B + 256 == CVS_P4 && CVS_P4 + 256 * 13 == CVS_P6 && CVS_P6 + 512 == CV_ITEMS, "conversion plan");
constexpr int PH_P0 = 0, PH_P1 = 1, PH_P1B = 2, PH_P2 = 3, PH_P3 = 4, PH_P4 = 5, PH_P5 = 6, PH_P6 = 7, PH_P7 = 8, PH_P8 = 9, PH_END = 10;
struct Args { Ptrs P; int ph_lo, ph_hi, use_bar, pad; };
#define CAS __attribute__((address_space(4)))
__device__ __forceinline__ void load_ptrs(const CAS Args* a, Ptrs& P) { P.x = a->P.x; P.meta = a->P.meta; P.g_attn = a->P.g_attn; P.w_in = a->P.w_in; P.g_q = a->P.g_q; P.w_uq = a->P.w_uq; P.g_kv = a->P.g_kv; P.w_ukv = a->P.w_ukv; P.pool_w = a->P.pool_w; P.pool_scale = a->P.pool_scale; P.w_o = a->P.w_o; P.g_ffn = a->P.g_ffn; P.w_router = a->P.w_router; P.b_router = a->P.b_router; P.w1 = a->P.w1; P.b1 = a->P.b1; P.w2 = a->P.w2; P.b2 = a->P.b2; P.g_final = a->P.g_final; P.out = a->P.out; P.ws = a->P.ws; }
__global__ void __launch_bounds__(NWAVES * 64, 2) mk_fwd(Args args) {
    extern __shared__ __attribute__((aligned(16))) unsigned char lds_raw[];
    LAS unsigned char* lds = (LAS unsigned char*)lds_raw;
    const int G = gridDim.x, bx = blockIdx.x;
#define PHASE_IDS int tid; asm volatile("v_mov_b32 %0, %1" : "=v"(tid) : "v"(threadIdx.x)); const int lane = tid & 63, wave = __builtin_amdgcn_readfirstlane(tid >> 6); \
    const long gw = (long)bx * NWAVES + wave, NGW = (long)G * NWAVES; (void)lane; (void)gw; (void)NGW; \
    const CAS Args* ap_ = (const CAS Args*)__builtin_amdgcn_kernarg_segment_ptr(); asm volatile("" : "+s"(ap_)); Ptrs P; load_ptrs(ap_, P); unsigned char* const ws = P.ws
    volatile LAS unsigned* MISC = (volatile LAS unsigned*)(lds + MISC_OFF);
    if (threadIdx.x < 64) MISC[threadIdx.x] = 0u;
    __syncthreads();
    XcdBarrier bar; bar.bar = (unsigned*)(args.P.ws + WS_CTL) + CW_BAR; bar.x = 0; bar.st = nullptr;
    if (args.use_bar) bar = xcd_barrier_post((unsigned*)(args.P.ws + WS_CTL) + CW_BAR, MISC + 8);
    const int lo = args.ph_lo, hi = args.ph_hi;
#define IN(k) (lo <= (k) && (k) < hi)
    const bool cv_first = ((bx >> 3) & 1) != 0;
#define CV_CALL(W1, F, S, N) do { const CAS Args* ap2_ = (const CAS Args*)__builtin_amdgcn_kernarg_segment_ptr(); asm volatile("" : "+s"(ap2_)); Ptrs Pc_; load_ptrs(ap2_, Pc_); cv_slice<W1>(Pc_, lds_raw, tid, (F), (S), (N)); } while (0)
#define CV_DEAL(W1, S, ca, ka, cb, kb, kc) do { if (G == 256) { int f_, s_, n_; if (bx < (ca)) { f_ = (S) + bx; s_ = (ca); n_ = (ka); } else if (bx < (cb)) { f_ = (S) + (ca) * (ka) + (bx - (ca)); s_ = (cb) - (ca); n_ = (kb); } \
        else { f_ = (S) + (ca) * (ka) + ((cb) - (ca)) * (kb) + (bx - (cb)); s_ = 256 - (cb); n_ = (kc); } CV_CALL(W1, f_, s_, n_); } \
    else { const int tot_ = (ca) * (ka) + ((cb) - (ca)) * (kb) + (256 - (cb)) * (kc); for (int it_ = (S) + bx; it_ < (S) + tot_; it_ += G) CV_CALL(W1, it_, 0, 1); } } while (0)
#define CV_SLICE(W1, S, N) CV_DEAL(W1, S, 0, 0, 0, 0, N)
#define SEAM(k) do { if (IN(k) && IN((k) + 1)) xcd_barrier(bar); } while (0)

    if (IN(PH_P0)) { PHASE_IDS;
        float* scr = (float*)lds_raw + wave * (64 * 65);
        for (long it = gw; it < I_TOTAL; it += NGW) p0_item(P, it, scr, lane);
        for (long p = gw; p < MP; p += NGW) p0_hn_row(P, (int)p, lane);
        { u32x4* z = (u32x4*)(ws + WS_WIN + (size_t)INW * DM * 2); const long n16 = (long)(DM - INW) * DM * 2 / 16;
          for (long i = (long)bx * 512 + tid; i < n16; i += (long)G * 512) z[i] = (u32x4){0u, 0u, 0u, 0u}; }
        { float* ct = (float*)(ws + WS_ROPE); float* st = ct + LSEQ * 32;
          for (long i = (long)bx * 512 + tid; i < LSEQ * 32; i += (long)G * 512) { const int pos = (int)(i / 32), j = (int)(i % 32);
              const float inv = 1.0f / powf(10000.0f, (float)(2 * j) / 64.0f); const float ang = (float)pos * inv; ct[i] = cosf(ang); st[i] = sinf(ang); } }
        { float* wr = (float*)(ws + WS_WR);
          for (long i = (long)bx * 512 + tid; i < DM * NE; i += (long)G * 512) { const int k = (int)(i / NE), e = (int)(i % NE); wr[((k >> 2) * NE + e) * 4 + (k & 3)] = P.w_router[i] * P.g_ffn[k]; } }
        __syncthreads();
    }
    SEAM(PH_P0);
    if (IN(PH_P1)) { PHASE_IDS;
        pg8::ProbP1 pb; pb.A = (const char*)(ws + WS_HN); pb.Bt = (const char*)(ws + WS_WIN); pb.K = DM; pb.lda = DM; pb.ldaB = 2 * DM; pb.ldb = DM; pb.ldbB = 2 * DM; pb.ord.init(MP / 256, 8, G, bx);
        pb.proj = (bf16_t*)(ws + WS_PROJ); pb.kr = (bf16_t*)(ws + WS_KR); pb.rope = (const float*)(ws + WS_ROPE); pb.ssqp = (float*)(ws + WS_RSQ);
        if (cv_first) CV_DEAL(true, CVS_P1, 16, 7, 96, 13, 12);
        pg8::gemm_phase<pg8::ProbP1, true>(lds + RING_OFF, pb, tid);
        if (!cv_first) CV_DEAL(true, CVS_P1, 16, 7, 96, 13, 12);
    }
    if (IN(PH_P1) && IN(PH_P2)) xcd_barrier(bar);
    if (IN(PH_P2)) { PHASE_IDS;
        for (long m = gw; m < MP; m += NGW) p1b_row(P, (int)m, lane);
        if (cv_first) CV_DEAL(true, CVS_P2, 140, 4, 164, 7, 6);
        { pg8::ProbP2q pb; pb.A = (const char*)(ws + WS_PROJ) + 1024 * 2; pb.Bt = (const char*)(ws + WS_WUQ); pb.K = QLORA; pb.lda = DM; pb.ldaB = 2 * DM; pb.ldb = QLORA; pb.ldbB = 2 * QLORA; pb.ord.init(MP / 256, 6, G, bx);
          pb.qb = (bf16_t*)(ws + WS_QB); pb.rsq = (const float*)(ws + WS_RSQ); pb.rope = (const float*)(ws + WS_ROPE);
          pg8::gemm_phase<pg8::ProbP2q, true>(lds + RING_OFF, pb, tid); }
        { pg8::ProbP2kv pb; pb.A = (const char*)(ws + WS_PROJ) + 1536 * 2; pb.Bt = (const char*)(ws + WS_WUKV); pb.K = KVLORA; pb.lda = DM; pb.ldaB = 2 * DM; pb.ldb = KVLORA; pb.ldbB = 2 * KVLORA; pb.ord.init(MP / 256, 8, G, (bx + 116) % G);
          pb.kn = (bf16_t*)(ws + WS_KN); pb.vb = (bf16_t*)(ws + WS_VB); pb.rskv = (const float*)(ws + WS_RSQ);
          pg8::gemm_phase<pg8::ProbP2kv, true>(lds + RING_OFF, pb, tid); }
        if (!cv_first) CV_DEAL(true, CVS_P2, 140, 4, 164, 7, 6);
    }
    SEAM(PH_P2);
    if (IN(PH_P3)) { PHASE_IDS;
        if (cv_first) { CV_SLICE(true, CVS_P3, 15); CV_SLICE(false, CVS_P3B, 1); }
        att::attn_phase(ws, ws, (LAS char*)(lds + RING_OFF), G, bx, tid);
        { pg8::ProbPool pb; pb.A = (const char*)(ws + WS_DP); pb.Bt = (const char*)(ws + WS_WPOOL); pb.K = 256; pb.lda = POOLW; pb.ldaB = 2 * POOLW; pb.ldb = 256; pb.ldbB = 2 * 256; pb.ord.init(MP / 256, 4, G, bx);
          pb.mix = (bf16_t*)(ws + WS_MIX); pb.pscale = P.pool_scale;
          pg8::gemm_phase<pg8::ProbPool, true>(lds + RING_OFF, pb, tid); }
        if (!cv_first) { CV_SLICE(true, CVS_P3, 15); CV_SLICE(false, CVS_P3B, 1); }
    }
    SEAM(PH_P3);
    if (IN(PH_P4)) { PHASE_IDS;
        pg8::ProbP4 pb; pb.A = (const char*)(ws + WS_MIX); pb.Bt = (const char*)(ws + WS_WO); pb.K = DM; pb.lda = DM; pb.ldaB = 2 * DM; pb.ldb = DM; pb.ldbB = 2 * DM; pb.ord.init(MR / 256, 8, G, bx);
        pb.x = P.x; pb.h2 = (bf16_t*)(ws + WS_HN); pb.h2f8 = ws + WS_H2B;
        pg8::gemm_phase<pg8::ProbP4, true>(lds + RING_OFF, pb, tid);
    }
    SEAM(PH_P4);
    if (IN(PH_P5)) { PHASE_IDS; for (int blk = bx; blk < MR / 64; blk += G) p5_block(P, blk, lds_raw, tid); }
    SEAM(PH_P5);
    if (IN(PH_P6)) { PHASE_IDS;
        pg8::moe_table(lds, (const unsigned*)(ws + WS_CTL) + CW_CNT, tid);
        pg8::ProbP6 pb; pb.A = (const char*)(ws + WS_H2B); pb.Bt = (const char*)(ws + WS_W1); pb.K = DM; pb.ldbB = DM; pb.ord.tab = (const LAS int*)(lds + TAB_OFF); pb.ord.G = G; pb.ord.c = bx;
        pb.list = (const int*)(ws + WS_LIST); pb.rsl = (const float*)(ws + WS_RSL); pb.b1 = P.b1; pb.act = ws + WS_ACT;
        const int split = 2 + 4 * ((bx >> 3) & 3);
        pb.ord.i0 = 0; pb.ord.i1 = split;
        pg8::gemm_phase<pg8::ProbP6, true>(lds + RING_OFF, pb, tid);
        CV_SLICE(false, CVS_P4, 13);
        pb.ord.i0 = split; pb.ord.i1 = 0x7fffffff;
        pg8::gemm_phase<pg8::ProbP6, true>(lds + RING_OFF, pb, tid);
        { const int U = ((const LAS int*)(lds + TAB_OFF))[NE] * 16, R = U % G, nidle = G - R, rank0 = (G & 7) ? bx : (bx & 7) * (G >> 3) + (bx >> 3);
          const bool few = nidle < 64; const int nshare = few ? G : nidle, rank = few ? rank0 : rank0 - R;
          if (rank >= 0) { const int cnt_ = (CV_ITEMS - CVS_P6 - rank + nshare - 1) / nshare; CV_CALL(false, CVS_P6 + rank, nshare, cnt_); } }
    }
    SEAM(PH_P6);
    if (IN(PH_P7)) { PHASE_IDS;
        pg8::moe_table(lds, (const unsigned*)(ws + WS_CTL) + CW_CNT, tid);
        pg8::ProbP7 pb; pb.A = (const char*)(ws + WS_ACT); pb.Bt = (const char*)(ws + WS_W2); pb.K = DFF; pb.ldbB = DFF; pb.ord.tab = (const LAS int*)(lds + TAB_OFF); pb.ord.G = G; pb.ord.c = bx; pb.ord.i0 = 0; pb.ord.i1 = 0x7fffffff;
        pb.list = (const int*)(ws + WS_LIST); pb.gate = (const float*)(ws + WS_GATE); pb.b2 = P.b2; pb.yb = ws + WS_YB;
        pg8::gemm_phase<pg8::ProbP7, true>(lds + RING_OFF, pb, tid);
    }
    SEAM(PH_P7);
    if (IN(PH_P8)) { PHASE_IDS; for (long r = gw; r < MR; r += NGW) p8_row(P, (int)r, lane, P.out); }
#undef IN
#undef SEAM
}

extern "C" void kernel_launch(void* const* d_in, const int* in_sizes, int n_in, void* d_out, int out_size, void* d_ws, size_t ws_size, hipStream_t stream) {
    static int ok = 0; static int grid = 256;
    if (ok == 0) {
        if (n_in != 19 || in_sizes[0] != NB * SEQ * DM || out_size != MR * DM || ws_size < WS_END) { fprintf(stderr, "kernel_launch: shape mismatch n_in %d in0 %d out %d ws %zu\n", n_in, n_in > 0 ? in_sizes[0] : -1, out_size, ws_size); ok = -1; return; }
        if (hipFuncSetAttribute((const void*)mk_fwd, hipFuncAttributeMaxDynamicSharedMemorySize, LDS_BYTES) != hipSuccess) { fprintf(stderr, "hipFuncSetAttribute(mk) failed\n"); ok = -1; return; }
        int dev = 0, cus = 0; (void)hipGetDevice(&dev); (void)hipDeviceGetAttribute(&cus, hipDeviceAttributeMultiprocessorCount, dev); if (cus > 0) grid = cus;
        ok = 1;
    }
    if (ok < 0) return;
    Ptrs P{};
    const float** pp = (const float**)&P;
    for (int i = 0; i < 19; ++i) pp[i] = (const float*)d_in[i];
    P.out = (float*)d_out; P.ws = (unsigned char*)d_ws;
    unsigned char* ws = (unsigned char*)d_ws;
    (void)hipMemsetAsync(ws + WS_CTL, 0, CTL_ZERO_BYTES, stream);
    { Args a{}; a.P = P; a.ph_lo = 0; a.ph_hi = PH_END; a.use_bar = 1; a.pad = 0;
      hipLaunchKernelGGL(mk_fwd, dim3(grid), dim3(NWAVES * 64), LDS_BYTES, stream, a); }
}
```

```cpp
#include <hip/hip_runtime.h>
#include <cstdint>
#include <cstdio>

constexpr int NB = 8, SEQ = 2048, NMETA = 16, LSEQ = 2064, LP = 2112, PADR = 48, MP = NB * LP, MR = NB * SEQ;
constexpr int DM = 2048, POOLW = 1024, QLORA = 512, KVLORA = 256, QKROPE = 64, QKNOPE = 128, VDIM = 128, NH = 8, QKD = 192;
constexpr int INW = 1856, NE = 32, TOPK = 4, DFF = 2048;
constexpr float EPS = 1e-5f;
constexpr float C2 = 0.07216878364870322f * 1.4426950408889634f;
constexpr int ACT_ROWS = MR * TOPK + NE * 256;

typedef unsigned short bf16_t;
typedef unsigned u32x4 __attribute__((ext_vector_type(4)));
typedef float f32x4 __attribute__((ext_vector_type(4)));

constexpr size_t MiB = 1u << 20;
constexpr size_t WS_CTL = 0, CTL_ZERO_BYTES = 1 * MiB;
constexpr size_t WS_ROPE = 1 * MiB;
constexpr size_t WS_WR = 2 * MiB;
constexpr size_t WS_WIN = 4 * MiB;
constexpr size_t WS_WUQ = 12 * MiB;
constexpr size_t WS_WUKV = 14 * MiB;
constexpr size_t WS_WPOOL = 15 * MiB;
constexpr size_t WS_WO = 16 * MiB;
constexpr size_t WS_W1 = 24 * MiB;
constexpr size_t WS_W2 = 536 * MiB;
constexpr size_t WS_HN = 792 * MiB;
constexpr size_t WS_PROJ = 860 * MiB;
constexpr size_t WS_QB = 928 * MiB;
constexpr size_t WS_KN = 980 * MiB;
constexpr size_t WS_VB = 1014 * MiB;
constexpr size_t WS_KR = 1048 * MiB;
constexpr size_t WS_RSQ = 1051 * MiB;
constexpr size_t WS_RSKV = 1052 * MiB;
constexpr size_t WS_RS2 = 1053 * MiB;
constexpr size_t WS_DP = 1054 * MiB;
constexpr size_t WS_MIX = 1088 * MiB;
constexpr int MIX_SCALE_LOG2 = 3, WO_SCALE_LOG2 = 5;
constexpr size_t WS_H2B = 1156 * MiB;
constexpr size_t WS_LIST = 1220 * MiB;
constexpr size_t WS_GATE = 1222 * MiB;
constexpr size_t WS_ACT = 1224 * MiB;
constexpr size_t WS_YB = 1512 * MiB;
constexpr size_t WS_RSL = 1768 * MiB;
constexpr size_t WS_END = 1770 * MiB;
constexpr int CW_CNT = 64;

struct Ptrs {
    const float *x, *meta, *g_attn, *w_in, *g_q, *w_uq, *g_kv, *w_ukv, *pool_w, *pool_scale, *w_o, *g_ffn, *w_router, *b_router, *w1, *b1, *w2, *b2, *g_final;
    float* out; unsigned char* ws;
};

__device__ __forceinline__ float bf2f(bf16_t v) { return __uint_as_float((unsigned)v << 16); }
__device__ __forceinline__ unsigned f2bf(float f) { unsigned u = __float_as_uint(f); return (u + 0x7fffu + ((u >> 16) & 1u)) >> 16; }
__device__ __forceinline__ unsigned pk2(float lo, float hi) { return f2bf(lo) | (f2bf(hi) << 16); }
__device__ __forceinline__ float wave_sum(float v) {
#pragma unroll
    for (int o = 1; o < 64; o <<= 1) v += __shfl_xor(v, o);
    return v;
}
__device__ __forceinline__ float wave_max(float v) {
#pragma unroll
    for (int o = 1; o < 64; o <<= 1) v = fmaxf(v, __shfl_xor(v, o));
    return v;
}

__device__ __forceinline__ void p0_hn_row(const Ptrs& P, int p, int lane) {
    bf16_t* hn = (bf16_t*)(P.ws + WS_HN) + (size_t)p * DM;
    const int b = p / LP, q = p % LP;
    unsigned long long* o8 = (unsigned long long*)hn + lane;
    if (q < PADR) {
#pragma unroll
        for (int j = 0; j < 8; ++j) o8[64 * j] = 0ull;
        return;
    }
    const int pos = q - PADR;
    const float* src = pos < NMETA ? P.meta + (size_t)pos * DM : P.x + ((size_t)b * SEQ + (pos - NMETA)) * DM;
    const f32x4* xr = (const f32x4*)src + lane;
    const f32x4* gr = (const f32x4*)P.g_attn + lane;
    f32x4 v[8]; float s = 0.f;
#pragma unroll
    for (int j = 0; j < 8; ++j) { v[j] = xr[64 * j]; s += (v[j].x * v[j].x + v[j].y * v[j].y) + (v[j].z * v[j].z + v[j].w * v[j].w); }
    const float rs = 1.0f / sqrtf(wave_sum(s) * (1.0f / DM) + EPS);
#pragma unroll
    for (int j = 0; j < 8; ++j) { const f32x4 g = gr[64 * j];
        o8[64 * j] = (unsigned long long)pk2(v[j].x * rs * g.x, v[j].y * rs * g.y) | ((unsigned long long)pk2(v[j].z * rs * g.z, v[j].w * rs * g.w) << 32); }
}
template <int MODE> __device__ __forceinline__ int nmap(int n) {
    if (MODE == 1) { if (n >= 1792) { const int j = n - 1792; return 1792 + (j < 32 ? 2 * j : 2 * (j - 32) + 1); } return n; }
    if (MODE == 2) { const int h = n / 192, d = n % 192; if (d >= 128) { const int j = d - 128; return h * 192 + 128 + (j < 32 ? 2 * j : 2 * (j - 32) + 1); } return n; }
    return n;
}
template <int MODE> __device__ __forceinline__ void p0_transpose_item(const float* W, int K, int N, bf16_t* WT, const float* gk, float* scr, int item, int lane) {
    const int nblk = N / 64, kb = item / nblk, nb = item % nblk, k0 = 64 * kb, n0 = 64 * nb;
    const int kl = lane >> 4, nl = (lane & 15) * 4;
#pragma unroll 4
    for (int i = 0; i < 16; ++i) { const int kk = kl + 4 * i; const f32x4 v = *(const f32x4*)(W + (size_t)(k0 + kk) * N + n0 + nl);
        const float g = gk ? gk[k0 + kk] : 1.0f;
        float* s = scr + kk * 65 + nl; s[0] = v.x * g; s[1] = v.y * g; s[2] = v.z * g; s[3] = v.w * g; }
    __builtin_amdgcn_s_waitcnt(0xc07f); asm volatile("" ::: "memory");
    const int c = lane & 7;
#pragma unroll
    for (int j = 0; j < 8; ++j) { const int n = (lane >> 3) + 8 * j; const float* s = scr + (8 * c) * 65 + n;
        u32x4 o; o.x = pk2(s[0 * 65], s[1 * 65]); o.y = pk2(s[2 * 65], s[3 * 65]); o.z = pk2(s[4 * 65], s[5 * 65]); o.w = pk2(s[6 * 65], s[7 * 65]);
        *(u32x4*)(WT + (size_t)nmap<MODE>(n0 + n) * K + k0 + 8 * c) = o; }
    __builtin_amdgcn_s_waitcnt(0xc07f); asm volatile("" ::: "memory");
}
__device__ __forceinline__ void p0_transpose_item_f8(const float* W, int K, int N, unsigned char* WT, const float* gk, float scale, float* scr, int item, int lane) {
    const int nblk = N / 64, kb = item / nblk, nb = item % nblk, k0 = 64 * kb, n0 = 64 * nb;
    const int kl = lane >> 4, nl = (lane & 15) * 4;
#pragma unroll 4
    for (int i = 0; i < 16; ++i) { const int kk = kl + 4 * i; const f32x4 v = *(const f32x4*)(W + (size_t)(k0 + kk) * N + n0 + nl);
        const float g = (gk ? gk[k0 + kk] : 1.0f) * scale;
        float* s = scr + kk * 65 + nl; s[0] = v.x * g; s[1] = v.y * g; s[2] = v.z * g; s[3] = v.w * g; }
    asm volatile("s_waitcnt lgkmcnt(0)" ::: "memory");
    const int c = lane & 7;
#pragma unroll
    for (int j = 0; j < 8; ++j) { const int n = (lane >> 3) + 8 * j; const float* s = scr + (8 * c) * 65 + n;
        int w0 = 0, w1 = 0;
        w0 = __builtin_amdgcn_cvt_pk_fp8_f32(s[0 * 65], s[1 * 65], w0, false); w0 = __builtin_amdgcn_cvt_pk_fp8_f32(s[2 * 65], s[3 * 65], w0, true);
        w1 = __builtin_amdgcn_cvt_pk_fp8_f32(s[4 * 65], s[5 * 65], w1, false); w1 = __builtin_amdgcn_cvt_pk_fp8_f32(s[6 * 65], s[7 * 65], w1, true);
        *(unsigned long long*)(WT + (size_t)(n0 + n) * K + k0 + 8 * c) = (unsigned long long)(unsigned)w0 | ((unsigned long long)(unsigned)w1 << 32); }
    asm volatile("s_waitcnt lgkmcnt(0)" ::: "memory");
}
constexpr int CV_ITEMS_W1 = NE * (DM / 128) * (4096 / 256), CV_ITEMS_W2 = NE * (DFF / 128) * (DM / 256), CV_ITEMS = CV_ITEMS_W1 + CV_ITEMS_W2;
struct CvItem { const float* src; unsigned char* dst; const float* gk; };
__device__ __forceinline__ const __attribute__((address_space(4))) float* cv_uniform_cptr(const float* p) {
    const unsigned long long v = (unsigned long long)p; const unsigned lo = __builtin_amdgcn_readfirstlane((unsigned)v), hi = __builtin_amdgcn_readfirstlane((unsigned)(v >> 32));
    return (const __attribute__((address_space(4))) float*)(((unsigned long long)hi << 32) | lo); }
template <bool W1> __device__ __forceinline__ CvItem cv_decode(const Ptrs& P, int it) {
    CvItem c;
    if (W1) { const int e = it >> 8, r = it & 255, kb = r >> 4, nb = r & 15;
        c.src = P.w1 + (size_t)e * DM * 4096 + (size_t)kb * 128 * 4096 + nb * 256; c.dst = P.ws + WS_W1 + ((size_t)e * 4096 + nb * 256) * DM + kb * 128; c.gk = P.g_ffn + kb * 128; }
    else { const int j = it - CV_ITEMS_W1, e = j >> 7, r = j & 127, kb = r >> 3, nb = r & 7;
        c.src = P.w2 + (size_t)e * DFF * DM + (size_t)kb * 128 * DM + nb * 256; c.dst = P.ws + WS_W2 + ((size_t)e * DM + nb * 256) * DFF + kb * 128; c.gk = nullptr; }
    return c;
}
#define CV_LOAD(V, C, VALID) do { const __amdgpu_buffer_rsrc_t rs_ = __builtin_amdgcn_make_buffer_rsrc((void*)(C).src, 0, (VALID) ? 0x7ffffffe : 0, 0x00020000);     \
        _Pragma("unroll") for (int i_ = 0; i_ < 16; ++i_) V[i_] = __builtin_bit_cast(f32x4, __builtin_amdgcn_raw_buffer_load_b128(rs_, lane * 16, (wave + 8 * i_) * NN * 4, 2  )); } while (0)
#define CV_PROCESS(V, C, NEXT_IDX) do { \
        const __attribute__((address_space(4))) float* gk_ = cv_uniform_cptr((C).gk);     \
          \
        _Pragma("unroll") for (int i_ = 0; i_ < 16; ++i_) { const int k_ = wave + 8 * i_; const float g_ = W1 ? gk_[k_] * 32.0f : 32.0f; \
            *(f32x4*)(scr + k_ * 256 + ((lane * 4) ^ (((i_ >> 1) & 3) << 3))) = V[i_] * g_; } \
        unsigned char* dst_ = (C).dst; \
        asm volatile("" ::: "memory"); __builtin_amdgcn_sched_barrier(0);     \
        { const int nx_ = (NEXT_IDX) < count ? (NEXT_IDX) : count - 1; (C) = cv_decode<W1>(P, first + nx_ * step); CV_LOAD(V, C, (NEXT_IDX) < count); } \
        asm volatile("s_waitcnt lgkmcnt(0)\n\ts_barrier" ::: "memory"); \
          \
        _Pragma("unroll") for (int p_ = 0; p_ < 4; ++p_) { const int u_ = p_ * 8 + wave, nn_ = (u_ >> 1) * 16 + (lane >> 2), k0_ = (u_ & 1) * 64 + (lane & 3) * 16; \
            const float* t_ = scr + k0_ * 256 + (nn_ ^ ((lane & 3) << 3)); u32x4 w_;     \
            _Pragma("unroll") for (int d_ = 0; d_ < 4; ++d_) { int x_ = 0; x_ = __builtin_amdgcn_cvt_pk_fp8_f32(t_[(4 * d_) * 256], t_[(4 * d_ + 1) * 256], x_, false); \
                x_ = __builtin_amdgcn_cvt_pk_fp8_f32(t_[(4 * d_ + 2) * 256], t_[(4 * d_ + 3) * 256], x_, true); w_[d_] = (unsigned)x_; } \
            *(u32x4*)(dst_ + (size_t)nn_ * DM + k0_) = w_; __builtin_amdgcn_sched_barrier(0); } \
        asm volatile("s_waitcnt lgkmcnt(0)\n\ts_barrier" ::: "memory"); } while (0)
template <bool W1> __device__ __forceinline__ void cv_slice(const Ptrs& P, unsigned char* ldsg, int tid, int first, int step, int count) {
    if (count <= 0) return;
    constexpr int NN = W1 ? 4096 : DM;
    float* scr = (float*)ldsg;
    const int lane = tid & 63, wave = __builtin_amdgcn_readfirstlane(tid >> 6);
    f32x4 va[16], vb[16];
    CvItem ca = cv_decode<W1>(P, first), cb = cv_decode<W1>(P, first + (count > 1 ? step : 0));
    CV_LOAD(va, ca, true); CV_LOAD(vb, cb, count > 1);
    int n = 0;
    for (; n + 1 < count; n += 2) { CV_PROCESS(va, ca, n + 2); CV_PROCESS(vb, cb, n + 3); }
    if (n < count) CV_PROCESS(va, ca, n + 2);
    asm volatile("s_waitcnt vmcnt(0)" ::: "memory");
}
#undef CV_LOAD
#undef CV_PROCESS
constexpr int I_WIN = (DM / 64) * (INW / 64), I_WUQ = (QLORA / 64) * (1536 / 64), I_WUKV = (KVLORA / 64) * (2048 / 64), I_POOL1 = 4 * 4, I_WO = 32 * 32,
              I_W1E = (DM / 64) * (4096 / 64), I_W2E = 32 * 32;
constexpr int I_SMALL = I_WIN + I_WUQ + I_WUKV + 4 * I_POOL1 + I_WO;
constexpr long I_TOTAL = (long)I_SMALL;
__device__ __forceinline__ void p0_item(const Ptrs& P, long it, float* scr, int lane) {
    unsigned char* ws = P.ws;
    if (it < I_SMALL) {
        int r = (int)it;
        if (r < I_WIN) { p0_transpose_item<1>(P.w_in, DM, INW, (bf16_t*)(ws + WS_WIN), nullptr, scr, r, lane); return; } r -= I_WIN;
        if (r < I_WUQ) { p0_transpose_item<2>(P.w_uq, QLORA, 1536, (bf16_t*)(ws + WS_WUQ), P.g_q, scr, r, lane); return; } r -= I_WUQ;
        if (r < I_WUKV) { p0_transpose_item<0>(P.w_ukv, KVLORA, 2048, (bf16_t*)(ws + WS_WUKV), P.g_kv, scr, r, lane); return; } r -= I_WUKV;
        if (r < 4 * I_POOL1) { const int g = r / I_POOL1; p0_transpose_item<0>(P.pool_w + (size_t)g * 65536, 256, 256, (bf16_t*)(ws + WS_WPOOL) + (size_t)g * 65536, nullptr, scr, r % I_POOL1, lane); return; } r -= 4 * I_POOL1;
        p0_transpose_item_f8(P.w_o, DM, DM, ws + WS_WO, nullptr, (float)(1 << WO_SCALE_LOG2), scr, r, lane); return;
    }
    it -= I_SMALL;
    if (it < (long)NE * I_W1E) { const int e = (int)(it / I_W1E), r = (int)(it % I_W1E);
        p0_transpose_item_f8(P.w1 + (size_t)e * DM * 4096, DM, 4096, ws + WS_W1 + (size_t)e * 4096 * DM, P.g_ffn, 32.0f, scr, r, lane); return; }
    it -= (long)NE * I_W1E;
    { const int e = (int)(it / I_W2E), r = (int)(it % I_W2E);
      p0_transpose_item_f8(P.w2 + (size_t)e * DFF * DM, DFF, DM, ws + WS_W2 + (size_t)e * DM * DFF, nullptr, 32.0f, scr, r, lane); }
}
__device__ __forceinline__ void st4bf(bf16_t* p, float a, float b, float c, float d) { *(unsigned long long*)p = (unsigned long long)pk2(a, b) | ((unsigned long long)pk2(c, d) << 32); }
__device__ __forceinline__ void p1b_row(const Ptrs& P, int m, int lane) {
    const bf16_t* proj = (const bf16_t*)(P.ws + WS_PROJ);
    const bf16_t* row = proj + (size_t)m * DM;
    bf16_t* dp = (bf16_t*)(P.ws + WS_DP) + (size_t)m * POOLW;
    const int pos = (m % LP) - PADR;
    if (pos < 0) {
#pragma unroll
        for (int g = 0; g < 4; ++g) *(unsigned long long*)(dp + g * 256 + lane * 4) = 0ull;
        return;
    }
    unsigned long long ld[30];
    { int q = 0;
#pragma unroll
      for (int g = 0; g < 4; ++g)
#pragma unroll
          for (int j = 0; j < (2 << g); ++j) { const int jj = j < pos ? j : pos; ld[q++] = *(const unsigned long long*)(row - (size_t)jj * DM + g * 256 + lane * 4); } }
    { int q = 0;
#pragma unroll
      for (int g = 0; g < 4; ++g) { const int w = 2 << g; const int cntw = pos + 1 < w ? pos + 1 : w;
        float s0 = 0.f, s1 = 0.f, s2 = 0.f, s3 = 0.f, u0 = 0.f, u1 = 0.f, u2 = 0.f, u3 = 0.f;
#pragma unroll
        for (int j = 0; j < w; ++j) { const unsigned long long v = ld[q++]; const unsigned lo = (unsigned)v, hi = (unsigned)(v >> 32);
            const float mk = j < cntw ? 1.0f : 0.0f;
            const float a = __uint_as_float(lo << 16) * mk, b2 = __uint_as_float(lo & 0xffff0000u) * mk, cc = __uint_as_float(hi << 16) * mk, d = __uint_as_float(hi & 0xffff0000u) * mk;
            if (j == 0) { u0 = a; u1 = b2; u2 = cc; u3 = d; } s0 += a; s1 += b2; s2 += cc; s3 += d; }
        const float ic = 1.0f / (float)cntw;
        st4bf(dp + g * 256 + lane * 4, s0 * ic - u0, s1 * ic - u1, s2 * ic - u2, s3 * ic - u3); } }
}
typedef float f32x16_t __attribute__((ext_vector_type(16)));
__device__ __forceinline__ void p5_block(const Ptrs& P, int blk, unsigned char* ldsg, int tid) {
    const int lane = tid & 63, wave = tid >> 6, t = lane & 31, kk = lane >> 5, tg = wave >> 2, kq = wave & 3;
    float* part = (float*)ldsg;
    float* ssqp = part + 8 * 32 * 33;
    const bf16_t* arow = (const bf16_t*)(P.ws + WS_HN) + (size_t)(blk * 64 + tg * 32 + t) * DM + kq * 512 + 16 * kk;
    const f32x4* bptr = (const f32x4*)(P.ws + WS_WR) + ((kq * 128 + 4 * kk) * NE + t);
    f32x16_t acc;
#pragma unroll
    for (int r = 0; r < 16; ++r) acc[r] = 0.f;
    float ss = 0.f;
#pragma unroll 2
    for (int j = 0; j < 16; ++j) {
        f32x4 a[4], b[4]; const u32x4 d0 = *(const u32x4*)(arow + 32 * j), d1 = *(const u32x4*)(arow + 32 * j + 8);
#pragma unroll
        for (int q = 0; q < 4; ++q) b[q] = bptr[(8 * j + q) * NE];
        a[0] = (f32x4){__uint_as_float(d0[0] << 16), __uint_as_float(d0[0] & 0xffff0000u), __uint_as_float(d0[1] << 16), __uint_as_float(d0[1] & 0xffff0000u)};
        a[1] = (f32x4){__uint_as_float(d0[2] << 16), __uint_as_float(d0[2] & 0xffff0000u), __uint_as_float(d0[3] << 16), __uint_as_float(d0[3] & 0xffff0000u)};
        a[2] = (f32x4){__uint_as_float(d1[0] << 16), __uint_as_float(d1[0] & 0xffff0000u), __uint_as_float(d1[1] << 16), __uint_as_float(d1[1] & 0xffff0000u)};
        a[3] = (f32x4){__uint_as_float(d1[2] << 16), __uint_as_float(d1[2] & 0xffff0000u), __uint_as_float(d1[3] << 16), __uint_as_float(d1[3] & 0xffff0000u)};
#pragma unroll
        for (int q = 0; q < 4; ++q) {
            ss += (a[q].x * a[q].x + a[q].y * a[q].y) + (a[q].z * a[q].z + a[q].w * a[q].w);
            acc = __builtin_amdgcn_mfma_f32_32x32x2f32(a[q].x, b[q].x, acc, 0, 0, 0); acc = __builtin_amdgcn_mfma_f32_32x32x2f32(a[q].y, b[q].y, acc, 0, 0, 0);
            acc = __builtin_amdgcn_mfma_f32_32x32x2f32(a[q].z, b[q].z, acc, 0, 0, 0); acc = __builtin_amdgcn_mfma_f32_32x32x2f32(a[q].w, b[q].w, acc, 0, 0, 0);
        }
    }
    ss += __shfl_xor(ss, 32);
#pragma unroll
    for (int r = 0; r < 16; ++r) part[(wave * 32 + ((r & 3) + 8 * (r >> 2) + 4 * kk)) * 33 + t] = acc[r];
    if (kk == 0) ssqp[wave * 32 + t] = ss;
    __syncthreads();
    if (tid < 64) {
        const int tg2 = tid >> 5, ti = tid & 31, r = blk * 64 + tid;
        float lg[NE];
#pragma unroll
        for (int e = 0; e < NE; ++e) lg[e] = (part[((tg2 * 4 + 0) * 32 + ti) * 33 + e] + part[((tg2 * 4 + 1) * 32 + ti) * 33 + e]) + (part[((tg2 * 4 + 2) * 32 + ti) * 33 + e] + part[((tg2 * 4 + 3) * 32 + ti) * 33 + e]);
        const float ssq = (ssqp[(tg2 * 4 + 0) * 32 + ti] + ssqp[(tg2 * 4 + 1) * 32 + ti]) + (ssqp[(tg2 * 4 + 2) * 32 + ti] + ssqp[(tg2 * 4 + 3) * 32 + ti]);
        const float rs = 1.0f / sqrtf(ssq * (1.0f / DM) + EPS);
#pragma unroll
        for (int e = 0; e < NE; ++e) lg[e] = lg[e] * rs + P.b_router[e];
        ((float*)(P.ws + WS_RS2))[r] = rs;
        int idx[TOPK]; float val[TOPK]; unsigned used = 0u;
#pragma unroll
        for (int k = 0; k < TOPK; ++k) { float best = -INFINITY; int bi = 0;
#pragma unroll
            for (int e = 0; e < NE; ++e) { const bool ok = !((used >> e) & 1u) && lg[e] > best; best = ok ? lg[e] : best; bi = ok ? e : bi; }
            used |= 1u << bi; idx[k] = bi; val[k] = best; }
        float den = 0.f, pe[TOPK];
#pragma unroll
        for (int k = 0; k < TOPK; ++k) { pe[k] = __expf(val[k] - val[0]); den += pe[k]; }
        unsigned* cnt = (unsigned*)(P.ws + WS_CTL) + CW_CNT; int* list = (int*)(P.ws + WS_LIST); float* gate = (float*)(P.ws + WS_GATE); float* rsl = (float*)(P.ws + WS_RSL);
        unsigned* lcnt = (unsigned*)(ssqp + 8 * 32); unsigned* lbase = lcnt + NE;
        if (tid < NE) lcnt[tid] = 0u;
        unsigned rk[TOPK];
#pragma unroll
        for (int k = 0; k < TOPK; ++k) rk[k] = __hip_atomic_fetch_add(lcnt + idx[k], 1u, __ATOMIC_RELAXED, __HIP_MEMORY_SCOPE_WORKGROUP);
        if (tid < NE) { const unsigned n = lcnt[tid]; lbase[tid] = n ? atomicAdd(cnt + tid, n) : 0u; }
#pragma unroll
        for (int k = 0; k < TOPK; ++k) { const unsigned slot = lbase[idx[k]] + rk[k]; const size_t o = (size_t)idx[k] * MR + slot; list[o] = r * 4 + k; gate[o] = pe[k] / den; rsl[o] = rs; }
    }
    __syncthreads();
}
__device__ __forceinline__ void p8_row(const Ptrs& P, int r, int lane, float* outbase) {
    const bf16_t* h2 = (const bf16_t*)(P.ws + WS_HN) + (size_t)r * DM; float* orow = outbase + (size_t)r * DM; const unsigned char* yb = P.ws + WS_YB + (size_t)r * 4 * DM;
    f32x4 v[8]; float s = 0.f;
#pragma unroll
    for (int j = 0; j < 8; ++j) { const int c = 4 * lane + 256 * j;
        { const unsigned long long y = *(const unsigned long long*)(h2 + c); const unsigned lo = (unsigned)y, hi = (unsigned)(y >> 32);
          v[j] = (f32x4){__uint_as_float(lo << 16), __uint_as_float(lo & 0xffff0000u), __uint_as_float(hi << 16), __uint_as_float(hi & 0xffff0000u)}; }
#pragma unroll
        for (int k = 0; k < 4; ++k) { const unsigned y = *(const unsigned*)(yb + (size_t)k * DM + c); typedef float f2_t __attribute__((ext_vector_type(2)));
            const f2_t lo = __builtin_amdgcn_cvt_pk_f32_fp8((int)y, false), hi = __builtin_amdgcn_cvt_pk_f32_fp8((int)y, true);
            v[j].x += lo.x * (1.0f / 16.0f); v[j].y += lo.y * (1.0f / 16.0f); v[j].z += hi.x * (1.0f / 16.0f); v[j].w += hi.y * (1.0f / 16.0f); }
        s += (v[j].x * v[j].x + v[j].y * v[j].y) + (v[j].z * v[j].z + v[j].w * v[j].w); }
    const float rs = 1.0f / sqrtf(wave_sum(s) * (1.0f / DM) + EPS);
#pragma unroll
    for (int j = 0; j < 8; ++j) { const int c = 4 * lane + 256 * j; const f32x4 g = *(const f32x4*)(P.g_final + c);
        __builtin_nontemporal_store((f32x4){v[j].x * rs * g.x, v[j].y * rs * g.y, v[j].z * rs * g.z, v[j].w * rs * g.w}, (f32x4*)(orow + c)); }
}
#define LAS __attribute__((address_space(3)))
#define GAS __attribute__((address_space(1)))
typedef short bf16x8 __attribute__((ext_vector_type(8)));
typedef int v4i_t __attribute__((ext_vector_type(4)));
typedef GAS unsigned gu32;
#define RLX_AGENT __ATOMIC_RELAXED, __HIP_MEMORY_SCOPE_AGENT
constexpr int NWAVES = 8;
constexpr int RING_OFF = 0, RING_BYTES = 131072;
constexpr int TAB_OFF = 133 * 1024;
constexpr int MISC_OFF = 143 * 1024;
constexpr int LDS_BYTES = 147456;

namespace pg8 {
constexpr int BM = 256, BK = 64, HALF = 128, HTB = HALF * BK * 2, NXCD = 8, WGM = 8;
__host__ __device__ __forceinline__ int lds_byte(int r, int c) { const int st = (r >> 4) * 2 + (c >> 5), rr = r & 15, cc = c & 31, ob = rr * 64 + cc * 2; return st * 1024 + (ob ^ (((ob >> 9) & 1) << 5)); }
__host__ __device__ __forceinline__ void stage_rc(int b, int& R, int& C) { const int st = b / 1024, sb = b % 1024, swz = sb ^ (((sb >> 9) & 1) << 5); R = (st >> 1) * 16 + swz / 64; C = (st & 1) * 32 + (swz % 64) / 2; }
__host__ __device__ __forceinline__ void stage_rc_f8(int b, int& R, int& Cb) { const int s = b >> 4; R = s >> 3; const int q = s & 7; Cb = 16 * (q ^ ((R >> 1) & 7)); }
__host__ __device__ __forceinline__ int perm32(int rho) { const int n = rho >> 4, i = rho & 15; return 8 * (i >> 2) + 4 * n + (i & 3); }
__host__ __device__ __forceinline__ int perm32x(int i) { return 16 * ((i >> 2) & 1) + 4 * (i >> 3) + (i & 3); }
typedef float f32x16 __attribute__((ext_vector_type(16)));
template <bool F8> struct AccSel { typedef f32x4 T[2][2][4][2]; };
template <> struct AccSel<true> { typedef f32x16 T[2][2][2]; };
struct Unit { int pm, pn, aux; };
__device__ __forceinline__ unsigned cvt_pk_bf16(float lo, float hi) { unsigned r; asm volatile("v_cvt_pk_bf16_f32 %0, %1, %2" : "=v"(r) : "v"(lo), "v"(hi)); return r; }
__device__ __forceinline__ u32x4 pack8(const f32x4& a, const f32x4& b) { u32x4 w; w.x = cvt_pk_bf16(a[0], a[1]); w.y = cvt_pk_bf16(a[2], a[3]); w.z = cvt_pk_bf16(b[0], b[1]); w.w = cvt_pk_bf16(b[2], b[3]); return w; }

struct Order2D {
    int nM, nN, nwg, G, c;
    __device__ __forceinline__ void init(int nM_, int nN_, int G_, int c_) { nM = nM_; nN = nN_; nwg = nM * nN; G = G_; c = c_; }
    __device__ __forceinline__ bool next(int i, Unit& u) const {
        const long L = (long)i * G + c; if (L >= nwg) return false;
        int wgid = (int)L; { const int q = nwg / NXCD, r = nwg % NXCD, xcd = wgid % NXCD, off = wgid / NXCD; wgid = (xcd < r ? xcd * (q + 1) : r * (q + 1) + (xcd - r) * q) + off; }
        const int nig = WGM * nN, gid = wgid / nig, fm = gid * WGM, gsz = (nM - fm) < WGM ? (nM - fm) : WGM;
        u.pm = fm + ((wgid % nig) % gsz); u.pn = (wgid % nig) / gsz; u.aux = 0; return true;
    }
};

template <class Prob, bool ALIGN_EPI>
__device__ __forceinline__ void gemm_phase(LAS unsigned char* lds, const Prob& Pb, const int tid) {
    const int wid = __builtin_amdgcn_readfirstlane(tid >> 6), lane = tid & 63, wr = wid >> 2, wc = wid & 3, fr = lane & 15, fq = lane >> 4;
    constexpr bool F8 = Prob::F8;
    const int nt = F8 ? Pb.K / 128 : Pb.K / BK;
    constexpr bool GATHER = Prob::GATHER;
    int Rr[2], Cc[2]; unsigned voffB, voffA = 0u;
    { int R, C; if (F8) stage_rc_f8(tid * 16, R, C); else { stage_rc(tid * 16, R, C); C *= 2; }
      Rr[0] = R; Rr[1] = R + 64; Cc[0] = C; Cc[1] = C; const int Rb = (R & ~31) + (F8 ? perm32x(R & 31) : perm32(R & 31)); voffB = (unsigned)(Rb * Pb.ldbB + C);
      if constexpr (!GATHER) voffA = (unsigned)(R * Pb.ldaB + C); }
    const unsigned r64B = 64u * (unsigned)Pb.ldbB, r64A = GATHER ? 0u : 64u * (unsigned)Pb.ldaB;
    const unsigned kstep = 128u;
    const unsigned hstepB = (unsigned)HALF * Pb.ldbB;
    const unsigned ldsw = (unsigned)wid * 1024u;
    const int r32 = lane & 31, g32 = lane >> 5;
    const int aoff = F8 ? (wr * 64 + r32) * 128 + (((2 * g32) ^ ((r32 >> 1) & 7)) * 16) : lds_byte(wr * 64 + fr, fq * 8);
    const int boff = F8 ? (wc * 32 + r32) * 128 + (((2 * g32) ^ ((r32 >> 1) & 7)) * 16) : lds_byte(wc * 32 + fr, fq * 8);
    const int aoff8 = aoff, boff8 = boff;
#define PG8_SA(b, h) (((b) * 2 + (h)) * HTB)
#define PG8_SB(b, h) ((4 + (b) * 2 + (h)) * HTB)
    const __amdgpu_buffer_rsrc_t rsA = __builtin_amdgcn_make_buffer_rsrc((void*)Pb.A, 0, 0x7ffffffe, 0x00020000), rsB = __builtin_amdgcn_make_buffer_rsrc((void*)Pb.Bt, 0, 0x7ffffffe, 0x00020000);
#define PG8_STAGE_B(bufoff, so) do { \
        __builtin_amdgcn_raw_ptr_buffer_load_lds(rsB, (LAS unsigned*)(lds + (bufoff) + ldsw), 16, voffB, (int)(so), 0, 0); \
        __builtin_amdgcn_raw_ptr_buffer_load_lds(rsB, (LAS unsigned*)(lds + (bufoff) + ldsw + 8192), 16, voffB, (int)((so) + r64B), 0, 0); } while (0)
#define PG8_STAGE_A(bufoff, so, h) do { if constexpr (GATHER) { \
        __builtin_amdgcn_raw_ptr_buffer_load_lds(rsA, (LAS unsigned*)(lds + (bufoff) + ldsw), 16, (h) ? ca10 : ca00, (int)(so), 0, 0); \
        __builtin_amdgcn_raw_ptr_buffer_load_lds(rsA, (LAS unsigned*)(lds + (bufoff) + ldsw + 8192), 16, (h) ? ca11 : ca01, (int)(so), 0, 0); } else { \
        __builtin_amdgcn_raw_ptr_buffer_load_lds(rsA, (LAS unsigned*)(lds + (bufoff) + ldsw), 16, voffA, (int)((so) + (h) * 2u * r64A), 0, 0); \
        __builtin_amdgcn_raw_ptr_buffer_load_lds(rsA, (LAS unsigned*)(lds + (bufoff) + ldsw + 8192), 16, voffA, (int)((so) + (h) * 2u * r64A + r64A), 0, 0); } } while (0)
#define PG8_LDA(dst, b, h) do { if constexpr (F8) { _Pragma("unroll") for (int m = 0; m < 2; ++m) _Pragma("unroll") for (int k = 0; k < 2; ++k) { dst[m * 2 + k][0] = *(const LAS bf16x8*)(lds + PG8_SA(b, h) + m * 4096 + (aoff8 ^ (k * 64))); dst[m * 2 + k][1] = *(const LAS bf16x8*)(lds + PG8_SA(b, h) + m * 4096 + (aoff8 ^ (k * 64) ^ 16)); } } \
        else { _Pragma("unroll") for (int m = 0; m < 4; ++m) _Pragma("unroll") for (int k = 0; k < 2; ++k) dst[m][k] = *(const LAS bf16x8*)(lds + PG8_SA(b, h) + aoff + m * 2048 + k * 1024); } } while (0)
#define PG8_LDB(dst, b, h) do { if constexpr (F8) { _Pragma("unroll") for (int k = 0; k < 2; ++k) { dst[k][0] = *(const LAS bf16x8*)(lds + PG8_SB(b, h) + (boff8 ^ (k * 64))); dst[k][1] = *(const LAS bf16x8*)(lds + PG8_SB(b, h) + (boff8 ^ (k * 64) ^ 16)); } } \
        else { _Pragma("unroll") for (int n = 0; n < 2; ++n) _Pragma("unroll") for (int k = 0; k < 2; ++k) dst[n][k] = *(const LAS bf16x8*)(lds + PG8_SB(b, h) + boff + n * 2048 + k * 1024); } } while (0)
#define PG8_F8FRAG(x) __builtin_shufflevector(__builtin_bit_cast(v4i_t, x[0]), __builtin_bit_cast(v4i_t, x[1]), 0, 1, 2, 3, 4, 5, 6, 7)
#define PG8_MMA(ai, bj, At, Bt) do { __builtin_amdgcn_s_setprio(1); if constexpr (F8) { _Pragma("unroll") for (int k = 0; k < 2; ++k) _Pragma("unroll") for (int m = 0; m < 2; ++m) \
        acc[ai][bj][m] = __builtin_amdgcn_mfma_scale_f32_32x32x64_f8f6f4(PG8_F8FRAG(Bt[k]), PG8_F8FRAG(At[m * 2 + k]), acc[ai][bj][m], 0, 0, 0, 0, 0, 0); }     \
        else { _Pragma("unroll") for (int m = 0; m < 4; ++m) _Pragma("unroll") for (int n = 0; n < 2; ++n) _Pragma("unroll") for (int k = 0; k < 2; ++k) \
        acc[ai][bj][m][n] = __builtin_amdgcn_mfma_f32_16x16x32_bf16(Bt[n][k], At[m][k], acc[ai][bj][m][n], 0, 0, 0); } __builtin_amdgcn_s_setprio(0); } while (0)
#define PG8_WAIT_V(n) asm volatile("s_waitcnt vmcnt(" #n ")" ::: "memory")
#define PG8_WAIT_L(n) asm volatile("s_waitcnt lgkmcnt(" #n ")" ::: "memory")
#define PG8_BAR __builtin_amdgcn_s_barrier()
#define PG8_SCHED __builtin_amdgcn_sched_barrier(0)
    Unit cur, nxt; int ui = 0;
    if (!Pb.next(0, cur)) return;
    const unsigned ktm = (unsigned)nt - 1u;
    unsigned rc = Pb.rot(cur), rn = 0u;
    typename AccSel<F8>::T acc;
#define PG8_ZERO_ACC do { if constexpr (F8) { _Pragma("unroll") for (int a = 0; a < 2; ++a) _Pragma("unroll") for (int b = 0; b < 2; ++b) _Pragma("unroll") for (int m = 0; m < 2; ++m) _Pragma("unroll") for (int n = 0; n < 16; ++n) acc[a][b][m][n] = 0.f; } \
        else { _Pragma("unroll") for (int a = 0; a < 2; ++a) _Pragma("unroll") for (int b = 0; b < 2; ++b) _Pragma("unroll") for (int m = 0; m < 4; ++m) _Pragma("unroll") for (int n = 0; n < 2; ++n) acc[a][b][m][n] = (f32x4){0.f, 0.f, 0.f, 0.f}; } } while (0)
    PG8_ZERO_ACC;
    bf16x8 At[4][2], B0[2][2], B1[2][2];
    unsigned ca00 = 0, ca01 = 0, ca10 = 0, ca11 = 0;
    unsigned cA, nA;
    if constexpr (GATHER) { Pb.a_fetch(cur, lds, wid); asm volatile("s_waitcnt vmcnt(0)" ::: "memory"); __builtin_amdgcn_s_barrier(); }
    Pb.e_fetch(cur, lds, wid, 0);
    { unsigned o[2][2]; Pb.a_addr(cur, Rr, Cc, o, cA, lds); ca00 = o[0][0]; ca01 = o[0][1]; ca10 = o[1][0]; ca11 = o[1][1]; }
    unsigned cB = Pb.b_base(cur);
    { const unsigned k0 = (rc & ktm) * kstep;
    PG8_STAGE_B(PG8_SB(0, 0), cB + k0); PG8_STAGE_B(PG8_SB(0, 1), cB + k0 + hstepB); PG8_STAGE_A(PG8_SA(0, 0), cA + k0, 0); PG8_STAGE_A(PG8_SA(0, 1), cA + k0, 1);
    if (wr == 1) PG8_BAR;
    PG8_WAIT_V(2); PG8_BAR;
    PG8_STAGE_B(PG8_SB(1, 0), cB + k0 + kstep); PG8_STAGE_A(PG8_SA(1, 0), cA + k0 + kstep, 0); PG8_STAGE_B(PG8_SB(1, 1), cB + k0 + hstepB + kstep); }
    PG8_WAIT_V(6); PG8_BAR;
    for (;;) {
        const bool has_next = Pb.next(ui + 1, nxt);
        unsigned nB;
        if (has_next) { if constexpr (GATHER) Pb.a_fetch(nxt, lds, wid); else { unsigned o[2][2]; Pb.a_addr(nxt, Rr, Cc, o, nA, lds); } nB = Pb.b_base(nxt); rn = Pb.rot(nxt); }
        else { nA = cA; nB = cB; rn = rc; }
        for (int t = 0; t < nt; t += 2) {
            const bool last = (t == nt - 2);
            const unsigned a1 = cA + (((unsigned)(t + 1) + rc) & ktm) * kstep;
            PG8_LDB(B0, 0, 0); PG8_LDB(B1, 0, 1); PG8_SCHED; PG8_LDA(At, 0, 0); PG8_STAGE_A(PG8_SA(1, 1), a1, 1);
            PG8_WAIT_V(8); PG8_WAIT_L(0); PG8_BAR; PG8_MMA(0, 0, At, B0); PG8_MMA(0, 1, At, B1); PG8_BAR; PG8_SCHED;
            const unsigned k2 = last ? (rn & ktm) * kstep : (((unsigned)(t + 2) + rc) & ktm) * kstep;
            const unsigned a2 = (last ? nA : cA) + k2, b2 = (last ? nB : cB) + k2;
            const unsigned a3 = a2 + kstep, b3 = b2 + kstep;
            if constexpr (GATHER) { if (last && has_next) { unsigned o[2][2]; Pb.a_addr(nxt, Rr, Cc, o, nA, lds); ca00 = o[0][0]; ca01 = o[0][1]; ca10 = o[1][0]; ca11 = o[1][1]; } }
            PG8_LDA(At, 0, 1); PG8_STAGE_B(PG8_SB(0, 0), b2); PG8_STAGE_B(PG8_SB(0, 1), b2 + hstepB); PG8_STAGE_A(PG8_SA(0, 0), a2, 0);
            PG8_WAIT_V(8); PG8_WAIT_L(0); PG8_BAR; PG8_MMA(1, 0, At, B0); PG8_MMA(1, 1, At, B1); PG8_BAR; PG8_SCHED;
            PG8_LDB(B0, 1, 0); PG8_LDB(B1, 1, 1); PG8_SCHED; PG8_LDA(At, 1, 0); PG8_STAGE_A(PG8_SA(0, 1), a2, 1);
            PG8_WAIT_V(8); PG8_WAIT_L(0); PG8_BAR; PG8_MMA(0, 0, At, B0); PG8_MMA(0, 1, At, B1); PG8_BAR; PG8_SCHED;
            PG8_LDA(At, 1, 1); PG8_STAGE_B(PG8_SB(1, 0), b3); PG8_STAGE_B(PG8_SB(1, 1), b3 + hstepB); PG8_STAGE_A(PG8_SA(1, 0), a3, 0);
            PG8_WAIT_V(8); PG8_WAIT_L(0); PG8_BAR; PG8_MMA(1, 0, At, B0); PG8_MMA(1, 1, At, B1); PG8_BAR; PG8_SCHED;
        }
        if constexpr (ALIGN_EPI) { if (wr == 0) PG8_BAR; }
        { int tl = tid; asm volatile("" : "+v"(tl));
          const int ln = tl & 63; if constexpr (F8) Pb.epi(acc, cur, wr, wc, ln & 31, ln >> 5, lds + (ui & 1) * 3072); else Pb.epi(acc, cur, wr, wc, ln & 15, ln >> 4, lds + (ui & 1) * 3072); }
        if (!has_next) break;
        PG8_ZERO_ACC;
        if constexpr (F8) { _Pragma("unroll") for (int a = 0; a < 2; ++a) _Pragma("unroll") for (int b = 0; b < 2; ++b) asm volatile("" : "+v"(acc[a][b][0]), "+v"(acc[a][b][1])); }
        else { _Pragma("unroll") for (int a = 0; a < 2; ++a) _Pragma("unroll") for (int b = 0; b < 2; ++b) _Pragma("unroll") for (int m = 0; m < 4; ++m) asm volatile("" : "+v"(acc[a][b][m][0]), "+v"(acc[a][b][m][1])); }
        cur = nxt; cA = nA; cB = nB; rc = rn; ++ui;
        Pb.e_fetch(cur, lds, wid, ui & 1);
        if constexpr (ALIGN_EPI) { if (wr == 1) PG8_BAR; }
    }
    PG8_WAIT_V(0);
    if constexpr (!ALIGN_EPI) { if (wr == 0) PG8_BAR; }
    PG8_BAR;
#undef PG8_SA
#undef PG8_SB
#undef PG8_STAGE_A
#undef PG8_STAGE_B
#undef PG8_LDA
#undef PG8_LDB
#undef PG8_MMA
#undef PG8_F8FRAG
#undef PG8_ZERO_ACC
#undef PG8_WAIT_V
#undef PG8_WAIT_L
#undef PG8_BAR
#undef PG8_SCHED
}
}
namespace pg8 {
#define PG8_EPI_LOOP for (int ai = 0; ai < 2; ++ai) _Pragma("unroll") for (int m = 0; m < 4; ++m) _Pragma("unroll") for (int bj = 0; bj < 2; ++bj)
__device__ __forceinline__ void rope4(const float* rope, int pos, int i0, f32x4& a, f32x4& b) {
    const f32x4 c = *(const f32x4*)(rope + pos * 32 + i0), s = *(const f32x4*)(rope + LSEQ * 32 + pos * 32 + i0);
    const f32x4 r0 = {a[0] * c[0] - a[1] * s[0], a[1] * c[0] + a[0] * s[0], a[2] * c[1] - a[3] * s[1], a[3] * c[1] + a[2] * s[1]};
    const f32x4 r1 = {b[0] * c[2] - b[1] * s[2], b[1] * c[2] + b[0] * s[2], b[2] * c[3] - b[3] * s[3], b[3] * c[3] + b[2] * s[3]};
    a = r0; b = r1;
}
__device__ __forceinline__ float clamp448(float v) { return __builtin_amdgcn_fmed3f(v, -448.0f, 448.0f); }
__device__ __forceinline__ unsigned pack4_f8(float a, float b, float c, float d) { int w = 0; w = __builtin_amdgcn_cvt_pk_fp8_f32(clamp448(a), clamp448(b), w, false); w = __builtin_amdgcn_cvt_pk_fp8_f32(clamp448(c), clamp448(d), w, true); return (unsigned)w; }
__device__ __forceinline__ unsigned long long pack8_f8(const f32x4& a, const f32x4& b) { return (unsigned long long)pack4_f8(a[0], a[1], a[2], a[3]) | ((unsigned long long)pack4_f8(b[0], b[1], b[2], b[3]) << 32); }
struct DenseBase {
    static constexpr bool F8 = false, GATHER = false; static constexpr int scaleA = 0, scaleB = 0;
    const char* A; const char* Bt; int K, lda, ldb, ldaB, ldbB; Order2D ord;
    __device__ __forceinline__ bool next(int i, Unit& u) const { return ord.next(i, u); }
    __device__ __forceinline__ unsigned rot(const Unit&) const { return 0u; }
    __device__ __forceinline__ void e_fetch(const Unit&, LAS unsigned char*, int, int) const {}
    __device__ __forceinline__ void a_addr(const Unit& u, const int (&Rr)[2], const int (&Cc)[2], unsigned (&o)[2][2], unsigned& base, LAS unsigned char*) const {
        base = (unsigned)u.pm * 256u * (unsigned)lda * 2u;
#pragma unroll
        for (int h = 0; h < 2; ++h)
#pragma unroll
            for (int i = 0; i < 2; ++i) o[h][i] = (unsigned)((h * 128 + Rr[i]) * lda * 2 + Cc[i]);
    }
    __device__ __forceinline__ unsigned b_base(const Unit& u) const { return (unsigned)u.pn * 256u * (unsigned)ldb * 2u; }
};
struct ProbP1 : DenseBase {
    bf16_t* proj; bf16_t* kr; const float* rope; float* ssqp;
    __device__ __forceinline__ void epi(const f32x4 (&acc)[2][2][4][2], const Unit& u, int wr, int wc, int fr, int fq, LAS unsigned char*) const {
        float ssq_acc[2][4];
#pragma unroll
        for (int a = 0; a < 2; ++a)
#pragma unroll
            for (int b = 0; b < 4; ++b) ssq_acc[a][b] = 0.f;
#pragma unroll
        PG8_EPI_LOOP {
            const int row = u.pm * 256 + ai * 128 + wr * 64 + m * 16 + fr, col = u.pn * 256 + bj * 128 + wc * 32 + fq * 8;
            f32x4 v0 = acc[ai][bj][m][0], v1 = acc[ai][bj][m][1];
            if (u.pn >= 4 && u.pn < 7) { const float q = (v0[0] * v0[0] + v0[1] * v0[1]) + (v0[2] * v0[2] + v0[3] * v0[3]) + (v1[0] * v1[0] + v1[1] * v1[1]) + (v1[2] * v1[2] + v1[3] * v1[3]);
                ssq_acc[ai][m] += q; }
            if (col < 1792) { *(u32x4*)(proj + (size_t)row * DM + col) = pack8(v0, v1); }
            else if (col < INW) { const int pos = (row % LP) - PADR;
                if (pos >= 0) rope4(rope, pos, (col - 1792) >> 1, v0, v1); else { v0 = (f32x4){0.f, 0.f, 0.f, 0.f}; v1 = v0; }
                *(u32x4*)(kr + (size_t)row * 64 + (col - 1792)) = pack8(v0, v1); }
        }
        if (u.pn >= 4 && u.pn < 7) {
            const int slot = u.pn < 6 ? (u.pn - 4) * 4 + wc : 8 + wc;
#pragma unroll
            for (int ai = 0; ai < 2; ++ai)
#pragma unroll
                for (int m = 0; m < 4; ++m) { float q = ssq_acc[ai][m]; q += __shfl_xor(q, 16); q += __shfl_xor(q, 32);
                    if (fq == 0) ssqp[(size_t)(u.pm * 256 + ai * 128 + wr * 64 + m * 16 + fr) * 12 + slot] = q; }
        }
    }
};
struct ProbP2q : DenseBase {
    bf16_t* qb; const float* rsq; const float* rope;
    __device__ __forceinline__ void epi(const f32x4 (&acc)[2][2][4][2], const Unit& u, int wr, int wc, int fr, int fq, LAS unsigned char*) const {
        float rsv[2][4];
#pragma unroll
        for (int ai = 0; ai < 2; ++ai)
#pragma unroll
            for (int m = 0; m < 4; ++m) { const float* pp = rsq + (size_t)(u.pm * 256 + ai * 128 + wr * 64 + m * 16 + fr) * 12; const f32x4 a = *(const f32x4*)pp, b = *(const f32x4*)(pp + 4);
                rsv[ai][m] = C2 / sqrtf(((a[0] + a[1]) + (a[2] + a[3]) + (b[0] + b[1]) + (b[2] + b[3])) * (1.0f / QLORA) + EPS); }
#pragma unroll
        PG8_EPI_LOOP {
            const int row = u.pm * 256 + ai * 128 + wr * 64 + m * 16 + fr, col = u.pn * 256 + bj * 128 + wc * 32 + fq * 8;
            const float s = rsv[ai][m]; f32x4 v0 = acc[ai][bj][m][0] * s, v1 = acc[ai][bj][m][1] * s;
            const int dd = col % QKD;
            if (dd >= QKNOPE) { const int pos = (row % LP) - PADR; if (pos >= 0) rope4(rope, pos, (dd - QKNOPE) >> 1, v0, v1); else { v0 = (f32x4){0.f, 0.f, 0.f, 0.f}; v1 = v0; } }
            *(u32x4*)(qb + (size_t)row * 1536 + col) = pack8(v0, v1);
        }
    }
};
struct ProbP2kv : DenseBase {
    bf16_t* kn; bf16_t* vb; const float* rskv;
    __device__ __forceinline__ void epi(const f32x4 (&acc)[2][2][4][2], const Unit& u, int wr, int wc, int fr, int fq, LAS unsigned char*) const {
#pragma unroll
        PG8_EPI_LOOP {
            const int row = u.pm * 256 + ai * 128 + wr * 64 + m * 16 + fr, c = wc * 32 + fq * 8;
            const f32x4 pk = *(const f32x4*)(rskv + (size_t)row * 12 + 8); const float s = 1.0f / sqrtf(((pk[0] + pk[1]) + (pk[2] + pk[3])) * (1.0f / KVLORA) + EPS); const f32x4 v0 = acc[ai][bj][m][0] * s, v1 = acc[ai][bj][m][1] * s;
            bf16_t* dst = (bj == 0 ? kn : vb) + (size_t)row * 1024 + u.pn * 128 + c;
            *(u32x4*)dst = pack8(v0, v1);
        }
    }
};
struct ProbPool : DenseBase {
    unsigned char* mix; const float* pscale;
    __device__ __forceinline__ void a_addr(const Unit& u, const int (&Rr)[2], const int (&Cc)[2], unsigned (&o)[2][2], unsigned& base, LAS unsigned char*) const {
        base = ((unsigned)u.pm * 256u * (unsigned)lda + (unsigned)u.pn * 256u) * 2u;
#pragma unroll
        for (int h = 0; h < 2; ++h)
#pragma unroll
            for (int i = 0; i < 2; ++i) o[h][i] = (unsigned)((h * 128 + Rr[i]) * lda * 2 + Cc[i]);
    }
    __device__ __forceinline__ unsigned b_base(const Unit& u) const { return (unsigned)u.pn * 65536u * 2u; }
    __device__ __forceinline__ void epi(const f32x4 (&acc)[2][2][4][2], const Unit& u, int wr, int wc, int fr, int fq, LAS unsigned char*) const {
#pragma unroll
        PG8_EPI_LOOP {
            const int row = u.pm * 256 + ai * 128 + wr * 64 + m * 16 + fr, c = u.pn * 256 + bj * 128 + wc * 32 + fq * 8;
            const f32x4 p0 = *(const f32x4*)(pscale + c), p1 = *(const f32x4*)(pscale + c + 4);
            *(unsigned long long*)(mix + (size_t)row * DM + c) = pack8_f8(acc[ai][bj][m][0] * p0 * (float)(1 << MIX_SCALE_LOG2), acc[ai][bj][m][1] * p1 * (float)(1 << MIX_SCALE_LOG2));
        }
    }
};
struct ProbP4 {
    static constexpr bool F8 = true, GATHER = false; static constexpr int ldaB = DM;
    const char* A; const char* Bt; int K, ldbB; Order2D ord;
    const float* x; bf16_t* h2; unsigned char* h2f8;
    __device__ __forceinline__ bool next(int i, Unit& u) const { return ord.next(i, u); }
    __device__ __forceinline__ unsigned rot(const Unit&) const { return 0u; }
    __device__ __forceinline__ void e_fetch(const Unit&, LAS unsigned char*, int, int) const {}
    __device__ __forceinline__ void a_addr(const Unit& u, const int (&Rr)[2], const int (&Cc)[2], unsigned (&o)[2][2], unsigned& base, LAS unsigned char*) const {
        base = (unsigned)((u.pm >> 3) * LP + 64 + (u.pm & 7) * 256) * (unsigned)DM;
#pragma unroll
        for (int h = 0; h < 2; ++h)
#pragma unroll
            for (int i = 0; i < 2; ++i) o[h][i] = (unsigned)((h * 128 + Rr[i]) * DM + Cc[i]);
    }
    __device__ __forceinline__ unsigned b_base(const Unit& u) const { return (unsigned)u.pn * 256u * (unsigned)DM; }
    __device__ __forceinline__ void epi(const f32x16 (&acc)[2][2][2], const Unit& u, int wr, int wc, int r32, int hi, LAS unsigned char*) const {
        typedef unsigned long long u64x2 __attribute__((ext_vector_type(2)));
        constexpr float SC = 1.0f / (float)(1 << (MIX_SCALE_LOG2 + WO_SCALE_LOG2));
#pragma unroll
        for (int ai = 0; ai < 2; ++ai)
#pragma unroll
            for (int mt = 0; mt < 2; ++mt)
#pragma unroll
                for (int bj = 0; bj < 2; ++bj) {
                    const int r = u.pm * 256 + ai * 128 + wr * 64 + mt * 32 + r32, c = u.pn * 256 + bj * 128 + wc * 32 + hi * 16;
                    const size_t off = (size_t)r * DM + c;
                    const f32x16 a = acc[ai][bj][mt];
                    f32x4 o[4];
#pragma unroll
                    for (int q = 0; q < 4; ++q) o[q] = *(const f32x4*)(x + off + 4 * q) + (f32x4){a[4 * q], a[4 * q + 1], a[4 * q + 2], a[4 * q + 3]} * SC;
                    *(u32x4*)(h2 + off) = pack8(o[0], o[1]); *(u32x4*)(h2 + off + 8) = pack8(o[2], o[3]);
                    u64x2 w; w.x = pack8_f8(o[0], o[1]); w.y = pack8_f8(o[2], o[3]); *(u64x2*)(h2f8 + off) = w;
                }
    }
};
}
namespace pg8 {
constexpr int TB_CNT = 64, TB_TE = 128, TB_TM = 416, TB_LIST = 768, TB_E0 = 1024, TB_E1 = 1280, TB_E2 = 1536;
__device__ __forceinline__ void moe_table(LAS unsigned char* lds, const unsigned* cnt, const int tid) {
    LAS int* tab = (LAS int*)(lds + TAB_OFF);
    __syncthreads();
    if (tid < NE) tab[TB_CNT + tid] = (int)__hip_atomic_load(cnt + tid, RLX_AGENT);
    __syncthreads();
    if (tid == 0) { int s = 0; for (int e = 0; e < NE; ++e) { tab[e] = s; s += (tab[TB_CNT + e] + 255) >> 8; } tab[NE] = s; }
    __syncthreads();
    if (tid < 288) { int e = 0; for (; e < NE - 1; ++e) if (tid < tab[e + 1]) break; tab[TB_TE + tid] = e; tab[TB_TM + tid] = tid - tab[e]; }
    __syncthreads();
}
#ifndef MOE_BT
#define MOE_BT 8
#endif
template <int NTN> struct MoeOrder {
    const LAS int* tab; int G, c, i0, i1;
    __device__ __forceinline__ bool next(int i_, Unit& u) const {
        const int i = i0 + i_; if (i >= i1) return false;
        const int cpx = G >> 3; const int F = (G & 7) ? i * G + c : (i * 8 + (c & 7)) * cpx + (c >> 3);
        const int ntile = __builtin_amdgcn_readfirstlane(tab[NE]); if (F >= ntile * NTN) return false;
        constexpr int BT = MOE_BT, PG = 32 / BT;
        const int blk = F / (BT * NTN), r = F - blk * (BT * NTN), nb = (ntile - blk * BT) < BT ? (ntile - blk * BT) : BT;
        int png, rr; if (nb == BT) { png = r / 32; rr = r & 31; } else { const int gs = nb * PG; png = r / gs; rr = r - png * gs; }
        const int T = blk * BT + rr / PG;
        u.aux = __builtin_amdgcn_readfirstlane(tab[TB_TE + T]); u.pm = __builtin_amdgcn_readfirstlane(tab[TB_TM + T]); u.pn = png * PG + (rr % PG); return true;
    }
};
constexpr int W_SCALE_LOG2 = 5, ACT_SCALE_LOG2 = 2, YB_SCALE_LOG2 = 4;
struct ProbP6 {
    static constexpr bool F8 = true, GATHER = true; static constexpr int ldaB = DM; static constexpr int scaleB = 0x01010101 * (127 - W_SCALE_LOG2), scaleA = 0x7f7f7f7f;
    const char* A; const char* Bt; int K, ldbB; MoeOrder<16> ord;
    const int* list; const float* rsl; const float* b1; unsigned char* act;
    __device__ __forceinline__ bool next(int i, Unit& u) const { return ord.next(i, u); }
    __device__ __forceinline__ unsigned rot(const Unit& u) const { return 0u; }
    __device__ __forceinline__ void a_fetch(const Unit& u, LAS unsigned char* lds, int wid) const {
        if (wid == 0) { const __amdgpu_buffer_rsrc_t rl = __builtin_amdgcn_make_buffer_rsrc((void*)list, 0, 0x7ffffffe, 0x00020000);
            __builtin_amdgcn_raw_ptr_buffer_load_lds(rl, (LAS unsigned*)(lds + TAB_OFF + TB_LIST * 4), 16, (threadIdx.x & 63) * 16, (int)(((unsigned)u.aux * (unsigned)MR + (unsigned)u.pm * 256u) * 4u), 0, 0); }
    }
    __device__ __forceinline__ void a_addr(const Unit& u, const int (&Rr)[2], const int (&Cc)[2], unsigned (&o)[2][2], unsigned& base, LAS unsigned char* lds) const {
        base = 0u; const int cnt_e = __builtin_amdgcn_readfirstlane(ord.tab[TB_CNT + u.aux]); const LAS int* lb = (const LAS int*)(lds + TAB_OFF) + TB_LIST; const int lastv = cnt_e - 1 - u.pm * 256;
#pragma unroll
        for (int h = 0; h < 2; ++h)
#pragma unroll
            for (int i = 0; i < 2; ++i) { int sl = h * 128 + Rr[i]; sl = sl < lastv ? sl : lastv; const int tok = lb[sl] >> 2; o[h][i] = (unsigned)tok * (unsigned)DM + (unsigned)Cc[i]; }
    }
    __device__ __forceinline__ void e_fetch(const Unit& u, LAS unsigned char* lds, int wid, int par) const {
        lds += par * 3072;
        if (wid == 1) { const __amdgpu_buffer_rsrc_t r = __builtin_amdgcn_make_buffer_rsrc((void*)rsl, 0, 0x7ffffffe, 0x00020000);
            __builtin_amdgcn_raw_ptr_buffer_load_lds(r, (LAS unsigned*)(lds + TAB_OFF + TB_E0 * 4), 16, (threadIdx.x & 63) * 16, (int)(((unsigned)u.aux * (unsigned)MR + (unsigned)u.pm * 256u) * 4u), 0, 0); }
        if (wid == 2) { const __amdgpu_buffer_rsrc_t r = __builtin_amdgcn_make_buffer_rsrc((void*)b1, 0, 0x7ffffffe, 0x00020000);
            __builtin_amdgcn_raw_ptr_buffer_load_lds(r, (LAS unsigned*)(lds + TAB_OFF + TB_E1 * 4), 16, (threadIdx.x & 63) * 16, (int)(((unsigned)u.aux * 4096u + (unsigned)u.pn * 256u) * 4u), 0, 0); }
    }
    __device__ __forceinline__ unsigned b_base(const Unit& u) const { return ((unsigned)u.aux * 4096u + (unsigned)u.pn * 256u) * (unsigned)DM; }
    __device__ __forceinline__ void epi(const f32x16 (&acc)[2][2][2], const Unit& u, int wr, int wc, int r32, int hi, LAS unsigned char* lds) const {
        const LAS float* rsb = (const LAS float*)(lds + TAB_OFF) + TB_E0; const LAS float* bb1 = (const LAS float*)(lds + TAB_OFF) + TB_E1;
        const int cnt_e = __builtin_amdgcn_readfirstlane(ord.tab[TB_CNT + u.aux]), rbase = __builtin_amdgcn_readfirstlane(ord.tab[u.aux]) * 256;
        constexpr float AS = (float)(1 << ACT_SCALE_LOG2), NC = -1.702f * 1.4426950408889634f;
#pragma unroll
        for (int bj = 0; bj < 2; ++bj) {
            f32x4 bg[2], bl[2];
#pragma unroll
            for (int h = 0; h < 2; ++h) { const LAS float* bp = bb1 + bj * 128 + wc * 32 + hi * 16 + h * 8; const f32x4 x0 = *(const LAS f32x4*)bp, x1 = *(const LAS f32x4*)(bp + 4);
                bg[h] = (f32x4){x0[0], x0[2], x1[0], x1[2]}; bl[h] = (f32x4){x0[1], x0[3], x1[1], x1[3]}; }
#pragma unroll
            for (int ai = 0; ai < 2; ++ai)
#pragma unroll
                for (int m = 0; m < 2; ++m) {
                    const int slot = u.pm * 256 + ai * 128 + wr * 64 + m * 32 + r32; const bool valid = slot < cnt_e;
                    const float rs = valid ? rsb[ai * 128 + wr * 64 + m * 32 + r32] * (1.0f / (float)(1 << W_SCALE_LOG2)) : 0.f;
                    const f32x16 a = acc[ai][bj][m];
                    unsigned w2[2];
#pragma unroll
                    for (int h = 0; h < 2; ++h) {
                        f32x4 g = (f32x4){a[8 * h + 0], a[8 * h + 2], a[8 * h + 4], a[8 * h + 6]} * rs + bg[h], l = (f32x4){a[8 * h + 1], a[8 * h + 3], a[8 * h + 5], a[8 * h + 7]} * rs + bl[h];
#pragma unroll
                        for (int q = 0; q < 4; ++q) { g[q] = fminf(g[q], 7.0f); l[q] = __builtin_amdgcn_fmed3f(l[q], -7.0f, 7.0f); }
                        f32x4 e = g * NC, lp = l * AS + AS;
#pragma unroll
                        for (int q = 0; q < 4; ++q) e[q] = __builtin_amdgcn_rcpf(1.0f + __builtin_amdgcn_exp2f(e[q]));
                        const f32x4 o = (g * e) * lp;
                        int w = 0; w = __builtin_amdgcn_cvt_pk_fp8_f32(o[0], o[1], w, false); w = __builtin_amdgcn_cvt_pk_fp8_f32(o[2], o[3], w, true); w2[h] = (unsigned)w;
                    }
                    if (valid) *(unsigned long long*)(act + (size_t)(rbase + slot) * DFF + u.pn * 128 + bj * 64 + wc * 16 + hi * 8) = (unsigned long long)w2[0] | ((unsigned long long)w2[1] << 32);
                }
        }
    }
};
struct ProbP7 {
    static constexpr bool F8 = true, GATHER = false; static constexpr int ldaB = DFF; static constexpr int scaleB = 0x01010101 * (127 - W_SCALE_LOG2), scaleA = 0x01010101 * (127 - ACT_SCALE_LOG2);
    const char* A; const char* Bt; int K, ldbB; MoeOrder<8> ord;
    const int* list; const float* gate; const float* b2; unsigned char* yb;
    __device__ __forceinline__ bool next(int i, Unit& u) const { return ord.next(i, u); }
    __device__ __forceinline__ unsigned rot(const Unit& u) const { return 0u; }
    __device__ __forceinline__ void a_addr(const Unit& u, const int (&Rr)[2], const int (&Cc)[2], unsigned (&o)[2][2], unsigned& base, LAS unsigned char*) const {
        base = (unsigned)(__builtin_amdgcn_readfirstlane(ord.tab[u.aux]) + u.pm) * 256u * (unsigned)DFF;
#pragma unroll
        for (int h = 0; h < 2; ++h)
#pragma unroll
            for (int i = 0; i < 2; ++i) o[h][i] = (unsigned)((h * 128 + Rr[i]) * DFF + Cc[i]);
    }
    __device__ __forceinline__ void e_fetch(const Unit& u, LAS unsigned char* lds, int wid, int par) const {
        lds += par * 3072;
        const int so = (int)(((unsigned)u.aux * (unsigned)MR + (unsigned)u.pm * 256u) * 4u);
        if (wid == 1) { const __amdgpu_buffer_rsrc_t r = __builtin_amdgcn_make_buffer_rsrc((void*)gate, 0, 0x7ffffffe, 0x00020000);
            __builtin_amdgcn_raw_ptr_buffer_load_lds(r, (LAS unsigned*)(lds + TAB_OFF + TB_E0 * 4), 16, (threadIdx.x & 63) * 16, so, 0, 0); }
        if (wid == 2) { const __amdgpu_buffer_rsrc_t r = __builtin_amdgcn_make_buffer_rsrc((void*)b2, 0, 0x7ffffffe, 0x00020000);
            __builtin_amdgcn_raw_ptr_buffer_load_lds(r, (LAS unsigned*)(lds + TAB_OFF + TB_E1 * 4), 16, (threadIdx.x & 63) * 16, (int)(((unsigned)u.aux * (unsigned)DM + (unsigned)u.pn * 256u) * 4u), 0, 0); }
        if (wid == 3) { const __amdgpu_buffer_rsrc_t r = __builtin_amdgcn_make_buffer_rsrc((void*)list, 0, 0x7ffffffe, 0x00020000);
            __builtin_amdgcn_raw_ptr_buffer_load_lds(r, (LAS unsigned*)(lds + TAB_OFF + TB_E2 * 4), 16, (threadIdx.x & 63) * 16, so, 0, 0); }
    }
    __device__ __forceinline__ unsigned b_base(const Unit& u) const { return ((unsigned)u.aux * (unsigned)DM + (unsigned)u.pn * 256u) * (unsigned)DFF; }
    __device__ __forceinline__ void epi(const f32x16 (&acc)[2][2][2], const Unit& u, int wr, int wc, int r32, int hi, LAS unsigned char* lds) const {
        const int cnt_e = __builtin_amdgcn_readfirstlane(ord.tab[TB_CNT + u.aux]);
        const LAS float* gtb = (const LAS float*)(lds + TAB_OFF) + TB_E0; const LAS float* bb2 = (const LAS float*)(lds + TAB_OFF) + TB_E1; const LAS int* idb = (const LAS int*)(lds + TAB_OFF) + TB_E2;
        const int col = u.pn * 256 + wc * 32 + hi * 16;
        typedef unsigned long long u64x2 __attribute__((ext_vector_type(2)));
#pragma unroll
        for (int bj = 0; bj < 2; ++bj) {
            f32x4 bb[4];
#pragma unroll
            for (int q = 0; q < 4; ++q) bb[q] = *(const LAS f32x4*)(bb2 + bj * 128 + wc * 32 + hi * 16 + q * 4);
#pragma unroll
            for (int ai = 0; ai < 2; ++ai)
#pragma unroll
                for (int m = 0; m < 2; ++m) {
                    const int rl = ai * 128 + wr * 64 + m * 32 + r32, slot = u.pm * 256 + rl; const bool valid = slot < cnt_e;
                    const int id = valid ? idb[rl] : 0; const float g = valid ? gtb[rl] : 0.f, gs = g * (1.0f / (float)(1 << (W_SCALE_LOG2 + ACT_SCALE_LOG2)));
                    const f32x16 a = acc[ai][bj][m];
                    f32x4 y[4];
#pragma unroll
                    for (int q = 0; q < 4; ++q) y[q] = ((f32x4){a[4 * q], a[4 * q + 1], a[4 * q + 2], a[4 * q + 3]} * gs + bb[q] * g) * (float)(1 << YB_SCALE_LOG2);
                    if (valid) { u64x2 w; w.x = pack8_f8(y[0], y[1]); w.y = pack8_f8(y[2], y[3]); *(u64x2*)(yb + (size_t)id * DM + col + bj * 128) = w; }
                }
        }
    }
};
}
namespace att {
using f32x16 = __attribute__((ext_vector_type(16))) float;
using s16x4 = __attribute__((ext_vector_type(4))) short;
constexpr int SHM_V = 16384, SHM_KN = 16384, SHM_KR = 8192, SHM_BUF = SHM_V + SHM_KN + SHM_KR, NBUF = 3, WS_OFF = NBUF * SHM_BUF;
#define ATT_SBAR() __builtin_amdgcn_sched_barrier(0)
__device__ __forceinline__ int crow(int r, int hi) { return (r & 3) + 8 * (r >> 2) + 4 * hi; }
__device__ __forceinline__ unsigned cvtpk(float lo, float hi) { unsigned r; asm volatile("v_cvt_pk_bf16_f32 %0, %1, %2" : "=v"(r) : "v"(lo), "v"(hi)); return r; }
__device__ __forceinline__ int v_st(int k, int c) { const int kk = (k & ~0xC) | ((k & 4) << 1) | ((k & 8) >> 1); return ((kk >> 3) * 4 + (c >> 5)) * 512 + ((kk & 7) * 32 + (c & 31)) * 2; }
__device__ __forceinline__ int v_rd_base(int lane) { return ((lane & 3) << 3) | (((lane >> 2) & 3) << 6) | (((lane >> 4) & 1) << 5) | (((lane >> 5) & 1) << 8); }
constexpr int v_rd_off(int d0, int ks, int half) { return d0 * 512 + ks * 4096 + half * 2048; }
template <int OFF> __device__ __forceinline__ s16x4 tr_read(int vb) { s16x4 r; asm volatile("ds_read_b64_tr_b16 %0, %1 offset:%2" : "=&v"(r) : "v"(vb), "i"(OFF) : "memory"); return r; }
template <int D0> __device__ __forceinline__ void pv_one(f32x16& od, int vb, bf16x8 pa0, bf16x8 pa1, bf16x8 pa2, bf16x8 pa3) {
    const s16x4 l0 = tr_read<v_rd_off(D0, 0, 0)>(vb), h0 = tr_read<v_rd_off(D0, 0, 1)>(vb), l1 = tr_read<v_rd_off(D0, 1, 0)>(vb), h1 = tr_read<v_rd_off(D0, 1, 1)>(vb);
    const s16x4 l2 = tr_read<v_rd_off(D0, 2, 0)>(vb), h2 = tr_read<v_rd_off(D0, 2, 1)>(vb), l3 = tr_read<v_rd_off(D0, 3, 0)>(vb), h3 = tr_read<v_rd_off(D0, 3, 1)>(vb);
    asm volatile("s_waitcnt lgkmcnt(0)" ::: "memory"); ATT_SBAR();
#define ATT_PK(L, H) (bf16x8){L[0], L[1], L[2], L[3], H[0], H[1], H[2], H[3]}
    od = __builtin_amdgcn_mfma_f32_32x32x16_bf16(pa0, ATT_PK(l0, h0), od, 0, 0, 0);
    od = __builtin_amdgcn_mfma_f32_32x32x16_bf16(pa1, ATT_PK(l1, h1), od, 0, 0, 0);
    od = __builtin_amdgcn_mfma_f32_32x32x16_bf16(pa2, ATT_PK(l2, h2), od, 0, 0, 0);
    od = __builtin_amdgcn_mfma_f32_32x32x16_bf16(pa3, ATT_PK(l3, h3), od, 0, 0, 0);
#undef ATT_PK
}
template <int D0, int HK> __device__ __forceinline__ void pv_half(f32x16& od, int vb, bf16x8 pa0, bf16x8 pa1) {
    const s16x4 l0 = tr_read<v_rd_off(D0, 2 * HK, 0)>(vb), h0 = tr_read<v_rd_off(D0, 2 * HK, 1)>(vb), l1 = tr_read<v_rd_off(D0, 2 * HK + 1, 0)>(vb), h1 = tr_read<v_rd_off(D0, 2 * HK + 1, 1)>(vb);
    asm volatile("s_waitcnt lgkmcnt(0)" ::: "memory"); ATT_SBAR();
#define ATT_PK(L, H) (bf16x8){L[0], L[1], L[2], L[3], H[0], H[1], H[2], H[3]}
    od = __builtin_amdgcn_mfma_f32_32x32x16_bf16(pa0, ATT_PK(l0, h0), od, 0, 0, 0);
    od = __builtin_amdgcn_mfma_f32_32x32x16_bf16(pa1, ATT_PK(l1, h1), od, 0, 0, 0);
#undef ATT_PK
}
__device__ __forceinline__ void attn_unit(int b, int h, int u, const bf16_t* __restrict__ QB, const bf16_t* __restrict__ KN, const bf16_t* __restrict__ KR, const bf16_t* __restrict__ VB,
                                          unsigned char* __restrict__ MIX, LAS char* lds, const int tid) {
    const int wid = tid >> 6, lane = tid & 63, r32 = lane & 31, hi = lane >> 5;
    const int qc = (0x22331100u >> (4 * wid)) & 3, half = wid & 1;
    const int c0 = 4 * u - 3, ntw = c0 + qc + 1, ntmax = 4 * u + 1;
    const size_t rowb = (size_t)b * LP;
    const int qrow0 = 64 * (c0 + qc) + 32 * half;
    LAS float* wsf = (LAS float*)(lds + WS_OFF) + wid * 64; LAS float* li_l = wsf; LAS float* al_l = wsf + 32;
    bf16x8 qr[12];
    { const bf16_t* Qw = QB + (rowb + qrow0 + r32) * 1536 + h * QKD + hi * 8;
#pragma unroll
      for (int d0 = 0; d0 < 12; ++d0) qr[d0] = *(const bf16x8*)(Qw + d0 * 16); }
    unsigned gk0, gv0, gr;
    { const int w = wid;
      { const int row = 32 * (w & 1) + (lane >> 1), hh = (lane & 1) ^ ((row >> 3) & 1);
        gk0 = (unsigned)(row * 1024 + h * 128 + (w >> 1) * 16 + hh * 8); gr = (unsigned)(row * 64 + (w >> 1) * 16 + hh * 8); }
      { const int st = 4 * w + (lane >> 5), kk = (st >> 2) * 8 + ((lane >> 2) & 7), k = (kk & ~0xC) | ((kk & 4) << 1) | ((kk & 8) >> 1), c = (st & 3) * 32 + (lane & 3) * 8; gv0 = (unsigned)(k * 1024 + h * 128 + c); } }
    const bf16_t* KNb = KN + rowb * 1024; const bf16_t* VBb = VB + rowb * 1024; const bf16_t* KRb = KR + rowb * 64;
    const unsigned wq = (unsigned)wid * 2048u, wk = (unsigned)wid * 1024u;
    const int kb0 = (int)(uintptr_t)lds + SHM_V + r32 * 32 + ((hi ^ ((r32 >> 3) & 1)) << 4);
    const int vb0 = (int)(uintptr_t)lds + v_rd_base(lane);
#define ATT_DMA(gp, lp) __builtin_amdgcn_global_load_lds((const unsigned*)(gp), (LAS unsigned*)(lp), 16, 0, 0)
#define ATT_STAGE(j_, bf_) do { LAS char* bb_ = lds + (bf_) * SHM_BUF; const size_t ko_ = (size_t)(j_) * 64; \
    ATT_DMA(KNb + ko_ * 1024 + gk0, bb_ + SHM_V + wk); ATT_DMA(KNb + ko_ * 1024 + gk0 + 64, bb_ + SHM_V + 8192 + wk); \
    ATT_DMA(VBb + ko_ * 1024 + gv0, bb_ + wq); ATT_DMA(VBb + ko_ * 1024 + gv0 + 64, bb_ + wq + 1024); ATT_DMA(KRb + ko_ * 64 + gr, bb_ + SHM_V + 16384 + wk); } while (0)
#define ATT_WAIT_BAR(N) asm volatile("s_waitcnt vmcnt(" #N ") lgkmcnt(0)\n\ts_barrier" ::: "memory")
    float m_reg = -1e30f, l_reg = 0.f; f32x16 o[4];
#pragma unroll
    for (int d = 0; d < 4; ++d)
#pragma unroll
        for (int r = 0; r < 16; ++r) o[d][r] = 0.f;
    ATT_STAGE(0, 0); if (ntmax > 1) { ATT_STAGE(1, 1); ATT_WAIT_BAR(5); } else { ATT_WAIT_BAR(0); }
    int bf = 0;
    for (int j = 0; j < ntmax; ++j) {
        const int bf2 = bf == 0 ? 2 : bf - 1;
        const bool st2 = j + 2 < ntmax;
        if (st2) ATT_STAGE(j + 2, bf2);
        if (j < ntw) {
            const int vb = vb0 + bf * SHM_BUF, kb = kb0 + bf * SHM_BUF;
#pragma unroll
            for (int hk = 0; hk < 2; ++hk) {
                if (j == 0 && hk == 0) continue;
                f32x16 p0;
#pragma unroll
                for (int r = 0; r < 16; ++r) p0[r] = 0.f;
#pragma unroll
                for (int d0 = 0; d0 < 12; ++d0) {
                    const bf16x8 b0 = *(const LAS bf16x8*)(uintptr_t)(unsigned)(kb + d0 * 2048 + hk * 1024);
                    p0 = __builtin_amdgcn_mfma_f32_32x32x16_bf16(b0, qr[d0], p0, 0, 0, 0); }
                if (j == 0) {
#pragma unroll
                    for (int r = 0; r < 8; ++r) p0[r] = -1e30f;
                }
                float pmax = p0[0];
#pragma unroll
                for (int r = 1; r < 16; ++r) pmax = fmaxf(pmax, p0[r]);
                { auto sw = __builtin_amdgcn_permlane32_swap(__float_as_uint(pmax), __float_as_uint(pmax), false, false); pmax = fmaxf(__uint_as_float(sw[0]), __uint_as_float(sw[1])); }
                float mn, alpha;
                if (__all(pmax - m_reg <= 8.0f)) { mn = m_reg; alpha = 1.f; }
                else { mn = fmaxf(m_reg, pmax); alpha = __builtin_amdgcn_exp2f(m_reg - mn); m_reg = mn; }
                float ps = 0.f;
#pragma unroll
                for (int r = 0; r < 16; ++r) { p0[r] = __builtin_amdgcn_exp2f(p0[r] - mn); ps += p0[r]; }
                { auto sw = __builtin_amdgcn_permlane32_swap(__float_as_uint(ps), __float_as_uint(ps), false, false); ps = __uint_as_float(sw[0]) + __uint_as_float(sw[1]); }
                l_reg = l_reg * alpha + ps;
                bf16x8 pa0, pa1;
#define ATT_PK4(Pv, BASE, OUT) do { unsigned a0 = cvtpk(Pv[BASE + 0], Pv[BASE + 1]), a1 = cvtpk(Pv[BASE + 2], Pv[BASE + 3]); \
    unsigned b0_ = cvtpk(Pv[BASE + 4], Pv[BASE + 5]), b1_ = cvtpk(Pv[BASE + 6], Pv[BASE + 7]); \
    auto r0 = __builtin_amdgcn_permlane32_swap(a0, b0_, false, false); auto r1 = __builtin_amdgcn_permlane32_swap(a1, b1_, false, false); \
    u32x4 w = {r0[0], r1[0], r0[1], r1[1]}; OUT = *reinterpret_cast<bf16x8*>(&w); } while (0)
                ATT_PK4(p0, 0, pa0); ATT_PK4(p0, 8, pa1);
#undef ATT_PK4
                if (__any(alpha < 1.f)) { if (hi == 0) al_l[r32] = alpha; asm volatile("s_waitcnt lgkmcnt(0)" ::: "memory");
#pragma unroll
                    for (int d = 0; d < 4; ++d)
#pragma unroll
                        for (int r = 0; r < 16; ++r) o[d][r] *= al_l[crow(r, hi)]; }
                if (hk == 0) { pv_half<0, 0>(o[0], vb, pa0, pa1); pv_half<1, 0>(o[1], vb, pa0, pa1); pv_half<2, 0>(o[2], vb, pa0, pa1); pv_half<3, 0>(o[3], vb, pa0, pa1); }
                else         { pv_half<0, 1>(o[0], vb, pa0, pa1); pv_half<1, 1>(o[1], vb, pa0, pa1); pv_half<2, 1>(o[2], vb, pa0, pa1); pv_half<3, 1>(o[3], vb, pa0, pa1); }
            }
        }
        if (st2) ATT_WAIT_BAR(5); else ATT_WAIT_BAR(0);
        bf = bf == 2 ? 0 : bf + 1;
    }
    if (hi == 0) li_l[r32] = l_reg;
    asm volatile("s_waitcnt lgkmcnt(0)" ::: "memory");
    unsigned char* Ow = MIX + (rowb + qrow0) * DM + POOLW + h * 128 + r32;
#pragma unroll
    for (int r = 0; r < 16; ++r) { const int orow = crow(r, hi); const float rli = __builtin_amdgcn_rcpf(li_l[orow]);
#pragma unroll
        for (int d0 = 0; d0 < 4; ++d0) Ow[(size_t)orow * DM + d0 * 32] = (unsigned char)__builtin_amdgcn_cvt_pk_fp8_f32(o[d0][r] * rli * (float)(1 << MIX_SCALE_LOG2), 0.f, 0, false); }
#undef ATT_DMA
#undef ATT_STAGE
#undef ATT_WAIT_BAR
}
__device__ __forceinline__ void attn_phase(const unsigned char* ws, unsigned char* wsw, LAS char* lds, int G, int bx, const int tid) {
    const bf16_t* QB = (const bf16_t*)(ws + WS_QB); const bf16_t* KN = (const bf16_t*)(ws + WS_KN); const bf16_t* KR = (const bf16_t*)(ws + WS_KR); const bf16_t* VB = (const bf16_t*)(ws + WS_VB);
    unsigned char* MIX = wsw + WS_MIX;
    for (int c = bx; c < 256; c += G) {
        const int x = c & 7, y = c >> 3, bh = 8 * (y >> 2) + x, p = y & 3, b = bh >> 3, h = bh & 7;
#pragma unroll 1
        for (int k = 0; k < 2; ++k) attn_unit(b, h, k == 0 ? 8 - p : 1 + p, QB, KN, KR, VB, MIX, lds, tid);
    }
}
}
#define XB_TMO      128
#define XB_XCNT(j)  (256  + 64 * (j))
#define XB_XSUB(j)  (1280 + 64 * (j))
#define XB_XGEN(j)  (2304 + 64 * (j))
#define XB_TOP      3328
#define XB_TOPGEN   3392
#define XCD_BAR_WORDS 3456
#define XB_SPIN_CAP (1u << 18)
__device__ __forceinline__ unsigned xb_ld(unsigned* p)              { return __hip_atomic_load(p, __ATOMIC_RELAXED, __HIP_MEMORY_SCOPE_AGENT); }
__device__ __forceinline__ unsigned xb_add(unsigned* p, unsigned v) { return __hip_atomic_fetch_add(p, v, __ATOMIC_RELAXED, __HIP_MEMORY_SCOPE_AGENT); }
__device__ __forceinline__ unsigned xb_xcc_id() { return (unsigned)__builtin_amdgcn_s_getreg((3 << 11) | 20) & 0xFu; }
#define XB_SPIN(cond, bar) do { unsigned _sp = 0; while (cond) { __builtin_amdgcn_s_sleep(1); \
    if ((++_sp & 255u) == 0u) { if (xb_ld(&(bar)[XB_TMO])) break; if (_sp > XB_SPIN_CAP) { atomicAdd(&(bar)[XB_TMO], 1u); break; } } } } while (0)
struct XcdBarrier { unsigned* bar; unsigned x; volatile LAS unsigned* st; };
__device__ __forceinline__ XcdBarrier xcd_barrier_post(unsigned* bar, volatile LAS unsigned* st) {
    XcdBarrier b; b.bar = bar; b.x = xb_xcc_id(); b.st = st;
    if (threadIdx.x == 0) (void)xb_add(&bar[XB_XCNT(b.x)], 1u);
    return b;
}
__device__ __forceinline__ void xcd_barrier_complete(unsigned* bar, unsigned x, unsigned& nloc, unsigned& nx) {
    const unsigned G = gridDim.x * gridDim.y * gridDim.z;
    unsigned sum, cnt, mine, sp = 0u;
    for (;;) {
        sum = 0u; cnt = 0u; mine = 0u;
#pragma unroll
        for (unsigned j = 0; j < 16; ++j) { const unsigned c = xb_ld(&bar[XB_XCNT(j)]); sum += c; cnt += (c > 0u) ? 1u : 0u; mine = (j == x) ? c : mine; }
        if (sum == G) break;
        __builtin_amdgcn_s_sleep(1);
        if ((++sp & 255u) == 0u) { if (xb_ld(&bar[XB_TMO])) break; if (sp > XB_SPIN_CAP) { atomicAdd(&bar[XB_TMO], 1u); break; } }
    }
    nloc = mine > 0u ? mine : 1u; nx = cnt > 0u ? cnt : 1u;
}
__device__ __forceinline__ void xcd_barrier(const XcdBarrier& b) {
    asm volatile("s_waitcnt vmcnt(0)" ::: "memory");
    __syncthreads();
    if (threadIdx.x == 0) {
        unsigned* bar = b.bar;
        __builtin_amdgcn_s_waitcnt(0);
        unsigned nloc = b.st[0], nx = b.st[1];
        if (nloc == 0u) { xcd_barrier_complete(bar, b.x, nloc, nx); b.st[0] = nloc; b.st[1] = nx; }
        const unsigned old = xb_add(&bar[XB_XSUB(b.x)], 1u);
        const unsigned gen = old / nloc;
        if (old + 1u == (gen + 1u) * nloc) {
            __builtin_amdgcn_fence(__ATOMIC_RELEASE, "agent");
            asm volatile("s_waitcnt vmcnt(0)" ::: "memory");
            const unsigned og = xb_add(&bar[XB_TOP], 1u);
            const unsigned tg = og / nx;
            if (og + 1u == (tg + 1u) * nx) xb_add(&bar[XB_TOPGEN], 1u);
            else XB_SPIN(xb_ld(&bar[XB_TOPGEN]) == tg, bar);
            __builtin_amdgcn_fence(__ATOMIC_ACQUIRE, "agent");
            xb_add(&bar[XB_XGEN(b.x)], 1u);
            asm volatile("s_waitcnt vmcnt(0)" ::: "memory");
        } else {
            XB_SPIN(xb_ld(&bar[XB_XGEN(b.x)]) == gen, bar);
            __builtin_amdgcn_fence(__ATOMIC_ACQUIRE, "agent");
            asm volatile("s_waitcnt vmcnt(0)" ::: "memory");
        }
    }
    __syncthreads();
}
constexpr int CW_BAR = 4096;

constexpr int CVS_P1 = 0, CVS_P2 = 3072, CVS_P3 = 4352, CVS_P3B = 8192, CVS_P4 = 8448, CVS_P6 = 11776;
static_assert(CVS_P1 + 16 * 7 + 80 * 13 + 160 * 12 == CVS_P2 && CVS_P2 + 140 * 4 + 24 * 7 + 92 * 6 == CVS_P3 && CVS_P3 + 256 * 15 == CV_ITEMS_W1 && CVS_P3B == CV_ITEMS_W1 && CVS_P3B + 256 == CVS_P4 && CVS_P4 + 256 * 13 == CVS_P6 && CVS_P6 + 512 == CV_ITEMS, "conversion plan");
constexpr int PH_P0 = 0, PH_P1 = 1, PH_P1B = 2, PH_P2 = 3, PH_P3 = 4, PH_P4 = 5, PH_P5 = 6, PH_P6 = 7, PH_P7 = 8, PH_P8 = 9, PH_END = 10;
struct Args { Ptrs P; int ph_lo, ph_hi, use_bar, pad; };
#define CAS __attribute__((address_space(4)))
__device__ __forceinline__ void load_ptrs(const CAS Args* a, Ptrs& P) { P.x = a->P.x; P.meta = a->P.meta; P.g_attn = a->P.g_attn; P.w_in = a->P.w_in; P.g_q = a->P.g_q; P.w_uq = a->P.w_uq; P.g_kv = a->P.g_kv; P.w_ukv = a->P.w_ukv; P.pool_w = a->P.pool_w; P.pool_scale = a->P.pool_scale; P.w_o = a->P.w_o; P.g_ffn = a->P.g_ffn; P.w_router = a->P.w_router; P.b_router = a->P.b_router; P.w1 = a->P.w1; P.b1 = a->P.b1; P.w2 = a->P.w2; P.b2 = a->P.b2; P.g_final = a->P.g_final; P.out = a->P.out; P.ws = a->P.ws; }
__global__ void __launch_bounds__(NWAVES * 64, 2) mk_fwd(Args args) {
    extern __shared__ __attribute__((aligned(16))) unsigned char lds_raw[];
    LAS unsigned char* lds = (LAS unsigned char*)lds_raw;
    const int G = gridDim.x, bx = blockIdx.x;
#define PHASE_IDS int tid; asm volatile("v_mov_b32 %0, %1" : "=v"(tid) : "v"(threadIdx.x)); const int lane = tid & 63, wave = __builtin_amdgcn_readfirstlane(tid >> 6); \
    const long gw = (long)bx * NWAVES + wave, NGW = (long)G * NWAVES; (void)lane; (void)gw; (void)NGW; \
    const CAS Args* ap_ = (const CAS Args*)__builtin_amdgcn_kernarg_segment_ptr(); asm volatile("" : "+s"(ap_)); Ptrs P; load_ptrs(ap_, P); unsigned char* const ws = P.ws
    volatile LAS unsigned* MISC = (volatile LAS unsigned*)(lds + MISC_OFF);
    if (threadIdx.x < 64) MISC[threadIdx.x] = 0u;
    __syncthreads();
    XcdBarrier bar; bar.bar = (unsigned*)(args.P.ws + WS_CTL) + CW_BAR; bar.x = 0; bar.st = nullptr;
    if (args.use_bar) bar = xcd_barrier_post((unsigned*)(args.P.ws + WS_CTL) + CW_BAR, MISC + 8);
    const int lo = args.ph_lo, hi = args.ph_hi;
#define IN(k) (lo <= (k) && (k) < hi)
    const bool cv_first = ((bx >> 3) & 1) != 0;
#define CV_CALL(W1, F, S, N) do { const CAS Args* ap2_ = (const CAS Args*)__builtin_amdgcn_kernarg_segment_ptr(); asm volatile("" : "+s"(ap2_)); Ptrs Pc_; load_ptrs(ap2_, Pc_); cv_slice<W1>(Pc_, lds_raw, tid, (F), (S), (N)); } while (0)
#define CV_DEAL(W1, S, ca, ka, cb, kb, kc) do { if (G == 256) { int f_, s_, n_; if (bx < (ca)) { f_ = (S) + bx; s_ = (ca); n_ = (ka); } else if (bx < (cb)) { f_ = (S) + (ca) * (ka) + (bx - (ca)); s_ = (cb) - (ca); n_ = (kb); } \
        else { f_ = (S) + (ca) * (ka) + ((cb) - (ca)) * (kb) + (bx - (cb)); s_ = 256 - (cb); n_ = (kc); } CV_CALL(W1, f_, s_, n_); } \
    else { const int tot_ = (ca) * (ka) + ((cb) - (ca)) * (kb) + (256 - (cb)) * (kc); for (int it_ = (S) + bx; it_ < (S) + tot_; it_ += G) CV_CALL(W1, it_, 0, 1); } } while (0)
#define CV_SLICE(W1, S, N) CV_DEAL(W1, S, 0, 0, 0, 0, N)
#define SEAM(k) do { if (IN(k) && IN((k) + 1)) xcd_barrier(bar); } while (0)

    if (IN(PH_P0)) { PHASE_IDS;
        float* scr = (float*)lds_raw + wave * (64 * 65);
        for (long it = gw; it < I_TOTAL; it += NGW) p0_item(P, it, scr, lane);
        for (long p = gw; p < MP; p += NGW) p0_hn_row(P, (int)p, lane);
        { u32x4* z = (u32x4*)(ws + WS_WIN + (size_t)INW * DM * 2); const long n16 = (long)(DM - INW) * DM * 2 / 16;
          for (long i = (long)bx * 512 + tid; i < n16; i += (long)G * 512) z[i] = (u32x4){0u, 0u, 0u, 0u}; }
        { float* ct = (float*)(ws + WS_ROPE); float* st = ct + LSEQ * 32;
          for (long i = (long)bx * 512 + tid; i < LSEQ * 32; i += (long)G * 512) { const int pos = (int)(i / 32), j = (int)(i % 32);
              const float inv = 1.0f / powf(10000.0f, (float)(2 * j) / 64.0f); const float ang = (float)pos * inv; ct[i] = cosf(ang); st[i] = sinf(ang); } }
        { float* wr = (float*)(ws + WS_WR);
          for (long i = (long)bx * 512 + tid; i < DM * NE; i += (long)G * 512) { const int k = (int)(i / NE), e = (int)(i % NE); wr[((k >> 2) * NE + e) * 4 + (k & 3)] = P.w_router[i] * P.g_ffn[k]; } }
        __syncthreads();
    }
    SEAM(PH_P0);
    if (IN(PH_P1)) { PHASE_IDS;
        pg8::ProbP1 pb; pb.A = (const char*)(ws + WS_HN); pb.Bt = (const char*)(ws + WS_WIN); pb.K = DM; pb.lda = DM; pb.ldaB = 2 * DM; pb.ldb = DM; pb.ldbB = 2 * DM; pb.ord.init(MP / 256, 8, G, bx);
        pb.proj = (bf16_t*)(ws + WS_PROJ); pb.kr = (bf16_t*)(ws + WS_KR); pb.rope = (const float*)(ws + WS_ROPE); pb.ssqp = (float*)(ws + WS_RSQ);
        if (cv_first) CV_DEAL(true, CVS_P1, 16, 7, 96, 13, 12);
        pg8::gemm_phase<pg8::ProbP1, true>(lds + RING_OFF, pb, tid);
        if (!cv_first) CV_DEAL(true, CVS_P1, 16, 7, 96, 13, 12);
    }
    if (IN(PH_P1) && IN(PH_P2)) xcd_barrier(bar);
    if (IN(PH_P2)) { PHASE_IDS;
        for (long m = gw; m < MP; m += NGW) p1b_row(P, (int)m, lane);
        if (cv_first) CV_DEAL(true, CVS_P2, 140, 4, 164, 7, 6);
        { pg8::ProbP2q pb; pb.A = (const char*)(ws + WS_PROJ) + 1024 * 2; pb.Bt = (const char*)(ws + WS_WUQ); pb.K = QLORA; pb.lda = DM; pb.ldaB = 2 * DM; pb.ldb = QLORA; pb.ldbB = 2 * QLORA; pb.ord.init(MP / 256, 6, G, bx);
          pb.qb = (bf16_t*)(ws + WS_QB); pb.rsq = (const float*)(ws + WS_RSQ); pb.rope = (const float*)(ws + WS_ROPE);
          pg8::gemm_phase<pg8::ProbP2q, true>(lds + RING_OFF, pb, tid); }
        { pg8::ProbP2kv pb; pb.A = (const char*)(ws + WS_PROJ) + 1536 * 2; pb.Bt = (const char*)(ws + WS_WUKV); pb.K = KVLORA; pb.lda = DM; pb.ldaB = 2 * DM; pb.ldb = KVLORA; pb.ldbB = 2 * KVLORA; pb.ord.init(MP / 256, 8, G, (bx + 116) % G);
          pb.kn = (bf16_t*)(ws + WS_KN); pb.vb = (bf16_t*)(ws + WS_VB); pb.rskv = (const float*)(ws + WS_RSQ);
          pg8::gemm_phase<pg8::ProbP2kv, true>(lds + RING_OFF, pb, tid); }
        if (!cv_first) CV_DEAL(true, CVS_P2, 140, 4, 164, 7, 6);
    }
    SEAM(PH_P2);
    if (IN(PH_P3)) { PHASE_IDS;
        if (cv_first) { CV_SLICE(true, CVS_P3, 15); CV_SLICE(false, CVS_P3B, 1); }
        att::attn_phase(ws, ws, (LAS char*)(lds + RING_OFF), G, bx, tid);
        { pg8::ProbPool pb; pb.A = (const char*)(ws + WS_DP); pb.Bt = (const char*)(ws + WS_WPOOL); pb.K = 256; pb.lda = POOLW; pb.ldaB = 2 * POOLW; pb.ldb = 256; pb.ldbB = 2 * 256; pb.ord.init(MP / 256, 4, G, bx);
          pb.mix = ws + WS_MIX; pb.pscale = P.pool_scale;
          pg8::gemm_phase<pg8::ProbPool, true>(lds + RING_OFF, pb, tid); }
        if (!cv_first) { CV_SLICE(true, CVS_P3, 15); CV_SLICE(false, CVS_P3B, 1); }
    }
    SEAM(PH_P3);
    if (IN(PH_P4)) { PHASE_IDS;
        pg8::ProbP4 pb; pb.A = (const char*)(ws + WS_MIX); pb.Bt = (const char*)(ws + WS_WO); pb.K = DM; pb.ldbB = DM; pb.ord.init(MR / 256, 8, G, bx);
        pb.x = P.x; pb.h2 = (bf16_t*)(ws + WS_HN); pb.h2f8 = ws + WS_H2B;
        pg8::gemm_phase<pg8::ProbP4, true>(lds + RING_OFF, pb, tid);
    }
    SEAM(PH_P4);
    if (IN(PH_P5)) { PHASE_IDS; for (int blk = bx; blk < MR / 64; blk += G) p5_block(P, blk, lds_raw, tid); }
    SEAM(PH_P5);
    if (IN(PH_P6)) { PHASE_IDS;
        pg8::moe_table(lds, (const unsigned*)(ws + WS_CTL) + CW_CNT, tid);
        pg8::ProbP6 pb; pb.A = (const char*)(ws + WS_H2B); pb.Bt = (const char*)(ws + WS_W1); pb.K = DM; pb.ldbB = DM; pb.ord.tab = (const LAS int*)(lds + TAB_OFF); pb.ord.G = G; pb.ord.c = bx;
        pb.list = (const int*)(ws + WS_LIST); pb.rsl = (const float*)(ws + WS_RSL); pb.b1 = P.b1; pb.act = ws + WS_ACT;
        const int split = 2 + 4 * ((bx >> 3) & 3);
        pb.ord.i0 = 0; pb.ord.i1 = split;
        pg8::gemm_phase<pg8::ProbP6, true>(lds + RING_OFF, pb, tid);
        CV_SLICE(false, CVS_P4, 13);
        pb.ord.i0 = split; pb.ord.i1 = 0x7fffffff;
        pg8::gemm_phase<pg8::ProbP6, true>(lds + RING_OFF, pb, tid);
        { const int U = ((const LAS int*)(lds + TAB_OFF))[NE] * 16, R = U % G, nidle = G - R, rank0 = (G & 7) ? bx : (bx & 7) * (G >> 3) + (bx >> 3);
          const bool few = nidle < 64; const int nshare = few ? G : nidle, rank = few ? rank0 : rank0 - R;
          if (rank >= 0) { const int cnt_ = (CV_ITEMS - CVS_P6 - rank + nshare - 1) / nshare; CV_CALL(false, CVS_P6 + rank, nshare, cnt_); } }
    }
    SEAM(PH_P6);
    if (IN(PH_P7)) { PHASE_IDS;
        pg8::moe_table(lds, (const unsigned*)(ws + WS_CTL) + CW_CNT, tid);
        pg8::ProbP7 pb; pb.A = (const char*)(ws + WS_ACT); pb.Bt = (const char*)(ws + WS_W2); pb.K = DFF; pb.ldbB = DFF; pb.ord.tab = (const LAS int*)(lds + TAB_OFF); pb.ord.G = G; pb.ord.c = bx; pb.ord.i0 = 0; pb.ord.i1 = 0x7fffffff;
        pb.list = (const int*)(ws + WS_LIST); pb.gate = (const float*)(ws + WS_GATE); pb.b2 = P.b2; pb.yb = ws + WS_YB;
        pg8::gemm_phase<pg8::ProbP7, true>(lds + RING_OFF, pb, tid);
    }
    SEAM(PH_P7);
    if (IN(PH_P8)) { PHASE_IDS; for (long r = gw; r < MR; r += NGW) p8_row(P, (int)r, lane, P.out); }
#undef IN
#undef SEAM
}

extern "C" void kernel_launch(void* const* d_in, const int* in_sizes, int n_in, void* d_out, int out_size, void* d_ws, size_t ws_size, hipStream_t stream) {
    static int ok = 0; static int grid = 256;
    if (ok == 0) {
        if (n_in != 19 || in_sizes[0] != NB * SEQ * DM || out_size != MR * DM || ws_size < WS_END) { fprintf(stderr, "kernel_launch: shape mismatch n_in %d in0 %d out %d ws %zu\n", n_in, n_in > 0 ? in_sizes[0] : -1, out_size, ws_size); ok = -1; return; }
        if (hipFuncSetAttribute((const void*)mk_fwd, hipFuncAttributeMaxDynamicSharedMemorySize, LDS_BYTES) != hipSuccess) { fprintf(stderr, "hipFuncSetAttribute(mk) failed\n"); ok = -1; return; }
        int dev = 0, cus = 0; (void)hipGetDevice(&dev); (void)hipDeviceGetAttribute(&cus, hipDeviceAttributeMultiprocessorCount, dev); if (cus > 0) grid = cus;
        ok = 1;
    }
    if (ok < 0) return;
    Ptrs P{};
    const float** pp = (const float**)&P;
    for (int i = 0; i < 19; ++i) pp[i] = (const float*)d_in[i];
    P.out = (float*)d_out; P.ws = (unsigned char*)d_ws;
    unsigned char* ws = (unsigned char*)d_ws;
    (void)hipMemsetAsync(ws + WS_CTL, 0, CTL_ZERO_BYTES, stream);
    { Args a{}; a.P = P; a.ph_lo = 0; a.ph_hi = PH_END; a.use_bar = 1; a.pad = 0;
      hipLaunchKernelGGL(mk_fwd, dim3(grid), dim3(NWAVES * 64), LDS_BYTES, stream, a); }
}
```
